# Optimizing an MI355X kernel written in HIP

```python
import jax, jax.numpy as jnp
from jax import lax
import numpy as np

D_MODEL = 1024
BATCH = 4
SEQ = 4096
DEPTH = 2

GRID_W = 64
CTX_LEN = 256
EPS = 1e-6
F32 = jnp.float32
NEG_INF = -1e30
F_FLOOR = 1e-30
NA_HEADS = 8
NA_HEAD_DIM = 64
NA_WIDTH = NA_HEADS * NA_HEAD_DIM
NA_WIN_ROWS = 8
NA_WIN_COLS = 16
NA_QCOL_BLOCK = 16
NA_KCOL_BAND = NA_QCOL_BLOCK + NA_WIN_COLS
HG_HEADS = 4
HG_HEAD_DIM = 128
HG_WIDTH = HG_HEADS * HG_HEAD_DIM
ML_HEADS = 4
ML_HEAD_DIM = 128
ML_WIDTH = ML_HEADS * ML_HEAD_DIM
ML_GATE_COLS = 2 * 2 * ML_HEADS
ROPE_BASE = 10000.0
CHUNK = 64
N_BRANCH = 3
BRANCH_WIDTH = 512
FFN_DIM = 2816
N_EXPERTS = 8
TOP_K = 2
EXPERT_DIM = 3584
MOE_BLOCK = 512

IN_NAMES = ('na_q', 'na_k', 'na_v', 'hg_q', 'hg_f_fwd', 'hg_f_bwd', 'hg_i', 'hg_g',
            'ml_q', 'ml_k', 'ml_v', 'ml_o', 'ml_gates', 'branch_gates')
IN_SIZES = (NA_WIDTH, NA_WIDTH, NA_WIDTH, HG_WIDTH, HG_WIDTH, HG_WIDTH, HG_WIDTH, HG_WIDTH,
            ML_WIDTH, ML_WIDTH, ML_WIDTH, ML_WIDTH, ML_GATE_COLS, N_BRANCH * D_MODEL)
IN_WIDTH = 3 * NA_WIDTH + 5 * HG_WIDTH + 4 * ML_WIDTH + ML_GATE_COLS + N_BRANCH * D_MODEL

kernel_name = 'hybrid_na_hgrn2_mlstm_moe_dit'


def rms_norm(x, w):
    xf = x.astype(F32)
    y = xf * lax.rsqrt(jnp.mean(xf * xf, axis=-1, keepdims=True) + EPS)
    return (y * w.astype(F32)).astype(x.dtype)


def modulate(h, shift, scale):
    return h * (1 + scale) + shift


def split_heads(t, n):
    return t.reshape(*t.shape[:-1], n, t.shape[-1] // n)


def split_in(proj):
    offs = np.cumsum(IN_SIZES)[:-1].tolist()
    return dict(zip(IN_NAMES, jnp.split(proj, offs, axis=-1)))


def head_rms(o, w):
    o = o * lax.rsqrt(jnp.mean(o * o, axis=-1, keepdims=True) + EPS)
    return o.reshape(*o.shape[:2], -1) * w.astype(F32)


def axial_rope(t, rows_pos, cols_pos):
    half = t.shape[-1] // 2
    n_freq = half // 2
    inv_freq = ROPE_BASE ** (-jnp.arange(n_freq, dtype=F32) / n_freq)

    def rotate(part, pos):
        ang = pos.astype(F32)[:, None] * inv_freq
        cos = jnp.cos(ang)[None, :, None, :]
        sin = jnp.sin(ang)[None, :, None, :]
        p1, p2 = part[..., :n_freq], part[..., n_freq:]
        return jnp.concatenate([p1 * cos - p2 * sin, p1 * sin + p2 * cos], axis=-1)

    return jnp.concatenate([rotate(t[..., :half], rows_pos), rotate(t[..., half:], cols_pos)], axis=-1)


def to_chunks(a):
    B, T, H, d = a.shape
    return a.reshape(B, T // CHUNK, CHUNK, H, d).transpose(1, 0, 3, 2, 4)


def gate_chunks(a):
    B, T, H = a.shape
    return a.reshape(B, T // CHUNK, CHUNK, H).transpose(1, 0, 3, 2)


def from_chunks(a):
    n, B, H, L, d = a.shape
    return a.transpose(1, 0, 3, 2, 4).reshape(B, n * L, H, d)


def na_latent(q, k, v, k_ctx, v_ctx, rpb):
    B, S, H, dh = q.shape
    rows = S // GRID_W
    wr = min(NA_WIN_ROWS, rows)
    n_cb = GRID_W // NA_QCOL_BLOCK
    scale = dh ** -0.5
    qcol = np.arange(GRID_W).reshape(n_cb, NA_QCOL_BLOCK)
    band_start = np.clip(np.arange(n_cb) * NA_QCOL_BLOCK - NA_WIN_COLS // 2, 0, GRID_W - NA_KCOL_BAND)
    kcol = band_start[:, None] + np.arange(NA_KCOL_BAND)
    win_start = np.clip(qcol - NA_WIN_COLS // 2, 0, GRID_W - NA_WIN_COLS)
    col_mask = (kcol[:, None, :] >= win_start[..., None]) & (kcol[:, None, :] < win_start[..., None] + NA_WIN_COLS)
    dc = np.clip(kcol[:, None, :] - qcol[..., None] + NA_WIN_COLS - 1, 0, 2 * NA_WIN_COLS - 2)
    rpb_c = rpb.astype(F32)[:, :, dc]
    qg = q.reshape(B, rows, GRID_W, H, dh)
    kband = k.reshape(B, rows, GRID_W, H, dh)[:, :, kcol]
    vband = v.reshape(B, rows, GRID_W, H, dh)[:, :, kcol]
    mask = jnp.asarray(col_mask)[:, :, None, :]

    def row_block(r):
        r0 = jnp.clip(r - NA_WIN_ROWS // 2, 0, rows - wr)
        q_r = lax.dynamic_index_in_dim(qg, r, axis=1, keepdims=False).reshape(B, n_cb, NA_QCOL_BLOCK, H, dh)
        k_r = lax.dynamic_slice_in_dim(kband, r0, wr, axis=1)
        v_r = lax.dynamic_slice_in_dim(vband, r0, wr, axis=1)
        s_loc = jnp.einsum('bcqhd,bwckhd->bhcqwk', q_r, k_r, preferred_element_type=F32) * scale
        dr = r0 + jnp.arange(wr) - r + NA_WIN_ROWS - 1
        bias = jnp.take(rpb_c, dr, axis=1).transpose(0, 2, 3, 1, 4)
        s_loc = jnp.where(mask, s_loc + bias, NEG_INF).reshape(B, H, n_cb, NA_QCOL_BLOCK, wr * NA_KCOL_BAND)
        s_ctx = jnp.einsum('bcqhd,bjhd->bhcqj', q_r, k_ctx, preferred_element_type=F32) * scale
        p = jax.nn.softmax(jnp.concatenate([s_loc, s_ctx], axis=-1), axis=-1).astype(v.dtype)
        p_loc = p[..., :wr * NA_KCOL_BAND].reshape(B, H, n_cb, NA_QCOL_BLOCK, wr, NA_KCOL_BAND)
        p_ctx = p[..., wr * NA_KCOL_BAND:]
        o = jnp.einsum('bhcqwk,bwckhd->bcqhd', p_loc, v_r) + jnp.einsum('bhcqj,bjhd->bcqhd', p_ctx, v_ctx)
        return o.reshape(B, GRID_W, H, dh)

    out = lax.map(row_block, jnp.arange(rows))
    return out.transpose(1, 0, 2, 3, 4).reshape(B, S, H * dh)


def context_attention(q, k, v):
    B, L, H, dh = q.shape
    s = jnp.einsum('bqhd,bkhd->bhqk', q, k, preferred_element_type=F32) * dh ** -0.5
    p = jax.nn.softmax(s, axis=-1).astype(v.dtype)
    return jnp.einsum('bhqk,bkhd->bqhd', p, v).reshape(B, L, H * dh)


def bidirectional(scan_fn, ctx_dirs, lat_dirs, init):
    outs_c, outs_l = [], []
    for d in range(2):
        rev = (lambda a: a) if d == 0 else (lambda a: jnp.flip(a, axis=1))
        o_c, state = scan_fn(*[rev(a) for a in ctx_dirs[d]], init)
        o_l, _ = scan_fn(*[rev(a) for a in lat_dirs[d]], state)
        outs_c.append(rev(o_c))
        outs_l.append(rev(o_l))
    return outs_c[0] + outs_c[1], outs_l[0] + outs_l[1]


def hgrn2_chunk_scan(q, k, v, log_f, state):
    tri = jnp.tril(jnp.ones((CHUNK, CHUNK), dtype=bool))[:, :, None]

    def step(S, inp):
        qc, kc, vc, gc = inp
        G = jnp.cumsum(gc, axis=2)
        decay = jnp.exp(jnp.where(tri, G[:, :, :, None, :] - G[:, :, None, :, :], NEG_INF))
        A = jnp.einsum('bhtd,bhsd,bhtsd->bhts', qc, kc, decay)
        o = jnp.einsum('bhts,bhsv->bhtv', A, vc) + jnp.einsum('bhtd,bhdv->bhtv', qc * jnp.exp(G), S)
        G_end = G[:, :, -1, :]
        S_new = jnp.exp(G_end)[..., None] * S + jnp.einsum('bhsd,bhsv->bhdv', kc * jnp.exp(G_end[:, :, None, :] - G), vc)
        return S_new, o

    S_fin, o = lax.scan(step, state, (to_chunks(q), to_chunks(k), to_chunks(v), to_chunks(log_f)))
    return from_chunks(o), S_fin


def hgrn2_branch(p_ctx, p_lat, lower, norm_w):
    def prep(p):
        q = jax.nn.silu(split_heads(p['hg_q'], HG_HEADS).astype(F32))
        v = split_heads(p['hg_i'], HG_HEADS).astype(F32)
        per_dir = []
        for d, name in enumerate(('hg_f_fwd', 'hg_f_bwd')):
            z = split_heads(p[name], HG_HEADS).astype(F32)
            lb = lower[d].reshape(HG_HEADS, HG_HEAD_DIM)
            k = (1.0 - lb) * jax.nn.sigmoid(-z)
            f = lb + (1.0 - lb) * jax.nn.sigmoid(z)
            log_f = jnp.log(jnp.maximum(f, F_FLOOR))
            per_dir.append((q, k, v, log_f))
        return per_dir

    B = p_lat['hg_q'].shape[0]
    init = jnp.zeros((B, HG_HEADS, HG_HEAD_DIM, HG_HEAD_DIM), F32)
    o_c, o_l = bidirectional(hgrn2_chunk_scan, prep(p_ctx), prep(p_lat), init)

    def readout(o, p):
        return head_rms(o, norm_w) * jax.nn.silu(p['hg_g'].astype(F32))

    return readout(o_c, p_ctx), readout(o_l, p_lat)


def mlstm_chunk_scan(q, k, v, log_i, log_f, state):
    tri = jnp.tril(jnp.ones((CHUNK, CHUNK), dtype=bool))

    def step(carry, inp):
        C, nv, m = carry
        qc, kc, vc, ic, fc = inp
        b = jnp.cumsum(fc, axis=-1)
        dmat = jnp.where(tri, b[..., :, None] - b[..., None, :] + ic[..., None, :], NEG_INF)
        inter = b + m[..., None]
        m_t = jnp.maximum(inter, jnp.max(dmat, axis=-1))
        w_inter = jnp.exp(inter - m_t)
        p = jnp.exp(dmat - m_t[..., None]) * jnp.einsum('bhtd,bhsd->bhts', qc, kc)
        num = jnp.einsum('bhts,bhsv->bhtv', p, vc) + w_inter[..., None] * jnp.einsum('bhtd,bhdv->bhtv', qc, C)
        den = jnp.sum(p, axis=-1) + w_inter * jnp.einsum('bhtd,bhd->bht', qc, nv)
        h = num / jnp.maximum(jnp.abs(den), jnp.exp(-m_t))[..., None]
        b_end = b[..., -1]
        e = b_end[..., None] - b + ic
        m_new = jnp.maximum(b_end + m, jnp.max(e, axis=-1))
        w_old = jnp.exp(b_end + m - m_new)
        w_s = jnp.exp(e - m_new[..., None])
        C_new = w_old[..., None, None] * C + jnp.einsum('bhs,bhsd,bhsv->bhdv', w_s, kc, vc)
        n_new = w_old[..., None] * nv + jnp.einsum('bhs,bhsd->bhd', w_s, kc)
        return (C_new, n_new, m_new), h

    xs = (to_chunks(q), to_chunks(k), to_chunks(v), gate_chunks(log_i), gate_chunks(log_f))
    state_out, h = lax.scan(step, state, xs)
    return from_chunks(h), state_out


def mlstm_branch(p_ctx, p_lat, gate_b, norm_w, rows_pos, cols_pos):
    def prep(p, use_rope):
        q = split_heads(p['ml_q'], ML_HEADS).astype(F32)
        k = split_heads(p['ml_k'], ML_HEADS).astype(F32) * ML_HEAD_DIM ** -0.5
        v = split_heads(p['ml_v'], ML_HEADS).astype(F32)
        if use_rope:
            q = axial_rope(q, rows_pos, cols_pos)
            k = axial_rope(k, rows_pos, cols_pos)
        B, T = q.shape[:2]
        g = p['ml_gates'].astype(F32).reshape(B, T, 2, 2, ML_HEADS) + gate_b.astype(F32)
        return [(q, k, v, g[:, :, d, 0], jax.nn.log_sigmoid(g[:, :, d, 1])) for d in range(2)]

    B = p_lat['ml_q'].shape[0]
    init = (jnp.zeros((B, ML_HEADS, ML_HEAD_DIM, ML_HEAD_DIM), F32),
            jnp.zeros((B, ML_HEADS, ML_HEAD_DIM), F32),
            jnp.zeros((B, ML_HEADS), F32))
    h_c, h_l = bidirectional(mlstm_chunk_scan, prep(p_ctx, False), prep(p_lat, True), init)

    def readout(h, p):
        return jax.nn.sigmoid(p['ml_o'].astype(F32)) * head_rms(h, norm_w)

    return readout(h_c, p_ctx), readout(h_l, p_lat)


def gated_merge(branches, gate_raw, w_branch, w_out):
    dt = gate_raw.dtype
    gates = jnp.split(jax.nn.sigmoid(gate_raw.astype(F32)).astype(dt), N_BRANCH, axis=-1)
    y = gates[0] * (branches[0].astype(dt) @ w_branch[0])
    for i in range(1, N_BRANCH):
        y = y + gates[i] * (branches[i].astype(dt) @ w_branch[i])
    return y @ w_out


def hybrid_mixer(a_lat, a_ctx, w_in, na_rpb, hg_lower, hg_norm_w, ml_gate_b, ml_norm_w, w_branch, w_out,
                 rows_pos, cols_pos, need_ctx_out):
    pl = split_in(a_lat @ w_in)
    pc = split_in(a_ctx @ w_in)
    nh = lambda t: split_heads(t, NA_HEADS)
    na_l = na_latent(nh(pl['na_q']), nh(pl['na_k']), nh(pl['na_v']), nh(pc['na_k']), nh(pc['na_v']), na_rpb)
    hg_c, hg_l = hgrn2_branch(pc, pl, hg_lower, hg_norm_w)
    ml_c, ml_l = mlstm_branch(pc, pl, ml_gate_b, ml_norm_w, rows_pos, cols_pos)
    y_lat = gated_merge((na_l, hg_l, ml_l), pl['branch_gates'], w_branch, w_out)
    if not need_ctx_out:
        return y_lat, None
    na_c = context_attention(nh(pc['na_q']), nh(pc['na_k']), nh(pc['na_v']))
    y_ctx = gated_merge((na_c, hg_c, ml_c), pc['branch_gates'], w_branch, w_out)
    return y_lat, y_ctx


def swiglu(h, w_up, w_down):
    a, u = jnp.split(h @ w_up, 2, axis=-1)
    return (jax.nn.silu(a) * u) @ w_down


def moe_swiglu(h, w_router, w_up, w_down):
    B, T, D = h.shape
    x = h.reshape(B * T, D)
    n_assign = B * T * TOP_K
    logits = jnp.einsum('nd,de->ne', x, w_router, preferred_element_type=F32)
    top_v, top_e = lax.top_k(logits, TOP_K)
    top_w = jax.nn.softmax(top_v, axis=-1)
    flat_e = top_e.reshape(-1)
    flat_tok = jnp.arange(n_assign, dtype=jnp.int32) // TOP_K
    flat_w = top_w.reshape(-1)
    order = jnp.argsort(flat_e)
    e_sorted = flat_e[order]
    counts = jnp.bincount(flat_e, length=N_EXPERTS)
    padded = (counts + MOE_BLOCK - 1) // MOE_BLOCK * MOE_BLOCK
    pad_end = jnp.cumsum(padded)
    pad_start = pad_end - padded
    grp_start = jnp.cumsum(counts) - counts
    dest = pad_start[e_sorted] + jnp.arange(n_assign) - grp_start[e_sorted]
    n_blocks = -(-(n_assign + N_EXPERTS * (MOE_BLOCK - 1)) // MOE_BLOCK)
    n_slots = n_blocks * MOE_BLOCK
    slot_tok = jnp.zeros((n_slots,), jnp.int32).at[dest].set(flat_tok[order])
    slot_w = jnp.zeros((n_slots,), F32).at[dest].set(flat_w[order])
    block_e = jnp.minimum(jnp.searchsorted(pad_end, jnp.arange(n_blocks) * MOE_BLOCK, side='right'), N_EXPERTS - 1)

    def block_fn(args):
        tok, w, e = args
        a, u = jnp.split(x[tok] @ w_up[e], 2, axis=-1)
        return ((jax.nn.silu(a) * u) @ w_down[e]) * w[:, None].astype(x.dtype)

    y = lax.map(block_fn, (slot_tok.reshape(n_blocks, MOE_BLOCK), slot_w.reshape(n_blocks, MOE_BLOCK), block_e))
    out = jnp.zeros_like(x).at[slot_tok].add(y.reshape(n_slots, D))
    return out.reshape(B, T, D)


def setup_inputs(seed: int = 0) -> dict:
    key = jax.random.key(seed)
    ks = jax.random.split(key, 24)
    D = D_MODEL
    n_dense = (DEPTH + 1) // 2
    n_moe = DEPTH // 2
    nrm = lambda k, shape, s: jax.random.normal(k, shape, F32) * s
    return {
        'x': nrm(ks[0], (BATCH, SEQ, D), 1.0),
        'c': nrm(ks[1], (BATCH, D), 1.0),
        'ctx': nrm(ks[2], (BATCH, CTX_LEN, D), 1.0),
        'c_ctx': nrm(ks[3], (D,), 1.0),
        'mod_w': nrm(ks[4], (DEPTH, D, 6 * D), 0.5 * D ** -0.5),
        'mod_b': nrm(ks[5], (DEPTH, 6 * D), 0.02),
        'norm1_w': 1.0 + nrm(ks[6], (DEPTH, D), 0.05),
        'w_in': nrm(ks[7], (DEPTH, D, IN_WIDTH), D ** -0.5),
        'na_rpb': nrm(ks[8], (DEPTH, NA_HEADS, 2 * NA_WIN_ROWS - 1, 2 * NA_WIN_COLS - 1), 0.1),
        'hg_lb': 1.0 + nrm(ks[9], (DEPTH, 2, HG_WIDTH), 0.5),
        'hg_norm_w': 1.0 + nrm(ks[10], (DEPTH, HG_WIDTH), 0.05),
        'ml_gate_b': nrm(ks[11], (DEPTH, 2, 2, ML_HEADS), 0.1) + jnp.array([0.0, 3.0], F32)[:, None],
        'ml_norm_w': 1.0 + nrm(ks[12], (DEPTH, ML_WIDTH), 0.05),
        'w_branch': nrm(ks[13], (DEPTH, N_BRANCH, BRANCH_WIDTH, D), BRANCH_WIDTH ** -0.5),
        'w_out': nrm(ks[14], (DEPTH, D, D), D ** -0.5),
        'norm2_w': 1.0 + nrm(ks[15], (DEPTH, D), 0.05),
        'ffn_w_up': nrm(ks[16], (n_dense, D, 2 * FFN_DIM), D ** -0.5),
        'ffn_w_down': nrm(ks[17], (n_dense, FFN_DIM, D), FFN_DIM ** -0.5),
        'moe_router': nrm(ks[18], (n_moe, D, N_EXPERTS), D ** -0.5),
        'moe_w_up': nrm(ks[19], (n_moe, N_EXPERTS, D, 2 * EXPERT_DIM), D ** -0.5),
        'moe_w_down': nrm(ks[20], (n_moe, N_EXPERTS, EXPERT_DIM, D), EXPERT_DIM ** -0.5),
        'final_norm_w': 1.0 + nrm(ks[21], (D,), 0.05),
    }


def reference(x, c, ctx, c_ctx, mod_w, mod_b, norm1_w, w_in, na_rpb, hg_lb, hg_norm_w, ml_gate_b, ml_norm_w,
              w_branch, w_out, norm2_w, ffn_w_up, ffn_w_down, moe_router, moe_w_up, moe_w_down, final_norm_w):
    B, S, D = x.shape
    t = jnp.arange(S, dtype=jnp.int32)
    rows_pos, cols_pos = t // GRID_W, t % GRID_W
    lb_p = jax.nn.softmax(hg_lb.astype(F32), axis=0)
    hg_lower = jnp.cumsum(lb_p, axis=0) - lb_p[0]
    h_lat, h_ctx = x, ctx
    for layer in range(DEPTH):
        last = layer == DEPTH - 1
        mod_lat = (jax.nn.silu(c) @ mod_w[layer] + mod_b[layer]).reshape(B, 1, 6, D)
        mod_ctx = (jax.nn.silu(c_ctx) @ mod_w[layer] + mod_b[layer]).reshape(1, 1, 6, D)
        a_lat = modulate(rms_norm(h_lat, norm1_w[layer]), mod_lat[:, :, 0], mod_lat[:, :, 1])
        a_ctx = modulate(rms_norm(h_ctx, norm1_w[layer]), mod_ctx[:, :, 0], mod_ctx[:, :, 1])
        y_lat, y_ctx = hybrid_mixer(a_lat, a_ctx, w_in[layer], na_rpb[layer], hg_lower[layer], hg_norm_w[layer],
                                    ml_gate_b[layer], ml_norm_w[layer], w_branch[layer], w_out[layer],
                                    rows_pos, cols_pos, not last)
        h_lat = h_lat + mod_lat[:, :, 2] * y_lat
        if not last:
            h_ctx = h_ctx + mod_ctx[:, :, 2] * y_ctx
        f_lat = modulate(rms_norm(h_lat, norm2_w[layer]), mod_lat[:, :, 3], mod_lat[:, :, 4])
        i = layer // 2
        if layer % 2 == 0:
            h_lat = h_lat + mod_lat[:, :, 5] * swiglu(f_lat, ffn_w_up[i], ffn_w_down[i])
        else:
            h_lat = h_lat + mod_lat[:, :, 5] * moe_swiglu(f_lat, moe_router[i], moe_w_up[i], moe_w_down[i])
        if not last:
            f_ctx = modulate(rms_norm(h_ctx, norm2_w[layer]), mod_ctx[:, :, 3], mod_ctx[:, :, 4])
            if layer % 2 == 0:
                h_ctx = h_ctx + mod_ctx[:, :, 5] * swiglu(f_ctx, ffn_w_up[i], ffn_w_down[i])
            else:
                h_ctx = h_ctx + mod_ctx[:, :, 5] * moe_swiglu(f_ctx, moe_router[i], moe_w_up[i], moe_w_down[i])
    return rms_norm(h_lat, final_norm_w)
```

```cpp
#define MK_ONE_LAUNCH 1
#include <hip/hip_runtime.h>
#include <cstdio>
#include <cstdint>

#define LAS __attribute__((address_space(3)))
typedef unsigned short bf16_t;
typedef short bf16x8 __attribute__((ext_vector_type(8)));
typedef short bf16x4 __attribute__((ext_vector_type(4)));
typedef float f32x4 __attribute__((ext_vector_type(4)));
typedef float f32x2 __attribute__((ext_vector_type(2)));
typedef unsigned u32x4 __attribute__((ext_vector_type(4)));
typedef unsigned u32x2 __attribute__((ext_vector_type(2)));

constexpr int NB = 4, SEQ = 4096, DM = 1024, NCTX = 256, DEPTH = 2;
constexpr int TT = NCTX + SEQ;
constexpr int MT = NB * TT;
constexpr int INW = 9232;
constexpr int NPROJ = 9216;
constexpr int C_NAQ = 0, C_NAK = 512, C_NAV = 1024, C_HGQ = 1536, C_HGF = 2048, C_HGI = 3072, C_HGG = 3584, C_MLQ = 4096, C_MLK = 4608, C_MLV = 5120, C_MLO = 5632, C_BG = 6144;
constexpr int FFN = 2816, EXD = 3584, NEXP = 8;
constexpr int NCH = TT / 64;
constexpr float EPS = 1e-6f;
constexpr int MAXSLOT = 34816;
constexpr int MAXRT = MAXSLOT / 256;

constexpr size_t MiB = 1u << 20;
constexpr size_t WS_CTL = 0;
constexpr size_t WS_MOD = 1 * MiB;
constexpr size_t WS_G16 = 2 * MiB;
constexpr size_t WS_ROUTE = 4 * MiB;
constexpr size_t WS_NST = 5 * MiB;
constexpr size_t WS_WIN = 7 * MiB;
constexpr size_t WS_WB = WS_WIN + 36 * MiB;
constexpr size_t WS_WO = WS_WB + 6 * MiB;
constexpr size_t WS_WUP = WS_WO + 4 * MiB;
constexpr size_t WS_WDN = WS_WUP + 11 * MiB;
constexpr size_t WS_MUP = WS_WDN + 6 * MiB;
constexpr size_t WS_MDN = WS_MUP + 112 * MiB;
constexpr size_t WS_H = WS_MDN + 56 * MiB;
constexpr size_t WS_A1 = WS_H + 68 * MiB;
constexpr size_t WS_PROJ = WS_A1 + 34 * MiB;
constexpr size_t WS_BR = WS_PROJ + 306 * MiB;
constexpr size_t WS_Y = WS_BR + 51 * MiB;
constexpr size_t WS_SP = WS_Y + 34 * MiB;
constexpr size_t WS_END = WS_SP + 136 * MiB;
constexpr size_t WS_HMID = WS_PROJ;
constexpr size_t WS_XG = WS_SP;
constexpr size_t WS_YM = WS_BR;
static_assert(WS_END <= 896 * MiB, "workspace map exceeds the guaranteed size");
static_assert((size_t)MAXSLOT * EXD * 2 <= 306 * MiB && (size_t)MAXSLOT * 1024 * 2 <= 85 * MiB && (size_t)MAXSLOT * 1024 * 2 <= 136 * MiB, "overlays");

constexpr int RT_TOKE = 0;
constexpr int RT_TOKW = 32768;
constexpr int RT_TOKS = 65536;
constexpr int RT_TILE = 98304;
constexpr int RT_NT = 98304 + 2 * 144;
constexpr int CW_CNT = 64;
constexpr int CW_CUR = 128;
constexpr int CW_BAR = 4096;

__device__ __forceinline__ unsigned f2bf(float f) { unsigned u = __builtin_bit_cast(unsigned, f); return (u + 0x7fffu + ((u >> 16) & 1u)) >> 16; }
__device__ __forceinline__ unsigned pk2(float lo, float hi) { return f2bf(lo) | (f2bf(hi) << 16); }
__device__ __forceinline__ float bf2f(unsigned short b) { return __builtin_bit_cast(float, (unsigned)b << 16); }
__device__ __forceinline__ float bflo(unsigned w) { return __builtin_bit_cast(float, w << 16); }
__device__ __forceinline__ float bfhi(unsigned w) { return __builtin_bit_cast(float, w & 0xffff0000u); }
__device__ __forceinline__ float fast_exp(float x) { return __builtin_amdgcn_exp2f(x * 1.4426950408889634f); }
__device__ __forceinline__ float fast_rcp(float x) { return __builtin_amdgcn_rcpf(x); }
__device__ __forceinline__ float sigmoidf_(float x) { return fast_rcp(1.0f + fast_exp(-x)); }
__device__ __forceinline__ float siluf_(float x) { return x * sigmoidf_(x); }
__device__ __forceinline__ float wave_sum(float v) {
#pragma unroll
    for (int o = 1; o < 64; o <<= 1) v += __shfl_xor(v, o);
    return v;
}
#define LDS_WAIT() asm volatile("s_waitcnt lgkmcnt(0)" ::: "memory")
#define VM_WAIT() asm volatile("s_waitcnt vmcnt(0)" ::: "memory")

namespace pg8 {
constexpr int BM = 256, BK = 64, HALF = 128, HTB = HALF * BK * 2, STAGE_BYTES = 8 * HTB, NXCD = 8, WGM = 8;
__host__ __device__ __forceinline__ int lds_byte(int r, int c) { const int st = (r >> 4) * 2 + (c >> 5), rr = r & 15, cc = c & 31, ob = rr * 64 + cc * 2; return st * 1024 + (ob ^ (((ob >> 9) & 1) << 5)); }
__host__ __device__ __forceinline__ void stage_rc(int b, int& R, int& C) { const int st = b / 1024, sb = b % 1024, swz = sb ^ (((sb >> 9) & 1) << 5); R = (st >> 1) * 16 + swz / 64; C = (st & 1) * 32 + (swz % 64) / 2; }
__host__ __device__ __forceinline__ int perm32(int rho) { const int n = rho >> 4, i = rho & 15; return 8 * (i >> 2) + 4 * n + (i & 3); }

struct Unit { int pm, pn, aux; };

__device__ __forceinline__ bool static_tile(long L, int nM, int nN, int& pm, int& pn) {
    const int nwg = nM * nN; if (L >= nwg) return false;
    int wgid = (int)L; { const int q = nwg / NXCD, r = nwg % NXCD, xcd = wgid % NXCD, off = wgid / NXCD; wgid = (xcd < r ? xcd * (q + 1) : r * (q + 1) + (xcd - r) * q) + off; }
    const int nig = WGM * nN, gid = wgid / nig, fm = gid * WGM, gsz = (nM - fm) < WGM ? (nM - fm) : WGM;
    pm = fm + ((wgid % nig) % gsz); pn = (wgid % nig) / gsz; return true;
}
struct StaticOrder {
    const char* A; const char* Bt; size_t tstepA, tstepB; int nM, nN, G, c, skip_ctx;
    __device__ __forceinline__ bool next(int i, Unit& u) const {
        int pm, pn; if (!static_tile((long)i * G + c, nM, nN, pm, pn)) return false;
        u.pm = skip_ctx ? pm + pm / 16 + 1 : pm; u.pn = pn; u.aux = 0; return true; }
    __device__ __forceinline__ const char* Aptr(const Unit& u) const { return A + (size_t)u.pm * tstepA; }
    __device__ __forceinline__ const char* Bptr(const Unit& u) const { return Bt + (size_t)u.pn * tstepB; }
};
struct MergeOrder {
    const char* A; const char* Bt; size_t tstepA, tstepB; int nM, nN, G, c, skip_ctx;
    __device__ __forceinline__ bool next(int i, Unit& u) const {
        int pm, pn; if (!static_tile((long)(i / 3) * G + c, nM, nN, pm, pn)) return false;
        u.pm = skip_ctx ? pm + pm / 16 + 1 : pm; u.pn = pn; u.aux = i % 3; return true; }
    __device__ __forceinline__ const char* Aptr(const Unit& u) const { return A + (size_t)u.pm * tstepA + (size_t)u.aux * 1024; }
    __device__ __forceinline__ const char* Bptr(const Unit& u) const { return Bt + (size_t)u.pn * tstepB + (size_t)u.aux * 1024; }
};
struct MoeOrder {
    const char* A; const char* Bt; size_t rowbytesA, tstepB, estepB; const int* tiles; int nM, nN, G, c;
    __device__ __forceinline__ bool next(int i, Unit& u) const {
        int pm, pn; if (!static_tile((long)i * G + c, nM, nN, pm, pn)) return false;
        u.pm = tiles[2 * pm + 1] >> 8; u.pn = pn; u.aux = tiles[2 * pm]; return true; }
    __device__ __forceinline__ const char* Aptr(const Unit& u) const { return A + (size_t)u.pm * 256 * rowbytesA; }
    __device__ __forceinline__ const char* Bptr(const Unit& u) const { return Bt + (size_t)u.aux * estepB + (size_t)u.pn * tstepB; }
};

__device__ __forceinline__ unsigned cvt_pk_bf16(float lo, float hi) { unsigned r; asm volatile("v_cvt_pk_bf16_f32 %0, %1, %2" : "=v"(r) : "v"(lo), "v"(hi)); return r; }

typedef f32x4 Acc[2][2][4][2];
__device__ __forceinline__ void zero_acc(Acc& acc) {
#pragma unroll
    for (int a = 0; a < 2; ++a)
#pragma unroll
        for (int b = 0; b < 2; ++b)
#pragma unroll
            for (int m = 0; m < 4; ++m)
#pragma unroll
                for (int n = 0; n < 2; ++n) acc[a][b][m][n] = (f32x4){0.f, 0.f, 0.f, 0.f};
}

template <class Epi, class Sched>
__device__ __forceinline__ void gemm_phase(LAS unsigned char* lds, const int tid, const int K, const int lda, const int ldb, const Sched& S, const Epi& E) {
    const int wid = __builtin_amdgcn_readfirstlane(tid >> 6), lane = tid & 63, wr = wid >> 2, wc = wid & 3, fr = lane & 15, fq = lane >> 4;
    const int nt = K / BK;
    unsigned voffA[2], voffB[2];
#pragma unroll
    for (int i = 0; i < 2; ++i) { int R, C; stage_rc(tid * 16 + i * 8192, R, C); const int Rb = Epi::PERM ? ((R & ~31) + perm32(R & 31)) : R;
        voffA[i] = (unsigned)(R * lda + C) * 2u; voffB[i] = (unsigned)(Rb * ldb + C) * 2u; }
    const size_t kstep = (size_t)(BK * 2);
    const size_t hstepA = (size_t)HALF * lda * 2, hstepB = (size_t)HALF * ldb * 2;
    const unsigned ldsw = (unsigned)wid * 1024u;
    const int aoff = lds_byte(wr * 64 + fr, fq * 8), boff = lds_byte(wc * 32 + fr, fq * 8);
#define PG8_SA(b, h) (((b) * 2 + (h)) * HTB)
#define PG8_SB(b, h) ((4 + (b) * 2 + (h)) * HTB)
#define PG8_STAGE(bufoff, gbase, voff) do { _Pragma("unroll") for (int _i = 0; _i < 2; ++_i) \
        __builtin_amdgcn_global_load_lds((const unsigned*)((const char*)(gbase) + (voff)[_i]), (LAS unsigned*)(lds + (bufoff) + ldsw + _i * 8192), 16, 0, 0); } while (0)
#define PG8_LDA(dst, b, h) do { _Pragma("unroll") for (int m = 0; m < 4; ++m) _Pragma("unroll") for (int k = 0; k < 2; ++k) dst[m][k] = *(const LAS bf16x8*)(lds + PG8_SA(b, h) + aoff + m * 2048 + k * 1024); } while (0)
#define PG8_LDB(dst, b, h) do { _Pragma("unroll") for (int n = 0; n < 2; ++n) _Pragma("unroll") for (int k = 0; k < 2; ++k) dst[n][k] = *(const LAS bf16x8*)(lds + PG8_SB(b, h) + boff + n * 2048 + k * 1024); } while (0)
#define PG8_MMA(ai, bj, At, Bt) do { __builtin_amdgcn_s_setprio(1); _Pragma("unroll") for (int m = 0; m < 4; ++m) _Pragma("unroll") for (int n = 0; n < 2; ++n) _Pragma("unroll") for (int k = 0; k < 2; ++k) \
        acc[ai][bj][m][n] = __builtin_amdgcn_mfma_f32_16x16x32_bf16(Bt[n][k], At[m][k], acc[ai][bj][m][n], 0, 0, 0); __builtin_amdgcn_s_setprio(0); } while (0)
#define PG8_WAIT_V(n) asm volatile("s_waitcnt vmcnt(" #n ")" ::: "memory")
#define PG8_WAIT_L(n) asm volatile("s_waitcnt lgkmcnt(" #n ")" ::: "memory")
#define PG8_BAR __builtin_amdgcn_s_barrier()
#define PG8_SCHED __builtin_amdgcn_sched_barrier(0)
    Unit cur, nxt; int ui = 0;
    if (!S.next(0, cur)) return;
    Acc acc; zero_acc(acc);
    bf16x8 At[4][2], B0[2][2], B1[2][2];
    const char* cA = S.Aptr(cur); const char* cB = S.Bptr(cur);
    PG8_STAGE(PG8_SB(0, 0), cB, voffB); PG8_STAGE(PG8_SB(0, 1), cB + hstepB, voffB); PG8_STAGE(PG8_SA(0, 0), cA, voffA); PG8_STAGE(PG8_SA(0, 1), cA + hstepA, voffA);
    if (wr == 1) PG8_BAR;
    PG8_WAIT_V(2); PG8_BAR;
    PG8_STAGE(PG8_SB(1, 0), cB + kstep, voffB); PG8_STAGE(PG8_SA(1, 0), cA + kstep, voffA); PG8_STAGE(PG8_SB(1, 1), cB + hstepB + kstep, voffB);
    PG8_WAIT_V(6); PG8_BAR;
    for (;;) {
        const bool has_next = S.next(ui + 1, nxt);
        const char* nA = has_next ? S.Aptr(nxt) : cA; const char* nB = has_next ? S.Bptr(nxt) : cB;
        for (int t = 0; t < nt; t += 2) {
            const bool last = (t == nt - 2);
            const char* a1 = cA + (size_t)(t + 1) * kstep;
            const char* a2 = last ? nA : cA + (size_t)(t + 2) * kstep; const char* b2 = last ? nB : cB + (size_t)(t + 2) * kstep;
            const char* a3 = a2 + kstep; const char* b3 = b2 + kstep;
            PG8_LDB(B0, 0, 0); PG8_LDB(B1, 0, 1); PG8_SCHED; PG8_LDA(At, 0, 0); PG8_STAGE(PG8_SA(1, 1), a1 + hstepA, voffA);
            PG8_WAIT_V(8); PG8_WAIT_L(0); PG8_BAR; PG8_MMA(0, 0, At, B0); PG8_MMA(0, 1, At, B1); PG8_BAR; PG8_SCHED;
            PG8_LDA(At, 0, 1); PG8_STAGE(PG8_SB(0, 0), b2, voffB); PG8_STAGE(PG8_SB(0, 1), b2 + hstepB, voffB); PG8_STAGE(PG8_SA(0, 0), a2, voffA);
            PG8_WAIT_V(8); PG8_WAIT_L(0); PG8_BAR; PG8_MMA(1, 0, At, B0); PG8_MMA(1, 1, At, B1); PG8_BAR; PG8_SCHED;
            PG8_LDB(B0, 1, 0); PG8_LDB(B1, 1, 1); PG8_SCHED; PG8_LDA(At, 1, 0); PG8_STAGE(PG8_SA(0, 1), a2 + hstepA, voffA);
            PG8_WAIT_V(8); PG8_WAIT_L(0); PG8_BAR; PG8_MMA(0, 0, At, B0); PG8_MMA(0, 1, At, B1); PG8_BAR; PG8_SCHED;
            PG8_LDA(At, 1, 1); PG8_STAGE(PG8_SB(1, 0), b3, voffB); PG8_STAGE(PG8_SB(1, 1), b3 + hstepB, voffB); PG8_STAGE(PG8_SA(1, 0), a3, voffA);
            PG8_WAIT_V(8); PG8_WAIT_L(0); PG8_BAR; PG8_MMA(1, 0, At, B0); PG8_MMA(1, 1, At, B1); PG8_BAR; PG8_SCHED;
        }
        if (wr == 0) PG8_BAR;
        E(acc, cur, wr, wc, fr, fq);
        if (!has_next) break;
        cur = nxt; cA = nA; cB = nB; ++ui;
        if (wr == 1) PG8_BAR;
    }
    PG8_WAIT_V(0);
    PG8_BAR;
#undef PG8_SA
#undef PG8_SB
#undef PG8_STAGE
#undef PG8_LDA
#undef PG8_LDB
#undef PG8_MMA
#undef PG8_WAIT_V
#undef PG8_WAIT_L
#undef PG8_BAR
#undef PG8_SCHED
}
}
namespace pg8 {
struct EpiStoreBf16 {
    static constexpr bool PERM = true;
    bf16_t* O; int ldc;
    __device__ __forceinline__ void operator()(Acc& acc, const Unit& u, int wr, int wc, int fr, int fq) const {
        const int row0 = u.pm * BM + wr * 64 + fr, col0 = u.pn * BM + wc * 32 + 8 * fq;
#pragma unroll
        for (int ai = 0; ai < 2; ++ai)
#pragma unroll
            for (int m = 0; m < 4; ++m) { bf16_t* rowp = O + (size_t)(row0 + ai * HALF + m * 16) * ldc + col0;
#pragma unroll
                for (int bj = 0; bj < 2; ++bj) { const f32x4 v0 = acc[ai][bj][m][0], v1 = acc[ai][bj][m][1];
                    u32x4 w; w.x = cvt_pk_bf16(v0[0], v0[1]); w.y = cvt_pk_bf16(v0[2], v0[3]); w.z = cvt_pk_bf16(v1[0], v1[1]); w.w = cvt_pk_bf16(v1[2], v1[3]);
                    *(u32x4*)(rowp + bj * HALF) = w; } }
        zero_acc(acc);
    }
};
struct EpiSwiGLU {
    static constexpr bool PERM = true;
    bf16_t* O; int ldc;
    __device__ __forceinline__ void operator()(Acc& acc, const Unit& u, int wr, int wc, int fr, int fq) const {
        const int row0 = u.pm * BM + wr * 64 + fr, col0 = u.pn * HALF + wc * 32 + 8 * fq;
#pragma unroll
        for (int ai = 0; ai < 2; ++ai)
#pragma unroll
            for (int m = 0; m < 4; ++m) { bf16_t* rowp = O + (size_t)(row0 + ai * HALF + m * 16) * ldc + col0;
                float h[8];
#pragma unroll
                for (int n = 0; n < 2; ++n)
#pragma unroll
                    for (int j = 0; j < 4; ++j) { const float a = acc[ai][0][m][n][j], g = acc[ai][1][m][n][j]; h[4 * n + j] = a * fast_rcp(1.0f + fast_exp(-a)) * g; }
                u32x4 w; w.x = cvt_pk_bf16(h[0], h[1]); w.y = cvt_pk_bf16(h[2], h[3]); w.z = cvt_pk_bf16(h[4], h[5]); w.w = cvt_pk_bf16(h[6], h[7]);
                *(u32x4*)rowp = w; }
        zero_acc(acc);
    }
};
struct EpiResid {
    static constexpr bool PERM = false;
    float* H; const float* mod;
    __device__ __forceinline__ void operator()(Acc& acc, const Unit& u, int wr, int wc, int fr, int fq) const {
        const int row0 = u.pm * BM + wr * 64 + fr, col0 = u.pn * BM + wc * 32 + 4 * fq;
        const int r = (u.pm % 17 == 0) ? 4 : u.pm / 17;
        const float* mp = mod + (size_t)r * 6144 + col0;
        f32x4 mv[2][2];
#pragma unroll
        for (int bj = 0; bj < 2; ++bj)
#pragma unroll
            for (int n = 0; n < 2; ++n) mv[bj][n] = *(const f32x4*)(mp + bj * HALF + n * 16);
#pragma unroll
        for (int ai = 0; ai < 2; ++ai)
#pragma unroll
            for (int m = 0; m < 4; ++m) { float* rowp = H + (size_t)(row0 + ai * HALF + m * 16) * DM + col0;
#pragma unroll
                for (int bj = 0; bj < 2; ++bj)
#pragma unroll
                    for (int n = 0; n < 2; ++n) { f32x4* p = (f32x4*)(rowp + bj * HALF + n * 16); *p = *p + mv[bj][n] * acc[ai][bj][m][n]; }
                asm volatile("" ::: "memory"); }
        zero_acc(acc);
    }
};
struct EpiMerge {
    static constexpr bool PERM = true;
    const bf16_t* P; bf16_t* Y;
    __device__ __forceinline__ void operator()(Acc& acc, const Unit& u, int wr, int wc, int fr, int fq) const {
        const int row0 = u.pm * BM + wr * 64 + fr, col0 = u.pn * BM + wc * 32 + 8 * fq, seg = u.aux;
#pragma unroll
        for (int ai = 0; ai < 2; ++ai)
#pragma unroll
            for (int m = 0; m < 4; ++m) { const size_t row = (size_t)(row0 + ai * HALF + m * 16);
                const bf16_t* gp = P + row * NPROJ + C_BG + seg * 1024 + col0;
#pragma unroll
                for (int bj = 0; bj < 2; ++bj) {
                    const u32x4 xd = *(const u32x4*)(gp + bj * HALF);
                    u32x4 xn = xd; if (seg < 2) xn = *(const u32x4*)(gp + 1024 + bj * HALF);
                    float f[8];
#pragma unroll
                    for (int q = 0; q < 4; ++q) {
                        const float d0 = 1.0f + fast_exp(-bflo(xd[q])), d1 = 1.0f + fast_exp(-bfhi(xd[q]));
                        const float n0 = seg < 2 ? 1.0f + fast_exp(-bflo(xn[q])) : 1.0f, n1 = seg < 2 ? 1.0f + fast_exp(-bfhi(xn[q])) : 1.0f;
                        f[2 * q] = n0 * fast_rcp(d0); f[2 * q + 1] = n1 * fast_rcp(d1); }
                    f32x4 v0 = acc[ai][bj][m][0], v1 = acc[ai][bj][m][1];
                    v0 = v0 * (f32x4){f[0], f[1], f[2], f[3]}; v1 = v1 * (f32x4){f[4], f[5], f[6], f[7]};
                    if (seg == 2) {
                        u32x4 w; w.x = cvt_pk_bf16(v0[0], v0[1]); w.y = cvt_pk_bf16(v0[2], v0[3]); w.z = cvt_pk_bf16(v1[0], v1[1]); w.w = cvt_pk_bf16(v1[2], v1[3]);
                        *(u32x4*)(Y + row * DM + col0 + bj * HALF) = w;
                        v0 = (f32x4){0.f, 0.f, 0.f, 0.f}; v1 = v0; }
                    acc[ai][bj][m][0] = v0; acc[ai][bj][m][1] = v1; } }
    }
};
}
constexpr int NWAVES = 8;
constexpr int LDS_BYTES = 147456;
constexpr int LDSCTL_OFF = 139264;

struct Args { const float* in[22]; float* out; unsigned char* ws; int ph_lo, ph_hi; };
enum { I_X = 0, I_C, I_CTX, I_CCTX, I_MODW, I_MODB, I_N1W, I_WIN, I_RPB, I_HGLB, I_HGNW, I_MLGB, I_MLNW, I_WBR, I_WOUT, I_N2W, I_FUP, I_FDN, I_ROUT, I_MUP, I_MDN, I_FNW };

struct Frame {
    LAS unsigned char* lds;
    volatile LAS unsigned* MISC;
    unsigned* ctl;
    unsigned char* ws;
    const float* const* in;
    float* out;
    int tid, lane, wave, G, bid;
};

#define XB_TMO      128
#define XB_XCNT(j)  (256  + 64 * (j))
#define XB_XSUB(j)  (1280 + 64 * (j))
#define XB_XGEN(j)  (2304 + 64 * (j))
#define XB_TOP      3328
#define XB_TOPGEN   3392
#define XCD_BAR_WORDS 3456
#define XB_SPIN_CAP (1u << 22)
__device__ __forceinline__ unsigned xb_ld(unsigned* p)              { return __hip_atomic_load(p, __ATOMIC_RELAXED, __HIP_MEMORY_SCOPE_AGENT); }
__device__ __forceinline__ unsigned xb_add(unsigned* p, unsigned v) { return __hip_atomic_fetch_add(p, v, __ATOMIC_RELAXED, __HIP_MEMORY_SCOPE_AGENT); }
__device__ __forceinline__ unsigned xb_xcc_id() { return (unsigned)__builtin_amdgcn_s_getreg((3 << 11) | 20) & 0xFu; }
#define XB_SPIN(cond, bar) do { unsigned _sp = 0; while (cond) { __builtin_amdgcn_s_sleep(1); \
    if ((++_sp & 255u) == 0u) { if (xb_ld(&(bar)[XB_TMO])) break; if (_sp > XB_SPIN_CAP) { atomicAdd(&(bar)[XB_TMO], 1u); break; } } } } while (0)
struct XcdBarrier { unsigned* bar; unsigned x; volatile LAS unsigned* st; };
__device__ __forceinline__ XcdBarrier xcd_barrier_post(unsigned* bar, volatile LAS unsigned* st) {
    XcdBarrier b; b.bar = bar; b.x = xb_xcc_id(); b.st = st;
    if (threadIdx.x == 0) (void)xb_add(&bar[XB_XCNT(b.x)], 1u);
    return b;
}
__device__ __forceinline__ void xcd_barrier_complete(unsigned* bar, unsigned x, unsigned& nloc, unsigned& nx) {
    const unsigned G = gridDim.x * gridDim.y * gridDim.z;
    unsigned sum, cnt, mine, sp = 0u;
    for (;;) {
        sum = 0u; cnt = 0u; mine = 0u;
#pragma unroll
        for (unsigned j = 0; j < 16; ++j) { const unsigned c = xb_ld(&bar[XB_XCNT(j)]); sum += c; cnt += (c > 0u) ? 1u : 0u; mine = (j == x) ? c : mine; }
        if (sum == G) break;
        __builtin_amdgcn_s_sleep(1);
        if ((++sp & 255u) == 0u) { if (xb_ld(&bar[XB_TMO])) break; if (sp > XB_SPIN_CAP) { atomicAdd(&bar[XB_TMO], 1u); break; } }
    }
    nloc = mine > 0u ? mine : 1u; nx = cnt > 0u ? cnt : 1u;
}
__device__ __forceinline__ void xcd_barrier(const XcdBarrier& b) {
    asm volatile("s_waitcnt vmcnt(0)" ::: "memory");
    __syncthreads();
    if (threadIdx.x == 0) {
        unsigned* bar = b.bar;
        __builtin_amdgcn_s_waitcnt(0);
        unsigned nloc = b.st[0], nx = b.st[1];
        if (nloc == 0u) { xcd_barrier_complete(bar, b.x, nloc, nx); b.st[0] = nloc; b.st[1] = nx; }
        const unsigned old = xb_add(&bar[XB_XSUB(b.x)], 1u);
        const unsigned gen = old / nloc;
        if (old + 1u == (gen + 1u) * nloc) {
            __builtin_amdgcn_fence(__ATOMIC_RELEASE, "agent");
            asm volatile("s_waitcnt vmcnt(0)" ::: "memory");
            const unsigned og = xb_add(&bar[XB_TOP], 1u);
            const unsigned tg = og / nx;
            if (og + 1u == (tg + 1u) * nx) xb_add(&bar[XB_TOPGEN], 1u);
            else XB_SPIN(xb_ld(&bar[XB_TOPGEN]) == tg, bar);
            __builtin_amdgcn_fence(__ATOMIC_ACQUIRE, "agent");
            xb_add(&bar[XB_XGEN(b.x)], 1u);
            asm volatile("s_waitcnt vmcnt(0)" ::: "memory");
        } else {
            XB_SPIN(xb_ld(&bar[XB_XGEN(b.x)]) == gen, bar);
            __builtin_amdgcn_fence(__ATOMIC_ACQUIRE, "agent");
            asm volatile("s_waitcnt vmcnt(0)" ::: "memory");
        }
    }
    __syncthreads();
}

__device__ __forceinline__ void xpose_item(const float* W, int ldw, bf16_t* WT, int ldd, LAS float* scr, int lane) {
#pragma unroll 8
    for (int i = 0; i < 32; ++i) { const int kk = 2 * i + (lane >> 5); scr[kk * 33 + (lane & 31)] = W[(size_t)kk * ldw + (lane & 31)]; }
    LDS_WAIT(); asm volatile("" ::: "memory");
    const int c = lane & 7;
#pragma unroll
    for (int j = 0; j < 4; ++j) { const int n = (lane >> 3) + 8 * j; const LAS float* s = scr + (8 * c) * 33 + n;
        u32x4 o; o.x = pk2(s[0 * 33], s[1 * 33]); o.y = pk2(s[2 * 33], s[3 * 33]); o.z = pk2(s[4 * 33], s[5 * 33]); o.w = pk2(s[6 * 33], s[7 * 33]);
        *(u32x4*)(WT + (size_t)n * ldd + 8 * c) = o; }
    LDS_WAIT(); asm volatile("" ::: "memory");
}
__device__ __forceinline__ bool xpose_mat(int& r, const float* W, int ldw, int K, int N, bf16_t* WT, int ldd, int pairF, LAS float* scr, int lane) {
    const int nblk = N / 32, items = (K / 64) * nblk;
    if (r >= items) { r -= items; return false; }
    const int kb = r / nblk, nb = r % nblk, k0 = 64 * kb, n0 = 32 * nb;
    int drow = n0;
    if (pairF) { const int isu = n0 >= pairF, idx = isu ? n0 - pairF : n0; drow = (idx / 128) * 256 + isu * 128 + (idx % 128); }
    xpose_item(W + (size_t)k0 * ldw + n0, ldw, WT + (size_t)drow * ldd + k0, ldd, scr, lane);
    return true;
}
__device__ __forceinline__ void ph_prologue(Frame& F) {
    {
        LAS float* sv = (LAS float*)F.lds;
        LAS float* red = (LAS float*)(F.lds + 5 * 1024 * 4);
        float* MOD = (float*)(F.ws + WS_MOD);
        bool have = false;
        for (int it = F.bid; it < 2 * 96; it += F.G) {
            if (!have) { for (int i = F.tid; i < 5 * 1024; i += 512) { const float v = i < 4096 ? F.in[I_C][i] : F.in[I_CCTX][i - 4096]; sv[i] = siluf_(v); } have = true; __syncthreads(); }
            const int l = it / 96, j0 = (it % 96) * 64, ks = F.wave, cj = F.lane;
            const float* w = F.in[I_MODW] + (size_t)l * 1024 * 6144 + j0 + cj;
            float a0 = 0.f, a1 = 0.f, a2 = 0.f, a3 = 0.f, a4 = 0.f;
#pragma unroll 8
            for (int k = ks * 128; k < ks * 128 + 128; ++k) { const float wv = w[(size_t)k * 6144];
                a0 += sv[k] * wv; a1 += sv[1024 + k] * wv; a2 += sv[2048 + k] * wv; a3 += sv[3072 + k] * wv; a4 += sv[4096 + k] * wv; }
            red[(ks * 5 + 0) * 64 + cj] = a0; red[(ks * 5 + 1) * 64 + cj] = a1; red[(ks * 5 + 2) * 64 + cj] = a2; red[(ks * 5 + 3) * 64 + cj] = a3; red[(ks * 5 + 4) * 64 + cj] = a4;
            __syncthreads();
            if (F.tid < 320) { const int r = F.tid / 64, c = F.tid % 64; float s = 0.f;
#pragma unroll
                for (int q = 0; q < 8; ++q) s += red[(q * 5 + r) * 64 + c];
                MOD[(size_t)(l * 5 + r) * 6144 + j0 + c] = s + F.in[I_MODB][l * 6144 + j0 + c]; }
            __syncthreads();
        }
        __syncthreads();
    }
    LAS float* scr = (LAS float*)(F.lds + F.wave * 16384);
    const int gw = F.bid * NWAVES + F.wave, NGW = F.G * NWAVES;
    bf16_t* WIN = (bf16_t*)(F.ws + WS_WIN); bf16_t* WB = (bf16_t*)(F.ws + WS_WB); bf16_t* WO = (bf16_t*)(F.ws + WS_WO);
    bf16_t* WUP = (bf16_t*)(F.ws + WS_WUP); bf16_t* WDN = (bf16_t*)(F.ws + WS_WDN); bf16_t* MUP = (bf16_t*)(F.ws + WS_MUP); bf16_t* MDN = (bf16_t*)(F.ws + WS_MDN);
    constexpr int NITEMS = 59008;
    for (int it = gw; it < NITEMS; it += NGW) {
        int r = it; bool done = false;
        for (int e = 0; e < NEXP && !done; ++e) done = xpose_mat(r, F.in[I_MUP] + (size_t)e * 1024 * 7168, 7168, 1024, 7168, MUP + (size_t)e * 7168 * 1024, 1024, EXD, scr, F.lane);
        for (int e = 0; e < NEXP && !done; ++e) done = xpose_mat(r, F.in[I_MDN] + (size_t)e * EXD * 1024, 1024, EXD, 1024, MDN + (size_t)e * 1024 * EXD, EXD, 0, scr, F.lane);
        for (int l = 0; l < 2 && !done; ++l) {
            done = xpose_mat(r, F.in[I_WIN] + (size_t)l * 1024 * INW, INW, 1024, 6144, WIN + (size_t)l * NPROJ * 1024, 1024, 0, scr, F.lane);
            if (!done) done = xpose_mat(r, F.in[I_WIN] + (size_t)l * 1024 * INW + 6160, INW, 1024, 3072, WIN + (size_t)l * NPROJ * 1024 + (size_t)6144 * 1024, 1024, 0, scr, F.lane);
            for (int i = 0; i < 3 && !done; ++i) done = xpose_mat(r, F.in[I_WBR] + (size_t)(l * 3 + i) * 512 * 1024, 1024, 512, 1024, WB + (size_t)l * 1024 * 1536 + i * 512, 1536, 0, scr, F.lane);
            if (!done) done = xpose_mat(r, F.in[I_WOUT] + (size_t)l * 1024 * 1024, 1024, 1024, 1024, WO + (size_t)l * 1024 * 1024, 1024, 0, scr, F.lane);
        }
        if (!done) done = xpose_mat(r, F.in[I_FUP], 2 * FFN, 1024, 2 * FFN, WUP, 1024, FFN, scr, F.lane);
        if (!done) done = xpose_mat(r, F.in[I_FDN], 1024, FFN, 1024, WDN, FFN, 0, scr, F.lane);
    }
}

__device__ __forceinline__ const float* src_row(const Frame& F, int layer_first, int m) {
    if (!layer_first) return (const float*)(F.ws + WS_H) + (size_t)m * DM;
    const int b = m / TT, r = m % TT;
    return r < NCTX ? F.in[I_CTX] + ((size_t)b * NCTX + r) * DM : F.in[I_X] + ((size_t)b * SEQ + (r - NCTX)) * DM;
}
__device__ __forceinline__ void ph_norm1(Frame& F, int l) {
    LAS float* WG = (LAS float*)F.lds;
    for (int i = F.tid; i < 16384; i += 512) { const int k = i >> 4, g = i & 15; WG[g * 1024 + k] = F.in[I_WIN][(size_t)l * 1024 * INW + (size_t)k * INW + 6144 + g]; }
    __syncthreads();
    const int gw = F.bid * NWAVES + F.wave, NGW = F.G * NWAVES;
    const float* MOD = (const float*)(F.ws + WS_MOD) + (size_t)l * 5 * 6144;
    const float* nw = F.in[I_N1W] + l * DM;
    float* H = (float*)(F.ws + WS_H); bf16_t* A1 = (bf16_t*)(F.ws + WS_A1); float* G16 = (float*)(F.ws + WS_G16);
    for (int m = gw; m < MT; m += NGW) {
        const float* xr = src_row(F, l == 0, m);
        const int r = (m % TT) < NCTX ? 4 : m / TT;
        const float* sh = MOD + (size_t)r * 6144; const float* sc = sh + 1024;
        f32x4 v[4]; float ss = 0.f;
#pragma unroll
        for (int j = 0; j < 4; ++j) { v[j] = *(const f32x4*)(xr + 256 * j + 4 * F.lane); ss += (v[j].x * v[j].x + v[j].y * v[j].y) + (v[j].z * v[j].z + v[j].w * v[j].w); }
        if (l == 0) {
#pragma unroll
            for (int j = 0; j < 4; ++j) *(f32x4*)(H + (size_t)m * DM + 256 * j + 4 * F.lane) = v[j]; }
        const float rstd = 1.0f / sqrtf(wave_sum(ss) * (1.f / DM) + EPS);
        f32x4 av[4];
#pragma unroll
        for (int j = 0; j < 4; ++j) { const int k0 = 256 * j + 4 * F.lane;
            const f32x4 w4 = *(const f32x4*)(nw + k0), s4 = *(const f32x4*)(sh + k0), c4 = *(const f32x4*)(sc + k0);
            av[j] = (v[j] * rstd * w4) * (c4 + 1.0f) + s4;
            *(u32x2*)(A1 + (size_t)m * DM + k0) = (u32x2){pk2(av[j].x, av[j].y), pk2(av[j].z, av[j].w)}; }
        float mine = 0.f;
#pragma unroll 2
        for (int q = 0; q < 16; ++q) { float gq = 0.f;
#pragma unroll
            for (int j = 0; j < 4; ++j) { const f32x4 wg = *(const LAS f32x4*)(WG + q * 1024 + 256 * j + 4 * F.lane); gq += (av[j].x * wg.x + av[j].y * wg.y) + (av[j].z * wg.z + av[j].w * wg.w); }
            const float t = wave_sum(gq); mine = (F.lane == q) ? t : mine; }
        if (F.lane < 16) G16[(size_t)m * 16 + F.lane] = mine;
    }
}
__device__ __forceinline__ void ph_norm2(Frame& F, int l) {
    const int gw = F.bid * NWAVES + F.wave, NGW = F.G * NWAVES;
    const float* MOD = (const float*)(F.ws + WS_MOD) + (size_t)l * 5 * 6144;
    const float* nw = F.in[I_N2W] + l * DM;
    const float* H = (const float*)(F.ws + WS_H); bf16_t* A1 = (bf16_t*)(F.ws + WS_A1);
    if (l == 0) {
        for (int m = gw; m < MT; m += NGW) {
            const float* xr = H + (size_t)m * DM;
            const int r = (m % TT) < NCTX ? 4 : m / TT;
            const float* sh = MOD + (size_t)r * 6144 + 3 * 1024; const float* sc = sh + 1024;
            f32x4 v[4]; float ss = 0.f;
#pragma unroll
            for (int j = 0; j < 4; ++j) { v[j] = *(const f32x4*)(xr + 256 * j + 4 * F.lane); ss += (v[j].x * v[j].x + v[j].y * v[j].y) + (v[j].z * v[j].z + v[j].w * v[j].w); }
            const float rstd = 1.0f / sqrtf(wave_sum(ss) * (1.f / DM) + EPS);
#pragma unroll
            for (int j = 0; j < 4; ++j) { const int k0 = 256 * j + 4 * F.lane;
                const f32x4 w4 = *(const f32x4*)(nw + k0), s4 = *(const f32x4*)(sh + k0), c4 = *(const f32x4*)(sc + k0);
                const f32x4 a = (v[j] * rstd * w4) * (c4 + 1.0f) + s4;
                *(u32x2*)(A1 + (size_t)m * DM + k0) = (u32x2){pk2(a.x, a.y), pk2(a.z, a.w)}; }
        }
        return;
    }
    LAS float* WR = (LAS float*)F.lds;
    LAS unsigned* lcnt = (LAS unsigned*)(F.lds + 32768);
    for (int i = F.tid; i < 8192; i += 512) { const int k = i >> 3, e = i & 7; WR[e * 1024 + k] = F.in[I_ROUT][(size_t)k * 8 + e]; }
    if (F.tid < 16) lcnt[F.tid] = 0u;
    __syncthreads();
    int* TOKE = (int*)(F.ws + WS_ROUTE) + RT_TOKE; float* TOKW = (float*)(F.ws + WS_ROUTE) + RT_TOKW; int* TOKS = (int*)(F.ws + WS_ROUTE) + RT_TOKS;
    for (int n = gw; n < NB * SEQ; n += NGW) {
        const int b = n / SEQ, m = b * TT + NCTX + (n % SEQ);
        const float* xr = H + (size_t)m * DM;
        const float* sh = MOD + (size_t)b * 6144 + 3 * 1024; const float* sc = sh + 1024;
        f32x4 v[4]; float ss = 0.f;
#pragma unroll
        for (int j = 0; j < 4; ++j) { v[j] = *(const f32x4*)(xr + 256 * j + 4 * F.lane); ss += (v[j].x * v[j].x + v[j].y * v[j].y) + (v[j].z * v[j].z + v[j].w * v[j].w); }
        const float rstd = 1.0f / sqrtf(wave_sum(ss) * (1.f / DM) + EPS);
        float g[8];
#pragma unroll
        for (int q = 0; q < 8; ++q) g[q] = 0.f;
#pragma unroll
        for (int j = 0; j < 4; ++j) { const int k0 = 256 * j + 4 * F.lane;
            const f32x4 w4 = *(const f32x4*)(nw + k0), s4 = *(const f32x4*)(sh + k0), c4 = *(const f32x4*)(sc + k0);
            const f32x4 a = (v[j] * rstd * w4) * (c4 + 1.0f) + s4;
            *(u32x2*)(A1 + (size_t)m * DM + k0) = (u32x2){pk2(a.x, a.y), pk2(a.z, a.w)};
#pragma unroll
            for (int q = 0; q < 8; ++q) { const f32x4 wg = *(const LAS f32x4*)(WR + q * 1024 + k0); g[q] += (a.x * wg.x + a.y * wg.y) + (a.z * wg.z + a.w * wg.w); } }
#pragma unroll
        for (int q = 0; q < 8; ++q) g[q] = wave_sum(g[q]);
        int e1 = 0; float v1 = g[0];
#pragma unroll
        for (int q = 1; q < 8; ++q) if (g[q] > v1) { v1 = g[q]; e1 = q; }
        int e2 = -1; float v2 = -3.0e38f;
#pragma unroll
        for (int q = 0; q < 8; ++q) if (q != e1 && g[q] > v2) { v2 = g[q]; e2 = q; }
        if (F.lane < 2) {
            const float w1 = 1.0f / (1.0f + fast_exp(v2 - v1));
            const int e = F.lane ? e2 : e1;
            const unsigned pos = __hip_atomic_fetch_add(lcnt + e, 1u, __ATOMIC_RELAXED, __HIP_MEMORY_SCOPE_WORKGROUP);
            TOKE[2 * n + F.lane] = e; TOKW[2 * n + F.lane] = F.lane ? 1.0f - w1 : w1; TOKS[2 * n + F.lane] = (int)pos;
        }
    }
    __syncthreads();
    if (F.tid < 8) lcnt[8 + F.tid] = xb_add(F.ctl + CW_CNT + F.tid, lcnt[F.tid]);
    __syncthreads();
    VM_WAIT();
    for (int n = gw; n < NB * SEQ; n += NGW) {
        if (F.lane < 2) { const int e = TOKE[2 * n + F.lane]; TOKS[2 * n + F.lane] += (int)lcnt[8 + e]; }
    }
}
__device__ __forceinline__ void ph_moe_gather(Frame& F) {
    const int gw = F.bid * NWAVES + F.wave, NGW = F.G * NWAVES;
    int pstart[NEXP]; int acc = 0;
#pragma unroll
    for (int e = 0; e < NEXP; ++e) { const int c = (int)xb_ld(F.ctl + CW_CNT + e); pstart[e] = acc; acc += (c + 255) & ~255; }
    int* RT = (int*)(F.ws + WS_ROUTE);
    if (F.bid == 0 && F.tid == 0) {
        int nt = 0;
        for (int e = 0; e < NEXP; ++e) { const int c = (int)xb_ld(F.ctl + CW_CNT + e); for (int t = 0; t * 256 < c; ++t) { RT[RT_TILE + 2 * nt] = e; RT[RT_TILE + 2 * nt + 1] = pstart[e] + 256 * t; ++nt; } }
        RT[RT_NT] = nt;
    }
    const int* TOKE = RT + RT_TOKE; int* TOKS = RT + RT_TOKS;
    const bf16_t* A1 = (const bf16_t*)(F.ws + WS_A1); bf16_t* XG = (bf16_t*)(F.ws + WS_XG);
    for (int n = gw; n < NB * SEQ; n += NGW) {
        const int b = n / SEQ, m = b * TT + NCTX + (n % SEQ);
        const int e1 = TOKE[2 * n], e2 = TOKE[2 * n + 1];
        int s1 = TOKS[2 * n], s2 = TOKS[2 * n + 1];
        int p1 = 0, p2 = 0;
#pragma unroll
        for (int e = 0; e < NEXP; ++e) { p1 = (e == e1) ? pstart[e] : p1; p2 = (e == e2) ? pstart[e] : p2; }
        s1 += p1; s2 += p2;
        const u32x4* src = (const u32x4*)(A1 + (size_t)m * DM);
        const u32x4 a = src[F.lane], c = src[64 + F.lane];
        u32x4* d1 = (u32x4*)(XG + (size_t)s1 * DM); u32x4* d2 = (u32x4*)(XG + (size_t)s2 * DM);
        d1[F.lane] = a; d1[64 + F.lane] = c; d2[F.lane] = a; d2[64 + F.lane] = c;
        if (F.lane == 0) { TOKS[2 * n] = s1; TOKS[2 * n + 1] = s2; }
    }
}
__device__ __forceinline__ void ph_final(Frame& F) {
    const int gw = F.bid * NWAVES + F.wave, NGW = F.G * NWAVES;
    const float* MOD = (const float*)(F.ws + WS_MOD) + (size_t)1 * 5 * 6144;
    const float* H = (const float*)(F.ws + WS_H); const bf16_t* YM = (const bf16_t*)(F.ws + WS_YM);
    const int* RT = (const int*)(F.ws + WS_ROUTE); const float* TOKW = (const float*)(F.ws + WS_ROUTE) + RT_TOKW;
    const float* fw = F.in[I_FNW];
    for (int n = gw; n < NB * SEQ; n += NGW) {
        const int b = n / SEQ, m = b * TT + NCTX + (n % SEQ);
        const int s1 = RT[RT_TOKS + 2 * n], s2 = RT[RT_TOKS + 2 * n + 1]; const float w1 = TOKW[2 * n], w2 = TOKW[2 * n + 1];
        const float* g5 = MOD + (size_t)b * 6144 + 5 * 1024;
        f32x4 v[4]; float ss = 0.f;
#pragma unroll
        for (int j = 0; j < 4; ++j) { const int k0 = 256 * j + 4 * F.lane;
            const f32x4 h = *(const f32x4*)(H + (size_t)m * DM + k0), gg = *(const f32x4*)(g5 + k0);
            const u32x2 y1 = *(const u32x2*)(YM + (size_t)s1 * DM + k0), y2 = *(const u32x2*)(YM + (size_t)s2 * DM + k0);
            f32x4 y; y.x = w1 * bflo(y1.x) + w2 * bflo(y2.x); y.y = w1 * bfhi(y1.x) + w2 * bfhi(y2.x); y.z = w1 * bflo(y1.y) + w2 * bflo(y2.y); y.w = w1 * bfhi(y1.y) + w2 * bfhi(y2.y);
            v[j] = h + gg * y; ss += (v[j].x * v[j].x + v[j].y * v[j].y) + (v[j].z * v[j].z + v[j].w * v[j].w); }
        const float rstd = 1.0f / sqrtf(wave_sum(ss) * (1.f / DM) + EPS);
#pragma unroll
        for (int j = 0; j < 4; ++j) { const int k0 = 256 * j + 4 * F.lane; const f32x4 w4 = *(const f32x4*)(fw + k0);
            *(f32x4*)(F.out + (size_t)n * DM + k0) = v[j] * rstd * w4; }
    }
}
__device__ __forceinline__ int tokrow(int b, int dir, int P) { return b * TT + (dir == 0 ? P : (P < NCTX ? (NCTX - 1) - P : (TT + NCTX - 1) - P)); }
__device__ __forceinline__ int iclamp(int v, int lo, int hi) { return v < lo ? lo : (v > hi ? hi : v); }
__device__ __forceinline__ bf16x8 cat4(bf16x4 a, bf16x4 b) { return __builtin_shufflevector(a, b, 0, 1, 2, 3, 4, 5, 6, 7); }
__device__ __forceinline__ f32x4 mfma16(bf16x8 a, bf16x8 b, f32x4 c) { return __builtin_amdgcn_mfma_f32_16x16x32_bf16(a, b, c, 0, 0, 0); }
__device__ __forceinline__ float wave_scan_add(float v, int lane) {
#pragma unroll
    for (int o = 1; o < 64; o <<= 1) { const float t = __shfl_up(v, o); if (lane >= o) v += t; }
    return v;
}
__device__ __forceinline__ float wave_scan_max(float v, int lane) {
#pragma unroll
    for (int o = 1; o < 64; o <<= 1) { const float t = __shfl_up(v, o); if (lane >= o) v = fmaxf(v, t); }
    return v;
}
__device__ __forceinline__ float wave_max(float v) {
#pragma unroll
    for (int o = 1; o < 64; o <<= 1) v = fmaxf(v, __shfl_xor(v, o));
    return v;
}
__device__ __forceinline__ float logsigmoidf_(float x) { return fminf(x, 0.f) - __logf(1.0f + fast_exp(-fabsf(x))); }

constexpr int NA_VTC = 0, NA_VTL = 33792, NA_RPB = 108544;
template <bool LOCAL>
__device__ __forceinline__ void na_unit(Frame& F, int l, int b, int h, int sub) {
    const bf16_t* P = (const bf16_t*)(F.ws + WS_PROJ); bf16_t* BR = (bf16_t*)(F.ws + WS_BR);
    LAS bf16_t* VTC = (LAS bf16_t*)(F.lds + NA_VTC); LAS bf16_t* VTL = (LAS bf16_t*)(F.lds + NA_VTL); LAS float* RPB = (LAS float*)(F.lds + NA_RPB);
    int tid = F.tid; asm volatile("" : "+v"(tid));
    const int lane = tid & 63, w = F.wave, g = lane >> 4, c = lane & 15;
    const int ubase = LOCAL ? iclamp(2 * sub - 4, 0, 56) : 0;
    __syncthreads();
    {   const int c8 = tid & 7, kq = tid >> 3;
#pragma unroll
        for (int it = 0; it < 4; ++it) { const int key = kq + 64 * it;
            const u32x4 v = *(const u32x4*)(P + (size_t)(b * TT + key) * NPROJ + C_NAV + 64 * h + 8 * c8);
            LAS bf16_t* d = VTC + (8 * c8) * 264 + key;
            d[0 * 264] = (bf16_t)(v.x & 0xffff); d[1 * 264] = (bf16_t)(v.x >> 16); d[2 * 264] = (bf16_t)(v.y & 0xffff); d[3 * 264] = (bf16_t)(v.y >> 16);
            d[4 * 264] = (bf16_t)(v.z & 0xffff); d[5 * 264] = (bf16_t)(v.z >> 16); d[6 * 264] = (bf16_t)(v.w & 0xffff); d[7 * 264] = (bf16_t)(v.w >> 16); }
        if (LOCAL) {
            const int nrows = (64 - ubase) < 9 ? (64 - ubase) : 9;
            for (int it = 0; it < nrows; ++it) {
                const int mk = b * TT + NCTX + (ubase + it) * 64 + kq;
                const u32x4 v = *(const u32x4*)(P + (size_t)mk * NPROJ + C_NAV + 64 * h + 8 * c8);
                LAS bf16_t* d = VTL + (8 * c8) * 584 + it * 64 + kq;
                d[0 * 584] = (bf16_t)(v.x & 0xffff); d[1 * 584] = (bf16_t)(v.x >> 16); d[2 * 584] = (bf16_t)(v.y & 0xffff); d[3 * 584] = (bf16_t)(v.y >> 16);
                d[4 * 584] = (bf16_t)(v.z & 0xffff); d[5 * 584] = (bf16_t)(v.z >> 16); d[6 * 584] = (bf16_t)(v.w & 0xffff); d[7 * 584] = (bf16_t)(v.w >> 16); }
            if (tid < 465) RPB[tid] = F.in[I_RPB][(size_t)(l * 8 + h) * 465 + tid];
        }
    }
    __syncthreads();
    const int qrow = LOCAL ? 2 * sub + (w >> 2) : 0, cb = w & 3;
    const int r0 = iclamp(qrow - 4, 0, 56), bs = iclamp(16 * cb - 8, 0, 32);
    const int mq = LOCAL ? b * TT + NCTX + qrow * 64 + 16 * cb + c : b * TT + 128 * sub + 16 * w + c;
    bf16x8 qf[2];
    qf[0] = *(const bf16x8*)(P + (size_t)mq * NPROJ + C_NAQ + 64 * h + 8 * g);
    qf[1] = *(const bf16x8*)(P + (size_t)mq * NPROJ + C_NAQ + 64 * h + 32 + 8 * g);
    constexpr int NKB = LOCAL ? 32 : 16, LB = LOCAL ? 16 : 0;
    float s[NKB][4];
    if (LOCAL) {
        const int qc = 16 * cb + c, wst = iclamp(qc - 8, 0, 48);
#pragma unroll
        for (int kb = 0; kb < 16; ++kb) { const int wr = kb >> 1, hf = kb & 1;
            const int mk = b * TT + NCTX + (r0 + wr) * 64 + bs + 16 * hf + c;
            const bf16x8 a0 = *(const bf16x8*)(P + (size_t)mk * NPROJ + C_NAK + 64 * h + 8 * g), a1 = *(const bf16x8*)(P + (size_t)mk * NPROJ + C_NAK + 64 * h + 32 + 8 * g);
            f32x4 z = (f32x4){0.f, 0.f, 0.f, 0.f}; z = mfma16(a0, qf[0], z); z = mfma16(a1, qf[1], z);
            const int dr = r0 + wr - qrow + 7;
#pragma unroll
            for (int r = 0; r < 4; ++r) { const int kc = bs + 16 * hf + 4 * g + r; const bool valid = (kc >= wst) && (kc < wst + 16); const int dc = iclamp(kc - qc + 15, 0, 30);
                s[kb][r] = valid ? z[r] * 0.125f + RPB[dr * 31 + dc] : -1e30f; } }
    }
#pragma unroll
    for (int kb = 0; kb < 16; ++kb) {
        const int mk = b * TT + 16 * kb + c;
        const bf16x8 a0 = *(const bf16x8*)(P + (size_t)mk * NPROJ + C_NAK + 64 * h + 8 * g), a1 = *(const bf16x8*)(P + (size_t)mk * NPROJ + C_NAK + 64 * h + 32 + 8 * g);
        f32x4 z = (f32x4){0.f, 0.f, 0.f, 0.f}; z = mfma16(a0, qf[0], z); z = mfma16(a1, qf[1], z);
#pragma unroll
        for (int r = 0; r < 4; ++r) s[LB + kb][r] = z[r] * 0.125f; }
    float mx = -3.0e38f;
#pragma unroll
    for (int kb = 0; kb < NKB; ++kb)
#pragma unroll
        for (int r = 0; r < 4; ++r) mx = fmaxf(mx, s[kb][r]);
    mx = fmaxf(mx, __shfl_xor(mx, 16)); mx = fmaxf(mx, __shfl_xor(mx, 32));
    float sum = 0.f;
#pragma unroll
    for (int kb = 0; kb < NKB; ++kb)
#pragma unroll
        for (int r = 0; r < 4; ++r) { const float p = fast_exp(s[kb][r] - mx); s[kb][r] = p; sum += p; }
    sum += __shfl_xor(sum, 16); sum += __shfl_xor(sum, 32);
    f32x4 o[4];
#pragma unroll
    for (int mb = 0; mb < 4; ++mb) o[mb] = (f32x4){0.f, 0.f, 0.f, 0.f};
#pragma unroll
    for (int kp = 0; kp < NKB / 2; ++kp) {
        u32x4 pw; pw.x = pk2(s[2 * kp][0], s[2 * kp][1]); pw.y = pk2(s[2 * kp][2], s[2 * kp][3]); pw.z = pk2(s[2 * kp + 1][0], s[2 * kp + 1][1]); pw.w = pk2(s[2 * kp + 1][2], s[2 * kp + 1][3]);
        const bf16x8 pf = __builtin_bit_cast(bf16x8, pw);
#pragma unroll
        for (int mb = 0; mb < 4; ++mb) { const int dv = 16 * mb + c;
            const LAS bf16_t* base = (LOCAL && kp < 8) ? VTL + dv * 584 + (r0 + kp - ubase) * 64 + bs + 4 * g : VTC + dv * 264 + 32 * (kp - (LOCAL ? 8 : 0)) + 4 * g;
            const bf16x4 lo = *(const LAS bf16x4*)base, hi = *(const LAS bf16x4*)(base + 16);
            o[mb] = mfma16(cat4(lo, hi), pf, o[mb]); } }
    const float inv = 1.0f / sum;
#pragma unroll
    for (int mb = 0; mb < 4; ++mb)
        *(u32x2*)(BR + (size_t)mq * 1536 + 64 * h + 16 * mb + 4 * g) = (u32x2){pk2(o[mb][0] * inv, o[mb][1] * inv), pk2(o[mb][2] * inv, o[mb][3] * inv)};
}

__device__ __forceinline__ void load_rope16(const bf16_t* src, int c8, int rr  , float scale, float (&x)[2][2][4]) {
#pragma unroll
    for (int hf = 0; hf < 2; ++hf)
#pragma unroll
        for (int q = 0; q < 2; ++q) { const u32x2 v = *(const u32x2*)(src + 64 * hf + 32 * q + 4 * c8);
            x[hf][q][0] = bflo(v.x) * scale; x[hf][q][1] = bfhi(v.x) * scale; x[hf][q][2] = bflo(v.y) * scale; x[hf][q][3] = bfhi(v.y) * scale; }
    if (rr >= NCTX) {
        const int t = rr - NCTX;
#pragma unroll
        for (int hf = 0; hf < 2; ++hf) { const float pos = (float)(hf ? (t & 63) : (t >> 6));
#pragma unroll
            for (int e = 0; e < 4; ++e) { const float rev = pos * (__builtin_amdgcn_exp2f(-(float)(4 * c8 + e) * 0.41524101186092030f) * 0.15915494309189535f);
                const float cs = __builtin_amdgcn_cosf(rev), sn = __builtin_amdgcn_sinf(rev);
                const float p1 = x[hf][0][e], p2 = x[hf][1][e]; x[hf][0][e] = p1 * cs - p2 * sn; x[hf][1][e] = p1 * sn + p2 * cs; } }
    }
}

constexpr int R1_LF = 0, R1_KT = 33792, R1_VT = 52224, R1_SEG = 56832, R1_DEC = 58880, R1_WSC = 59392, R1_MISC = 59648;
template <bool ML>
__device__ __forceinline__ void r1_unit(Frame& F, int l, int b, int h, int dir, int vs) {
    const bf16_t* P = (const bf16_t*)(F.ws + WS_PROJ);
    bf16_t* SP = (bf16_t*)(F.ws + WS_SP) + ((size_t)((((ML ? 1 : 0) * 4 + b) * 4 + h) * 2 + dir) * NCH) * 16384;
    float* NST = (float*)(F.ws + WS_NST) + (size_t)(((b * 4 + h) * 2 + dir) * NCH) * 132;
    const float* G16 = (const float*)(F.ws + WS_G16);
    LAS float* LF = (LAS float*)(F.lds + R1_LF); LAS bf16_t* KT = (LAS bf16_t*)(F.lds + R1_KT); LAS bf16_t* VT = (LAS bf16_t*)(F.lds + R1_VT);
    LAS float* SEG = (LAS float*)(F.lds + R1_SEG); LAS float* DEC = (LAS float*)(F.lds + R1_DEC); LAS float* WSC = (LAS float*)(F.lds + R1_WSC); LAS float* MISC = (LAS float*)(F.lds + R1_MISC);
    int tid = F.tid; asm volatile("" : "+v"(tid));
    const int lane = tid & 63, w = F.wave, g = lane >> 4, c = lane & 15;
    const int p_ = tid >> 3, c8 = tid & 7;
    float lb[16];
    if (!ML) {
#pragma unroll
        for (int e = 0; e < 16; ++e) { const int ch = dir * 512 + 128 * h + 16 * c8 + e; lb[e] = (l == 0) ? 0.f : sigmoidf_(F.in[I_HGLB][1024 + ch] - F.in[I_HGLB][ch]); }
    }
    const float gbi = ML ? F.in[I_MLGB][((l * 2 + dir) * 2 + 0) * 4 + h] : 0.f, gbf = ML ? F.in[I_MLGB][((l * 2 + dir) * 2 + 1) * 4 + h] : 0.f;
    f32x4 acc[2]; acc[0] = (f32x4){0.f, 0.f, 0.f, 0.f}; acc[1] = acc[0];
    float m_old = 0.f, nreg = 0.f;
    __syncthreads();
    for (int C = 0; C < NCH; ++C) {
        const int mrow = tokrow(b, dir, 64 * C + p_);
        {   const u32x2 v = *(const u32x2*)(P + (size_t)mrow * NPROJ + (ML ? C_MLV : C_HGI) + 128 * h + 32 * vs + 4 * c8);
            LAS bf16_t* d = VT + (4 * c8) * 72 + p_;
            d[0] = (bf16_t)(v.x & 0xffff); d[72] = (bf16_t)(v.x >> 16); d[144] = (bf16_t)(v.y & 0xffff); d[216] = (bf16_t)(v.y >> 16); }
        float w_old = 0.f;
        if (!ML) {
            const bf16_t* zp = P + (size_t)mrow * NPROJ + C_HGF + 512 * dir + 128 * h + 16 * c8;
            const u32x4 z0 = *(const u32x4*)zp, z1 = *(const u32x4*)(zp + 8);
            float lf[16];
#pragma unroll
            for (int q = 0; q < 4; ++q) { const unsigned wa = z0[q], wb = z1[q];
                lf[2 * q] = bflo(wa); lf[2 * q + 1] = bfhi(wa); lf[8 + 2 * q] = bflo(wb); lf[8 + 2 * q + 1] = bfhi(wb); }
#pragma unroll
            for (int e = 0; e < 16; ++e) { const float f = lb[e] + (1.0f - lb[e]) * sigmoidf_(lf[e]); lf[e] = __logf(fmaxf(f, 1e-30f)); }
#pragma unroll
            for (int q = 0; q < 4; ++q) *(LAS f32x4*)(LF + p_ * 132 + 16 * c8 + 4 * q) = (f32x4){lf[4 * q], lf[4 * q + 1], lf[4 * q + 2], lf[4 * q + 3]};
            __syncthreads();
            const int d = tid & 127, sg = tid >> 7;
            float pre[16], raw[16]; float run = 0.f;
#pragma unroll
            for (int i = 0; i < 16; ++i) { raw[i] = LF[(16 * sg + i) * 132 + d]; run += raw[i]; pre[i] = run; }
            SEG[sg * 128 + d] = run;
            __syncthreads();
            float off = 0.f, tot = 0.f;
#pragma unroll
            for (int q = 0; q < 4; ++q) { const float t = SEG[q * 128 + d]; tot += t; off += (q < sg) ? t : 0.f; }
            unsigned pkd[8];
#pragma unroll
            for (int i = 0; i < 8; ++i) { const float k0 = (1.0f - fast_exp(raw[2 * i])) * fast_exp(tot - (off + pre[2 * i])), k1 = (1.0f - fast_exp(raw[2 * i + 1])) * fast_exp(tot - (off + pre[2 * i + 1])); pkd[i] = pk2(k0, k1); }
            *(LAS u32x4*)(KT + d * 72 + 16 * sg) = (u32x4){pkd[0], pkd[1], pkd[2], pkd[3]};
            *(LAS u32x4*)(KT + d * 72 + 16 * sg + 8) = (u32x4){pkd[4], pkd[5], pkd[6], pkd[7]};
            if (sg == 0) DEC[d] = fast_exp(tot);
            __syncthreads();
        } else {
            if (w == 0) {
                const int mr = tokrow(b, dir, 64 * C + lane);
                const float ig = G16[(size_t)mr * 16 + dir * 8 + h] + gbi, lfg = logsigmoidf_(G16[(size_t)mr * 16 + dir * 8 + 4 + h] + gbf);
                const float bb = wave_scan_add(lfg, lane), bend = __shfl(bb, 63);
                const float e = bend - bb + ig, mloc = wave_max(e), mnew = fmaxf(bend + m_old, mloc);
                WSC[lane] = fast_exp(e - mnew);
                if (lane == 0) { MISC[0] = fast_exp(bend + m_old - mnew); MISC[1] = m_old; }
                m_old = mnew;
            }
            __syncthreads();
            w_old = MISC[0];
            float x[2][2][4];
            load_rope16(P + (size_t)mrow * NPROJ + C_MLK + 128 * h, c8, mrow % TT, 0.08838834764831845f * WSC[p_], x);
#pragma unroll
            for (int hf = 0; hf < 2; ++hf)
#pragma unroll
                for (int q = 0; q < 2; ++q)
#pragma unroll
                    for (int e = 0; e < 4; ++e) KT[(64 * hf + 32 * q + 4 * c8 + e) * 72 + p_] = (bf16_t)f2bf(x[hf][q][e]);
            __syncthreads();
            if (tid < 128) {
                float ns = 0.f;
#pragma unroll
                for (int q = 0; q < 8; ++q) { const u32x4 v = *(const LAS u32x4*)(KT + tid * 72 + 8 * q);
                    ns += (bflo(v.x) + bfhi(v.x)) + (bflo(v.y) + bfhi(v.y)) + (bflo(v.z) + bfhi(v.z)) + (bflo(v.w) + bfhi(v.w)); }
                if (vs == 0) { NST[(size_t)C * 132 + tid] = nreg; if (tid == 0) NST[(size_t)C * 132 + 128] = MISC[1]; }
                nreg = w_old * nreg + ns;
            }
        }
        bf16_t* ST = SP + (size_t)C * 16384;
#pragma unroll
        for (int nb = 0; nb < 2; ++nb)
            *(u32x2*)(ST + (size_t)(32 * vs + 16 * nb + c) * 128 + 16 * w + 4 * g) = (u32x2){pk2(acc[nb][0], acc[nb][1]), pk2(acc[nb][2], acc[nb][3])};
        f32x4 dec;
        if (ML) dec = (f32x4){w_old, w_old, w_old, w_old}; else dec = *(const LAS f32x4*)(DEC + 16 * w + 4 * g);
        const bf16x8 a0 = *(const LAS bf16x8*)(KT + (16 * w + c) * 72 + 8 * g), a1 = *(const LAS bf16x8*)(KT + (16 * w + c) * 72 + 32 + 8 * g);
#pragma unroll
        for (int nb = 0; nb < 2; ++nb) {
            const bf16x8 b0 = *(const LAS bf16x8*)(VT + (16 * nb + c) * 72 + 8 * g), b1 = *(const LAS bf16x8*)(VT + (16 * nb + c) * 72 + 32 + 8 * g);
            acc[nb] = acc[nb] * dec; acc[nb] = mfma16(a0, b0, acc[nb]); acc[nb] = mfma16(a1, b1, acc[nb]); }
        __syncthreads();
    }
}

constexpr int R2_QS = 0, R2_KS = 17408, R2_GT = 34816, R2_VT = 68608, R2_AM = 87040, R2_OT = 96256, R2_SEG = 130048, R2_SC = 132096;
__device__ __forceinline__ bf16x8 hg_frag(const LAS bf16_t* X, const LAS float* G, int row, int ks, int g, const LAS float* ref, float sgn) {
    const u32x4 xv = *(const LAS u32x4*)(X + row * 136 + 32 * ks + 8 * g);
    f32x4 g0 = *(const LAS f32x4*)(G + row * 132 + 32 * ks + 8 * g), g1 = *(const LAS f32x4*)(G + row * 132 + 32 * ks + 8 * g + 4);
    if (ref) { g0 = g0 - *(const LAS f32x4*)(ref + 32 * ks + 8 * g); g1 = g1 - *(const LAS f32x4*)(ref + 32 * ks + 8 * g + 4); }
    u32x4 o;
    o.x = pk2(bflo(xv.x) * fast_exp(sgn * g0.x), bfhi(xv.x) * fast_exp(sgn * g0.y)); o.y = pk2(bflo(xv.y) * fast_exp(sgn * g0.z), bfhi(xv.y) * fast_exp(sgn * g0.w));
    o.z = pk2(bflo(xv.z) * fast_exp(sgn * g1.x), bfhi(xv.z) * fast_exp(sgn * g1.y)); o.w = pk2(bflo(xv.w) * fast_exp(sgn * g1.z), bfhi(xv.w) * fast_exp(sgn * g1.w));
    return __builtin_bit_cast(bf16x8, o);
}
template <bool ML>
__device__ __forceinline__ void r2_unit(Frame& F, int l, int b, int h, int cn) {
    const bf16_t* P = (const bf16_t*)(F.ws + WS_PROJ); bf16_t* BR = (bf16_t*)(F.ws + WS_BR);
    const float* G16 = (const float*)(F.ws + WS_G16);
    LAS bf16_t* QS = (LAS bf16_t*)(F.lds + R2_QS); LAS bf16_t* KS = (LAS bf16_t*)(F.lds + R2_KS); LAS float* GT = (LAS float*)(F.lds + R2_GT);
    LAS bf16_t* VT = (LAS bf16_t*)(F.lds + R2_VT); LAS bf16_t* AM = (LAS bf16_t*)(F.lds + R2_AM); LAS float* OT = (LAS float*)(F.lds + R2_OT);
    LAS float* SEG = (LAS float*)(F.lds + R2_SEG); LAS float* SC = (LAS float*)(F.lds + R2_SC);
    LAS float* S_AS = SC, *S_MU = SC + 64, *S_WI = SC + 128, *S_FL = SC + 192, *S_QN = SC + 256, *S_DEN = SC + 320;
    int tid = F.tid; asm volatile("" : "+v"(tid));
    const int lane = tid & 63, w = F.wave, g = lane >> 4, c = lane & 15;
    const int p_ = tid >> 3, c8 = tid & 7;
    const int mbase = b * TT + 64 * cn;
    for (int dir = 0; dir < 2; ++dir) {
        const int C = dir == 0 ? cn : (cn < 4 ? 3 - cn : 71 - cn);
        const int mrow = tokrow(b, dir, 64 * C + p_);
        const bf16_t* ST = (const bf16_t*)(F.ws + WS_SP) + ((size_t)((((ML ? 1 : 0) * 4 + b) * 4 + h) * 2 + dir) * NCH + C) * 16384;
        const float* NSTc = (const float*)(F.ws + WS_NST) + ((size_t)(((b * 4 + h) * 2 + dir) * NCH) + C) * 132;
        __syncthreads();
        {   const bf16_t* vp = P + (size_t)mrow * NPROJ + (ML ? C_MLV : C_HGI) + 128 * h + 16 * c8;
            const u32x4 v0 = *(const u32x4*)vp, v1 = *(const u32x4*)(vp + 8);
            LAS bf16_t* d = VT + (16 * c8) * 72 + p_;
#pragma unroll
            for (int q = 0; q < 4; ++q) { d[(2 * q) * 72] = (bf16_t)(v0[q] & 0xffff); d[(2 * q + 1) * 72] = (bf16_t)(v0[q] >> 16); d[(8 + 2 * q) * 72] = (bf16_t)(v1[q] & 0xffff); d[(8 + 2 * q + 1) * 72] = (bf16_t)(v1[q] >> 16); } }
        if (!ML) {
            const bf16_t* qp = P + (size_t)mrow * NPROJ + C_HGQ + 128 * h + 16 * c8;
            const bf16_t* zp = P + (size_t)mrow * NPROJ + C_HGF + 512 * dir + 128 * h + 16 * c8;
            const u32x4 q0 = *(const u32x4*)qp, q1 = *(const u32x4*)(qp + 8), z0 = *(const u32x4*)zp, z1 = *(const u32x4*)(zp + 8);
            float qv[16], lf[16];
#pragma unroll
            for (int q = 0; q < 4; ++q) { qv[2 * q] = bflo(q0[q]); qv[2 * q + 1] = bfhi(q0[q]); qv[8 + 2 * q] = bflo(q1[q]); qv[8 + 2 * q + 1] = bfhi(q1[q]);
                lf[2 * q] = bflo(z0[q]); lf[2 * q + 1] = bfhi(z0[q]); lf[8 + 2 * q] = bflo(z1[q]); lf[8 + 2 * q + 1] = bfhi(z1[q]); }
            unsigned qk[8], kk[8];
#pragma unroll
            for (int e = 0; e < 16; e += 2) {
                float f0, f1;
                { const int ch = dir * 512 + 128 * h + 16 * c8 + e; const float lb0 = (l == 0) ? 0.f : sigmoidf_(F.in[I_HGLB][1024 + ch] - F.in[I_HGLB][ch]), lb1 = (l == 0) ? 0.f : sigmoidf_(F.in[I_HGLB][1024 + ch + 1] - F.in[I_HGLB][ch + 1]);
                  f0 = lb0 + (1.0f - lb0) * sigmoidf_(lf[e]); f1 = lb1 + (1.0f - lb1) * sigmoidf_(lf[e + 1]); }
                lf[e] = __logf(fmaxf(f0, 1e-30f)); lf[e + 1] = __logf(fmaxf(f1, 1e-30f));
                kk[e >> 1] = pk2(1.0f - f0, 1.0f - f1); qk[e >> 1] = pk2(siluf_(qv[e]), siluf_(qv[e + 1])); }
            *(LAS u32x4*)(QS + p_ * 136 + 16 * c8) = (u32x4){qk[0], qk[1], qk[2], qk[3]}; *(LAS u32x4*)(QS + p_ * 136 + 16 * c8 + 8) = (u32x4){qk[4], qk[5], qk[6], qk[7]};
            *(LAS u32x4*)(KS + p_ * 136 + 16 * c8) = (u32x4){kk[0], kk[1], kk[2], kk[3]}; *(LAS u32x4*)(KS + p_ * 136 + 16 * c8 + 8) = (u32x4){kk[4], kk[5], kk[6], kk[7]};
#pragma unroll
            for (int q = 0; q < 4; ++q) *(LAS f32x4*)(GT + p_ * 132 + 16 * c8 + 4 * q) = (f32x4){lf[4 * q], lf[4 * q + 1], lf[4 * q + 2], lf[4 * q + 3]};
            __syncthreads();
            const int d = tid & 127, sg = tid >> 7;
            float pre[16]; float run = 0.f;
#pragma unroll
            for (int i = 0; i < 16; ++i) { run += GT[(16 * sg + i) * 132 + d]; pre[i] = run; }
            SEG[sg * 128 + d] = run;
            __syncthreads();
            float off = 0.f;
#pragma unroll
            for (int q = 0; q < 4; ++q) { const float t = SEG[q * 128 + d]; off += (q < sg) ? t : 0.f; }
#pragma unroll
            for (int i = 0; i < 16; ++i) GT[(16 * sg + i) * 132 + d] = off + pre[i];
        } else {
            float xq[2][2][4], xk[2][2][4];
            load_rope16(P + (size_t)mrow * NPROJ + C_MLQ + 128 * h, c8, mrow % TT, 1.0f, xq);
            load_rope16(P + (size_t)mrow * NPROJ + C_MLK + 128 * h, c8, mrow % TT, 0.08838834764831845f, xk);
            float qn = 0.f;
#pragma unroll
            for (int hf = 0; hf < 2; ++hf)
#pragma unroll
                for (int q = 0; q < 2; ++q) { const int ch = 64 * hf + 32 * q + 4 * c8;
                    const f32x4 nv = *(const f32x4*)(NSTc + ch);
                    qn += (xq[hf][q][0] * nv.x + xq[hf][q][1] * nv.y) + (xq[hf][q][2] * nv.z + xq[hf][q][3] * nv.w);
                    *(LAS u32x2*)(QS + p_ * 136 + ch) = (u32x2){pk2(xq[hf][q][0], xq[hf][q][1]), pk2(xq[hf][q][2], xq[hf][q][3])};
                    *(LAS u32x2*)(KS + p_ * 136 + ch) = (u32x2){pk2(xk[hf][q][0], xk[hf][q][1]), pk2(xk[hf][q][2], xk[hf][q][3])}; }
            qn += __shfl_xor(qn, 1); qn += __shfl_xor(qn, 2); qn += __shfl_xor(qn, 4);
            if (c8 == 0) S_QN[p_] = qn;
            if (w == 0) {
                const int mr = tokrow(b, dir, 64 * C + lane);
                const float gbi = F.in[I_MLGB][((l * 2 + dir) * 2 + 0) * 4 + h], gbf = F.in[I_MLGB][((l * 2 + dir) * 2 + 1) * 4 + h];
                const float ig = G16[(size_t)mr * 16 + dir * 8 + h] + gbi, lfg = logsigmoidf_(G16[(size_t)mr * 16 + dir * 8 + 4 + h] + gbf);
                const float bb = wave_scan_add(lfg, lane), a = ig - bb, mu = fmaxf(NSTc[128], wave_scan_max(a, lane));
                S_AS[lane] = a; S_MU[lane] = mu; S_WI[lane] = fast_exp(NSTc[128] - mu); S_FL[lane] = fast_exp(-bb - mu);
            }
        }
        __syncthreads();
        if (!ML) {
            if (w < 7) {
                const int nblk = w < 4 ? 1 : 2;
                for (int q = 0; q < nblk; ++q) {
                    int I, J;
                    if (w < 4) { I = w; J = w; } else if (w == 4) { I = 1 + q; J = 0; } else if (w == 5) { I = 2 + q; J = q ? 0 : 1; } else { I = 3; J = 1 + q; }
                    const LAS float* ref = GT + ((I == J) ? 16 * I + 8 : 16 * J + 15) * 132;
                    f32x4 z = (f32x4){0.f, 0.f, 0.f, 0.f};
#pragma unroll
                    for (int ks = 0; ks < 4; ++ks) z = mfma16(hg_frag(KS, GT, 16 * J + c, ks, g, ref, -1.0f), hg_frag(QS, GT, 16 * I + c, ks, g, ref, 1.0f), z);
                    if (I == J) {
#pragma unroll
                        for (int r = 0; r < 4; ++r) z[r] = (4 * g + r <= c) ? z[r] : 0.f; }
                    *(LAS u32x2*)(AM + (16 * I + c) * 72 + 16 * J + 4 * g) = (u32x2){pk2(z[0], z[1]), pk2(z[2], z[3])};
                }
            } else {
                for (int i = lane; i < 6 * 16 * 2; i += 64) { const int blk = i >> 5, rr = (i >> 1) & 15, hh = i & 1;
                    const int I = blk < 3 ? 0 : (blk < 5 ? 1 : 2), J = blk < 3 ? 1 + blk : (blk < 5 ? blk - 1 : 3);
                    *(LAS u32x4*)(AM + (16 * I + rr) * 72 + 16 * J + 8 * hh) = (u32x4){0u, 0u, 0u, 0u}; }
            }
        } else {
            const int I = w & 3, par = w >> 2;
            float dsum = 0.f;
            const float mu = S_MU[16 * I + c];
            for (int J = par; J < 4; J += 2) {
                if (J <= I) {
                    f32x4 z = (f32x4){0.f, 0.f, 0.f, 0.f};
#pragma unroll
                    for (int ks = 0; ks < 4; ++ks) z = mfma16(*(const LAS bf16x8*)(KS + (16 * J + c) * 136 + 32 * ks + 8 * g), *(const LAS bf16x8*)(QS + (16 * I + c) * 136 + 32 * ks + 8 * g), z);
                    const f32x4 as = *(const LAS f32x4*)(S_AS + 16 * J + 4 * g);
#pragma unroll
                    for (int r = 0; r < 4; ++r) { const bool ok = (J < I) || (4 * g + r <= c); z[r] = ok ? fast_exp(as[r] - mu) * z[r] : 0.f; dsum += z[r]; }
                    *(LAS u32x2*)(AM + (16 * I + c) * 72 + 16 * J + 4 * g) = (u32x2){pk2(z[0], z[1]), pk2(z[2], z[3])};
                } else {
                    *(LAS u32x2*)(AM + (16 * I + c) * 72 + 16 * J + 4 * g) = (u32x2){0u, 0u};
                }
            }
            dsum += __shfl_xor(dsum, 16); dsum += __shfl_xor(dsum, 32);
            if (g == 0) S_DEN[par * 64 + 16 * I + c] = dsum;
        }
        __syncthreads();
        {
            const int I = w & 3, half = w >> 2;
            f32x4 o[4];
#pragma unroll
            for (int nb = 0; nb < 4; ++nb) o[nb] = (f32x4){0.f, 0.f, 0.f, 0.f};
#pragma unroll
            for (int ks = 0; ks < 4; ++ks) {
                const bf16x8 af = ML ? *(const LAS bf16x8*)(QS + (16 * I + c) * 136 + 32 * ks + 8 * g) : hg_frag(QS, GT, 16 * I + c, ks, g, nullptr, 1.0f);
#pragma unroll
                for (int nb = 0; nb < 4; ++nb) { const bf16x8 bf = *(const bf16x8*)(ST + (size_t)(64 * half + 16 * nb + c) * 128 + 32 * ks + 8 * g); o[nb] = mfma16(af, bf, o[nb]); } }
            if (ML) { const f32x4 wi = *(const LAS f32x4*)(S_WI + 16 * I + 4 * g);
#pragma unroll
                for (int nb = 0; nb < 4; ++nb) o[nb] = o[nb] * wi; }
            for (int kp = 0; kp <= (I >> 1); ++kp) {
                const bf16x8 af = *(const LAS bf16x8*)(AM + (16 * I + c) * 72 + 32 * kp + 8 * g);
#pragma unroll
                for (int nb = 0; nb < 4; ++nb) { const bf16x8 bf = *(const LAS bf16x8*)(VT + (64 * half + 16 * nb + c) * 72 + 32 * kp + 8 * g); o[nb] = mfma16(af, bf, o[nb]); } }
            f32x4 rs = (f32x4){1.f, 1.f, 1.f, 1.f};
            if (ML) {
#pragma unroll
                for (int r = 0; r < 4; ++r) { const int pp = 16 * I + 4 * g + r; const float den = S_DEN[pp] + S_DEN[64 + pp] + S_WI[pp] * S_QN[pp]; rs[r] = fast_rcp(fmaxf(fabsf(den), S_FL[pp])); } }
#pragma unroll
            for (int r = 0; r < 4; ++r) { const int pp = 16 * I + 4 * g + r; const int nl = dir == 0 ? pp : 63 - pp;
#pragma unroll
                for (int nb = 0; nb < 4; ++nb) { LAS float* op = OT + nl * 132 + 64 * half + 16 * nb + c; const float val = o[nb][r] * rs[r]; *op = (dir == 0) ? val : *op + val; } }
        }
    }
    __syncthreads();
    {
        const int m = mbase + p_;
        float ov[16]; float ss = 0.f;
#pragma unroll
        for (int q = 0; q < 4; ++q) { const f32x4 t = *(const LAS f32x4*)(OT + p_ * 132 + 16 * c8 + 4 * q); ov[4 * q] = t.x; ov[4 * q + 1] = t.y; ov[4 * q + 2] = t.z; ov[4 * q + 3] = t.w; ss += (t.x * t.x + t.y * t.y) + (t.z * t.z + t.w * t.w); }
        ss += __shfl_xor(ss, 1); ss += __shfl_xor(ss, 2); ss += __shfl_xor(ss, 4);
        const float rstd = 1.0f / sqrtf(ss * (1.0f / 128.0f) + EPS);
        const bf16_t* gp = P + (size_t)m * NPROJ + (ML ? C_MLO : C_HGG) + 128 * h + 16 * c8;
        const u32x4 g0 = *(const u32x4*)gp, g1 = *(const u32x4*)(gp + 8);
        const float* nw = F.in[ML ? I_MLNW : I_HGNW] + l * 512 + 128 * h + 16 * c8;
        unsigned ow[8];
#pragma unroll
        for (int q = 0; q < 8; ++q) { const unsigned gw_ = q < 4 ? g0[q] : g1[q - 4]; const float ga = bflo(gw_), gb = bfhi(gw_);
            const float fa = ML ? sigmoidf_(ga) : siluf_(ga), fb = ML ? sigmoidf_(gb) : siluf_(gb);
            ow[q] = pk2(ov[2 * q] * rstd * nw[2 * q] * fa, ov[2 * q + 1] * rstd * nw[2 * q + 1] * fb); }
        bf16_t* op = BR + (size_t)m * 1536 + (ML ? 1024 : 512) + 128 * h + 16 * c8;
        *(u32x4*)op = (u32x4){ow[0], ow[1], ow[2], ow[3]}; *(u32x4*)(op + 8) = (u32x4){ow[4], ow[5], ow[6], ow[7]};
    }
}
constexpr int N_PHASES = 22;
__device__ __forceinline__ void init_frame(Frame& F, const Args& args, unsigned char* lds_raw) {
    F.lds = (LAS unsigned char*)lds_raw;
    F.MISC = (volatile LAS unsigned*)(F.lds + LDSCTL_OFF);
    F.tid = threadIdx.x; F.lane = F.tid & 63; F.wave = __builtin_amdgcn_readfirstlane(F.tid >> 6);
    F.G = gridDim.x; F.bid = blockIdx.x;
    F.ws = args.ws; F.ctl = (unsigned*)(args.ws + WS_CTL); F.in = args.in; F.out = args.out;
}
template <int PH>
__device__ __forceinline__ void run_phase(Frame& F) {
    LAS unsigned char* lds = F.lds;
    bf16_t* A1 = (bf16_t*)(F.ws + WS_A1); bf16_t* PROJ = (bf16_t*)(F.ws + WS_PROJ); bf16_t* BRb = (bf16_t*)(F.ws + WS_BR); bf16_t* Yb = (bf16_t*)(F.ws + WS_Y);
    bf16_t* HMID = (bf16_t*)(F.ws + WS_HMID); bf16_t* XG = (bf16_t*)(F.ws + WS_XG); bf16_t* YM = (bf16_t*)(F.ws + WS_YM);
    float* H = (float*)(F.ws + WS_H); const float* MOD = (const float*)(F.ws + WS_MOD);
    if constexpr (PH == 0) ph_prologue(F);
    else if constexpr (PH == 21) ph_final(F);
    else {
        constexpr int l = (PH - 1) / 10, sp = (PH - 1) % 10;
        if constexpr (sp == 0) ph_norm1(F, l);
        else if constexpr (sp == 1) {
            pg8::StaticOrder S{(const char*)A1, (const char*)(F.ws + WS_WIN) + (size_t)l * NPROJ * 1024 * 2, (size_t)256 * 1024 * 2, (size_t)256 * 1024 * 2, MT / 256, NPROJ / 256, F.G, F.bid, 0};
            pg8::EpiStoreBf16 E{PROJ, NPROJ};
            pg8::gemm_phase(lds, F.tid, 1024, 1024, 1024, S, E);
        } else if constexpr (sp == 2) {
            constexpr int nna = (l == 0) ? 1024 + 64 : 1024;
            for (int u = F.bid; u < nna; u += F.G) {
                if (u < 1024) na_unit<true>(F, l, u >> 8, (u >> 5) & 7, u & 31);
                else { const int v = u - 1024; na_unit<false>(F, l, v >> 4, (v >> 1) & 7, v & 1); } }
            for (int u = F.bid; u < 256; u += F.G) {
                const int vs = u & 3, dir = (u >> 2) & 1, h = (u >> 3) & 3, b = (u >> 5) & 3;
                if (u < 128) r1_unit<false>(F, l, b, h, dir, vs); else r1_unit<true>(F, l, b, h, dir, vs); }
        } else if constexpr (sp == 3) {
            constexpr int c0 = (l == 0) ? 0 : 4, ncn = NCH - c0, nu = 2 * 16 * ncn;
            for (int u = F.bid; u < nu; u += F.G) {
                const int mix = u & 1, v = u >> 1, cn = c0 + v % ncn, bh = v / ncn;
                if (mix == 0) r2_unit<false>(F, l, bh >> 2, bh & 3, cn); else r2_unit<true>(F, l, bh >> 2, bh & 3, cn); }
        } else if constexpr (sp == 4) {
            pg8::MergeOrder S{(const char*)BRb, (const char*)(F.ws + WS_WB) + (size_t)l * 1024 * 1536 * 2, (size_t)256 * 1536 * 2, (size_t)256 * 1536 * 2, l == 0 ? MT / 256 : 64, 4, F.G, F.bid, l == 0 ? 0 : 1};
            pg8::EpiMerge E{PROJ, Yb};
            pg8::gemm_phase(lds, F.tid, 512, 1536, 1536, S, E);
        } else if constexpr (sp == 5) {
            pg8::StaticOrder S{(const char*)Yb, (const char*)(F.ws + WS_WO) + (size_t)l * 1024 * 1024 * 2, (size_t)256 * 1024 * 2, (size_t)256 * 1024 * 2, l == 0 ? MT / 256 : 64, 4, F.G, F.bid, l == 0 ? 0 : 1};
            pg8::EpiResid E{H, MOD + (size_t)l * 5 * 6144 + 2 * 1024};
            pg8::gemm_phase(lds, F.tid, 1024, 1024, 1024, S, E);
        } else if constexpr (sp == 6) ph_norm2(F, l);
        else if constexpr (sp == 7) {
            if constexpr (l == 0) {
                pg8::StaticOrder S{(const char*)A1, (const char*)(F.ws + WS_WUP), (size_t)256 * 1024 * 2, (size_t)256 * 1024 * 2, MT / 256, 2 * FFN / 256, F.G, F.bid, 0};
                pg8::EpiSwiGLU E{HMID, FFN};
                pg8::gemm_phase(lds, F.tid, 1024, 1024, 1024, S, E);
            } else ph_moe_gather(F);
        } else if constexpr (sp == 8) {
            if constexpr (l == 0) {
                pg8::StaticOrder S{(const char*)HMID, (const char*)(F.ws + WS_WDN), (size_t)256 * FFN * 2, (size_t)256 * FFN * 2, MT / 256, 4, F.G, F.bid, 0};
                pg8::EpiResid E{H, MOD + 5 * 1024};
                pg8::gemm_phase(lds, F.tid, FFN, FFN, FFN, S, E);
            } else {
                const int* RT = (const int*)(F.ws + WS_ROUTE);
                pg8::MoeOrder S{(const char*)XG, (const char*)(F.ws + WS_MUP), (size_t)1024 * 2, (size_t)256 * 1024 * 2, (size_t)2 * EXD * 1024 * 2, RT + RT_TILE, RT[RT_NT], 2 * EXD / 256, F.G, F.bid};
                pg8::EpiSwiGLU E{HMID, EXD};
                pg8::gemm_phase(lds, F.tid, 1024, 1024, 1024, S, E);
            }
        } else if constexpr (sp == 9) {
            if constexpr (l == 1) {
                const int* RT = (const int*)(F.ws + WS_ROUTE);
                pg8::MoeOrder S{(const char*)HMID, (const char*)(F.ws + WS_MDN), (size_t)EXD * 2, (size_t)256 * EXD * 2, (size_t)1024 * EXD * 2, RT + RT_TILE, RT[RT_NT], 4, F.G, F.bid};
                pg8::EpiStoreBf16 E{YM, 1024};
                pg8::gemm_phase(lds, F.tid, EXD, EXD, EXD, S, E);
            }
        }
    }
}
#ifdef MK_ONE_LAUNCH
template <int PH> __device__ __forceinline__ void run_all(Frame& F, const Args& args, const XcdBarrier& bar) {
    if constexpr (PH < N_PHASES) {
        if constexpr (PH != 10) {
            { size_t zo = 0; asm volatile("" : "+s"(zo)); unsigned char* wsl = args.ws + zo; F.ws = wsl; F.ctl = (unsigned*)(wsl + WS_CTL);
              int ln = (int)__builtin_amdgcn_mbcnt_hi(~0u, __builtin_amdgcn_mbcnt_lo(~0u, 0u)); asm volatile("" : "+v"(ln)); F.lane = ln; F.tid = F.wave * 64 + ln; }
            run_phase<PH>(F);
            if constexpr (PH + 1 < N_PHASES) xcd_barrier(bar);
        }
        run_all<PH + 1>(F, args, bar);
    }
}
__global__ void __launch_bounds__(NWAVES * 64, 2) mega_fwd(Args args) {
    extern __shared__ __attribute__((aligned(16))) unsigned char lds_raw[];
    Frame F; init_frame(F, args, lds_raw);
    for (int u = F.tid; u < (LDS_BYTES - LDSCTL_OFF) / 4; u += NWAVES * 64) ((LAS unsigned*)(F.lds + LDSCTL_OFF))[u] = 0u;
    __syncthreads();
    const XcdBarrier bar = xcd_barrier_post(F.ctl + CW_BAR, F.MISC + 8);
    run_all<0>(F, args, bar);
}
#else
template <int PH>
__global__ void __launch_bounds__(NWAVES * 64, 2) k_phase(Args args) {
    extern __shared__ __attribute__((aligned(16))) unsigned char lds_raw[];
    Frame F; init_frame(F, args, lds_raw);
    run_phase<PH>(F);
}
template <int PH> static void launch_phases(int grid, hipStream_t stream, const Args& a) {
    if constexpr (PH < N_PHASES) {
        if constexpr (PH != 10) {
            static bool attr = false;
            if (!attr) { (void)hipFuncSetAttribute((const void*)k_phase<PH>, hipFuncAttributeMaxDynamicSharedMemorySize, LDS_BYTES); attr = true; }
            hipLaunchKernelGGL(k_phase<PH>, dim3(grid), dim3(NWAVES * 64), LDS_BYTES, stream, a);
        }
        launch_phases<PH + 1>(grid, stream, a);
    }
}
#endif

extern "C" void kernel_launch(void* const* d_in, const int* in_sizes, int n_in, void* d_out, int out_size, void* d_ws, size_t ws_size, hipStream_t stream) {
    static int grid = 0;
    if (grid == 0) {
        if (n_in != 22 || out_size != NB * SEQ * DM || ws_size < WS_END) { fprintf(stderr, "kernel_launch: unexpected shapes (n_in %d, out %d, ws %zu, need %zu)\n", n_in, out_size, ws_size, (size_t)WS_END); grid = -1; return; }
        int dev = 0, cus = 0;
        if (hipGetDevice(&dev) != hipSuccess || hipDeviceGetAttribute(&cus, hipDeviceAttributeMultiprocessorCount, dev) != hipSuccess) { grid = -1; return; }
        grid = cus;
    }
    if (grid < 0) return;
    (void)hipMemsetAsync((char*)d_ws + WS_CTL, 0, 1 * MiB, stream);
    Args a{};
    for (int i = 0; i < 22; ++i) a.in[i] = (const float*)d_in[i];
    a.out = (float*)d_out; a.ws = (unsigned char*)d_ws; a.ph_lo = 0; a.ph_hi = N_PHASES;
#ifndef MK_ONE_LAUNCH
    launch_phases<0>(grid, stream, a);
#else
    static bool attr = false;
    if (!attr) { (void)hipFuncSetAttribute((const void*)mega_fwd, hipFuncAttributeMaxDynamicSharedMemorySize, LDS_BYTES); attr = true; }
    hipLaunchKernelGGL(mega_fwd, dim3(grid), dim3(NWAVES * 64), LDS_BYTES, stream, a);
#endif
}
```

```cpp
#define MK_ONE_LAUNCH 1
#include <hip/hip_runtime.h>
#include <cstdio>
#include <cstdint>

#define LAS __attribute__((address_space(3)))
typedef unsigned short bf16_t;
typedef short bf16x8 __attribute__((ext_vector_type(8)));
typedef short bf16x4 __attribute__((ext_vector_type(4)));
typedef float f32x4 __attribute__((ext_vector_type(4)));
typedef float f32x2 __attribute__((ext_vector_type(2)));
typedef unsigned u32x4 __attribute__((ext_vector_type(4)));
typedef unsigned u32x2 __attribute__((ext_vector_type(2)));

constexpr int NB = 4, SEQ = 4096, DM = 1024, NCTX = 256, DEPTH = 2;
constexpr int TT = NCTX + SEQ;
constexpr int MT = NB * TT;
constexpr int INW = 9232;
constexpr int NPROJ = 7680;
constexpr int NWIN = 9216;
constexpr int C_NAQ = 0, C_NAK = 512, C_HGQ = 1024, C_HGF = 1536, C_HGG = 2560, C_MLQ = 3072, C_MLK = 3584, C_MLO = 4096, C_BG = 4608;
constexpr int V_NA = 0, V_HG = 512, V_ML = 1024;
constexpr int FFN = 2816, EXD = 3584, NEXP = 8;
constexpr int NCH = TT / 64;
constexpr float EPS = 1e-6f;
constexpr int MAXSLOT = 34816;
constexpr int MAXRT = MAXSLOT / 256;

constexpr size_t MiB = 1u << 20;
constexpr size_t WS_CTL = 0;
constexpr size_t WS_MOD = 1 * MiB;
constexpr size_t WS_G16 = 2 * MiB;
constexpr size_t WS_ROUTE = 4 * MiB;
constexpr size_t WS_NST = 5 * MiB;
constexpr size_t WS_WIN = 7 * MiB;
constexpr size_t WS_WB = WS_WIN + 36 * MiB;
constexpr size_t WS_WO = WS_WB + 6 * MiB;
constexpr size_t WS_WUP = WS_WO + 4 * MiB;
constexpr size_t WS_WDN = WS_WUP + 11 * MiB;
constexpr size_t WS_MUP = WS_WDN + 6 * MiB;
constexpr size_t WS_MDN = WS_MUP + 112 * MiB;
constexpr size_t WS_H = WS_MDN + 56 * MiB;
constexpr size_t WS_A1 = WS_H + 68 * MiB;
constexpr size_t WS_PROJ = WS_A1 + 34 * MiB;
constexpr size_t WS_VTG = WS_PROJ + 255 * MiB;
constexpr size_t WS_BR = WS_PROJ + 306 * MiB;
constexpr size_t WS_Y = WS_BR + 51 * MiB;
constexpr size_t WS_SP = WS_Y + 34 * MiB;
constexpr size_t WS_DEC = WS_SP + 136 * MiB;
constexpr size_t WS_NSG = WS_DEC + 2 * MiB;
constexpr size_t WS_MLS = WS_NSG + 2 * MiB;
constexpr size_t WS_END = WS_MLS + 1 * MiB;
constexpr size_t WS_KTG0 = WS_A1;
constexpr size_t WS_KTG1 = WS_Y;
constexpr size_t WS_HMID = WS_PROJ;
constexpr size_t WS_XG = WS_SP;
constexpr size_t WS_YM = WS_BR;
constexpr size_t WS_YMP = WS_SP + 68 * MiB;
static_assert(WS_END <= 896 * MiB, "workspace map exceeds the guaranteed size");
static_assert((size_t)MAXSLOT * EXD * 2 <= 255 * MiB && (size_t)MT * NPROJ * 2 <= 255 * MiB && (size_t)MAXSLOT * 1024 * 2 <= 85 * MiB && (size_t)MAXSLOT * 1024 * 2 <= 136 * MiB, "overlays");

constexpr int RT_TOKE = 0;
constexpr int RT_TOKW = 32768;
constexpr int RT_TOKS = 65536;
constexpr int RT_TILE = 98304;
constexpr int RT_NT = 98304 + 2 * 144;
constexpr int RT_SPLITX = RT_NT + 16;
constexpr int CW_CNT = 64;
constexpr int CW_CUR = 128;
constexpr int CW_NAQ = 256;
constexpr int CW_BAR = 4096;
static_assert((CW_BAR + 3456) * 4 <= 32768, "control words inside the per-call memset");

__device__ __forceinline__ unsigned f2bf(float f) { unsigned u = __builtin_bit_cast(unsigned, f); return (u + 0x7fffu + ((u >> 16) & 1u)) >> 16; }
typedef __bf16 bf16n2 __attribute__((ext_vector_type(2)));
__device__ __forceinline__ unsigned pk2(float lo, float hi) { const f32x2 f = {lo, hi}; return __builtin_bit_cast(unsigned, __builtin_convertvector(f, bf16n2)); }
__device__ __forceinline__ float bf2f(unsigned short b) { return __builtin_bit_cast(float, (unsigned)b << 16); }
__device__ __forceinline__ float bflo(unsigned w) { return __builtin_bit_cast(float, w << 16); }
__device__ __forceinline__ float bfhi(unsigned w) { return __builtin_bit_cast(float, w & 0xffff0000u); }
__device__ __forceinline__ float fast_exp(float x) { return __builtin_amdgcn_exp2f(x * 1.4426950408889634f); }
__device__ __forceinline__ float fast_rcp(float x) { return __builtin_amdgcn_rcpf(x); }
__device__ __forceinline__ float sigmoidf_(float x) { return fast_rcp(1.0f + fast_exp(-x)); }
__device__ __forceinline__ float siluf_(float x) { return x * sigmoidf_(x); }
__device__ __forceinline__ float wave_sum(float v) {
#pragma unroll
    for (int o = 1; o < 64; o <<= 1) v += __shfl_xor(v, o);
    return v;
}
#define LDS_WAIT() asm volatile("s_waitcnt lgkmcnt(0)" ::: "memory")
#define VM_WAIT() asm volatile("s_waitcnt vmcnt(0)" ::: "memory")

namespace pg8 {
#ifndef PG8_WGM
#define PG8_WGM 4
#endif
constexpr int BM = 256, BK = 64, HALF = 128, HTB = HALF * BK * 2, STAGE_BYTES = 8 * HTB, NXCD = 8, WGM = PG8_WGM;
__host__ __device__ __forceinline__ int lds_byte(int r, int c) { const int st = (r >> 4) * 2 + (c >> 5), rr = r & 15, cc = c & 31, ob = rr * 64 + cc * 2; return st * 1024 + (ob ^ (((ob >> 9) & 1) << 5)); }
__host__ __device__ __forceinline__ void stage_rc(int b, int& R, int& C) { const int st = b / 1024, sb = b % 1024, swz = sb ^ (((sb >> 9) & 1) << 5); R = (st >> 1) * 16 + swz / 64; C = (st & 1) * 32 + (swz % 64) / 2; }
__host__ __device__ __forceinline__ int perm32(int rho) { const int n = rho >> 4, i = rho & 15; return 8 * (i >> 2) + 4 * n + (i & 3); }

struct Unit { int pm, pn, aux; };

__device__ __forceinline__ bool static_tile(long L, int nM, int nN, int& pm, int& pn) {
    const int nwg = nM * nN; if (L >= nwg) return false;
    int wgid = (int)L; { const int q = nwg / NXCD, r = nwg % NXCD, xcd = wgid % NXCD, off = wgid / NXCD; wgid = (xcd < r ? xcd * (q + 1) : r * (q + 1) + (xcd - r) * q) + off; }
    const int nig = WGM * nN, gid = wgid / nig, fm = gid * WGM, gsz = (nM - fm) < WGM ? (nM - fm) : WGM;
    pm = fm + ((wgid % nig) % gsz); pn = (wgid % nig) / gsz; return true;
}
struct StaticOrder {
    const char* A; const char* Bt; size_t tstepA, tstepB; int nM, nN, G, c, skip_ctx;
    __device__ __forceinline__ bool next(int i, Unit& u) const {
        int pm, pn; if (!static_tile((long)i * G + c, nM, nN, pm, pn)) return false;
        u.pm = skip_ctx ? pm + pm / 16 + 1 : pm; u.pn = pn; u.aux = 0; return true; }
    __device__ __forceinline__ const char* Aptr(const Unit& u) const { return A + (size_t)u.pm * tstepA; }
    __device__ __forceinline__ const char* Bptr(const Unit& u) const { return Bt + (size_t)u.pn * tstepB; }
};
struct InProjOrder {
    const char* X; const char* W; int G, c;
    __device__ __forceinline__ bool next(int i, Unit& u) const {
        const long L = (long)i * G + c;
        if (L < 68 * 30) { int pm, pn; static_tile(L, 68, 30, pm, pn); u.pm = pm; u.pn = pn; u.aux = 0; return true; }
        const long L2 = L - 68 * 30; if (L2 >= 6 * 68) return false;
        u.pm = (int)(L2 % 6); u.pn = (int)(L2 / 6); u.aux = 1; return true; }
    __device__ __forceinline__ const char* Aptr(const Unit& u) const { return u.aux ? W + (size_t)(NPROJ + 256 * u.pm) * 2048 : X + (size_t)u.pm * 256 * 2048; }
    __device__ __forceinline__ const char* Bptr(const Unit& u) const { return u.aux ? X + (size_t)u.pn * 256 * 2048 : W + (size_t)u.pn * 256 * 2048; }
};
struct MergeOrder {
    const char* A; const char* Bt; size_t tstepA, tstepB; int nM, nN, G, c, skip_ctx;
    __device__ __forceinline__ bool next(int i, Unit& u) const {
        int pm, pn; if (!static_tile((long)(i / 3) * G + c, nM, nN, pm, pn)) return false;
        u.pm = skip_ctx ? pm + pm / 16 + 1 : pm; u.pn = pn; u.aux = i % 3; return true; }
    __device__ __forceinline__ const char* Aptr(const Unit& u) const { return A + (size_t)u.pm * tstepA + (size_t)u.aux * 1024; }
    __device__ __forceinline__ const char* Bptr(const Unit& u) const { return Bt + (size_t)u.pn * tstepB + (size_t)u.aux * 1024; }
};
struct MoeOrder {
    const char* A; const char* Bt; size_t rowbytesA, tstepB, estepB; const int* tiles; int nM, nN, G, c, ncap;
    __device__ __forceinline__ bool next(int i, Unit& u) const {
        const long L = (long)i * G + c; if (L >= ncap) return false;
        int pm, pn; if (!static_tile(L, nM, nN, pm, pn)) return false;
        u.pm = tiles[2 * pm + 1] >> 8; u.pn = pn; u.aux = tiles[2 * pm]; return true; }
    __device__ __forceinline__ const char* Aptr(const Unit& u) const { return A + (size_t)u.pm * 256 * rowbytesA; }
    __device__ __forceinline__ const char* Bptr(const Unit& u) const { return Bt + (size_t)u.aux * estepB + (size_t)u.pn * tstepB; }
};
constexpr int MOE_S = 7;
struct MoeSplitOrder {
    const char* A; const char* Bt; size_t tstepB, estepB; const int* tiles; int nM, nN, G, c, first, nextra;
    __device__ __forceinline__ bool next(int i, Unit& u) const {
        const int L2 = i * G + c; if (L2 >= nextra * MOE_S) return false;
        const int x = L2 % nextra, sl = L2 / nextra; int pm, pn; static_tile((long)first + x, nM, nN, pm, pn);
        u.pm = x * MOE_S + sl; u.pn = 0; u.aux = (pm << 8) | (pn << 4) | sl; return true; }
    __device__ __forceinline__ const char* Aptr(const Unit& u) const { return A + (size_t)(u.aux >> 8) * 256 * (EXD * 2) + (size_t)(u.aux & 15) * 1024; }
    __device__ __forceinline__ const char* Bptr(const Unit& u) const { return Bt + (size_t)tiles[2 * (u.aux >> 8)] * estepB + (size_t)((u.aux >> 4) & 15) * tstepB + (size_t)(u.aux & 15) * 1024; }
};

__device__ __forceinline__ unsigned cvt_pk_bf16(float lo, float hi) { return pk2(lo, hi); }

typedef f32x4 Acc[2][2][4][2];
__device__ __forceinline__ void zero_acc(Acc& acc) {
#pragma unroll
    for (int a = 0; a < 2; ++a)
#pragma unroll
        for (int b = 0; b < 2; ++b)
#pragma unroll
            for (int m = 0; m < 4; ++m)
#pragma unroll
                for (int n = 0; n < 2; ++n) acc[a][b][m][n] = (f32x4){0.f, 0.f, 0.f, 0.f};
}

template <class Epi, class Sched>
__device__ __forceinline__ void gemm_phase(LAS unsigned char* lds, const int tid, const int K, const int lda, const int ldb, const Sched& S, const Epi& E) {
    const int wid = __builtin_amdgcn_readfirstlane(tid >> 6), lane = tid & 63, wr = wid >> 2, wc = wid & 3, fr = lane & 15, fq = lane >> 4;
    const int nt = K / BK;
    unsigned voffA[2], voffB[2];
#pragma unroll
    for (int i = 0; i < 2; ++i) { int R, C; stage_rc(tid * 16 + i * 8192, R, C); const int Rb = Epi::PERM ? ((R & ~31) + perm32(R & 31)) : R;
        voffA[i] = (unsigned)(R * lda + C) * 2u; voffB[i] = (unsigned)(Rb * ldb + C) * 2u; }
    const size_t kstep = (size_t)(BK * 2);
    const size_t hstepA = (size_t)HALF * lda * 2, hstepB = (size_t)HALF * ldb * 2;
    const unsigned ldsw = (unsigned)wid * 1024u;
    const int aoff = lds_byte(wr * 64 + fr, fq * 8), boff = lds_byte(wc * 32 + fr, fq * 8);
#define PG8_SA(b, h) (((b) * 2 + (h)) * HTB)
#define PG8_SB(b, h) ((4 + (b) * 2 + (h)) * HTB)
#define PG8_STAGE(bufoff, gbase, voff) do { _Pragma("unroll") for (int _i = 0; _i < 2; ++_i) \
        __builtin_amdgcn_global_load_lds((const unsigned*)((const char*)(gbase) + (voff)[_i]), (LAS unsigned*)(lds + (bufoff) + ldsw + _i * 8192), 16, 0, 0); } while (0)
#define PG8_LDA(dst, b, h) do { _Pragma("unroll") for (int m = 0; m < 4; ++m) _Pragma("unroll") for (int k = 0; k < 2; ++k) dst[m][k] = *(const LAS bf16x8*)(lds + PG8_SA(b, h) + aoff + m * 2048 + k * 1024); } while (0)
#define PG8_LDB(dst, b, h) do { _Pragma("unroll") for (int n = 0; n < 2; ++n) _Pragma("unroll") for (int k = 0; k < 2; ++k) dst[n][k] = *(const LAS bf16x8*)(lds + PG8_SB(b, h) + boff + n * 2048 + k * 1024); } while (0)
#define PG8_MMA(ai, bj, At, Bt) do { __builtin_amdgcn_s_setprio(1); _Pragma("unroll") for (int m = 0; m < 4; ++m) _Pragma("unroll") for (int n = 0; n < 2; ++n) _Pragma("unroll") for (int k = 0; k < 2; ++k) \
        acc[ai][bj][m][n] = __builtin_amdgcn_mfma_f32_16x16x32_bf16(Bt[n][k], At[m][k], acc[ai][bj][m][n], 0, 0, 0); __builtin_amdgcn_s_setprio(0); } while (0)
#define PG8_WAIT_V(n) asm volatile("s_waitcnt vmcnt(" #n ")" ::: "memory")
#define PG8_WAIT_L(n) asm volatile("s_waitcnt lgkmcnt(" #n ")" ::: "memory")
#define PG8_BAR __builtin_amdgcn_s_barrier()
#define PG8_SCHED __builtin_amdgcn_sched_barrier(0)
    Unit cur, nxt; int ui = 0;
    if (!S.next(0, cur)) return;
    Acc acc; zero_acc(acc);
    bf16x8 At[4][2], B0[2][2], B1[2][2];
    const char* cA = S.Aptr(cur); const char* cB = S.Bptr(cur);
    PG8_STAGE(PG8_SB(0, 0), cB, voffB); PG8_STAGE(PG8_SB(0, 1), cB + hstepB, voffB); PG8_STAGE(PG8_SA(0, 0), cA, voffA); PG8_STAGE(PG8_SA(0, 1), cA + hstepA, voffA);
    if (wr == 1) PG8_BAR;
    PG8_WAIT_V(2); PG8_BAR;
    PG8_STAGE(PG8_SB(1, 0), cB + kstep, voffB); PG8_STAGE(PG8_SA(1, 0), cA + kstep, voffA); PG8_STAGE(PG8_SB(1, 1), cB + hstepB + kstep, voffB);
    PG8_WAIT_V(6); PG8_BAR;
    for (;;) {
        const bool has_next = S.next(ui + 1, nxt);
        const char* nA = has_next ? S.Aptr(nxt) : cA; const char* nB = has_next ? S.Bptr(nxt) : cB;
        for (int t = 0; t < nt; t += 2) {
            const bool last = (t == nt - 2);
            const char* a1 = cA + (size_t)(t + 1) * kstep;
            const char* a2 = last ? nA : cA + (size_t)(t + 2) * kstep; const char* b2 = last ? nB : cB + (size_t)(t + 2) * kstep;
            const char* a3 = a2 + kstep; const char* b3 = b2 + kstep;
            PG8_LDB(B0, 0, 0); PG8_LDB(B1, 0, 1); PG8_SCHED; PG8_LDA(At, 0, 0); PG8_STAGE(PG8_SA(1, 1), a1 + hstepA, voffA);
            PG8_WAIT_V(8); PG8_WAIT_L(0); PG8_BAR; PG8_MMA(0, 0, At, B0); PG8_MMA(0, 1, At, B1); PG8_BAR; PG8_SCHED;
            PG8_LDA(At, 0, 1); PG8_STAGE(PG8_SB(0, 0), b2, voffB); PG8_STAGE(PG8_SB(0, 1), b2 + hstepB, voffB); PG8_STAGE(PG8_SA(0, 0), a2, voffA);
            PG8_WAIT_V(8); PG8_WAIT_L(0); PG8_BAR; PG8_MMA(1, 0, At, B0); PG8_MMA(1, 1, At, B1); PG8_BAR; PG8_SCHED;
            PG8_LDB(B0, 1, 0); PG8_LDB(B1, 1, 1); PG8_SCHED; PG8_LDA(At, 1, 0); PG8_STAGE(PG8_SA(0, 1), a2 + hstepA, voffA);
            PG8_WAIT_V(8); PG8_WAIT_L(0); PG8_BAR; PG8_MMA(0, 0, At, B0); PG8_MMA(0, 1, At, B1); PG8_BAR; PG8_SCHED;
            PG8_LDA(At, 1, 1); PG8_STAGE(PG8_SB(1, 0), b3, voffB); PG8_STAGE(PG8_SB(1, 1), b3 + hstepB, voffB); PG8_STAGE(PG8_SA(1, 0), a3, voffA);
            PG8_WAIT_V(8); PG8_WAIT_L(0); PG8_BAR; PG8_MMA(1, 0, At, B0); PG8_MMA(1, 1, At, B1); PG8_BAR; PG8_SCHED;
        }
        if (wr == 0) PG8_BAR;
        E(acc, cur, wr, wc, fr, fq);
        if (!has_next) break;
        cur = nxt; cA = nA; cB = nB; ++ui;
        if (wr == 1) PG8_BAR;
    }
    PG8_WAIT_V(0);
    PG8_BAR;
#undef PG8_SA
#undef PG8_SB
#undef PG8_STAGE
#undef PG8_LDA
#undef PG8_LDB
#undef PG8_MMA
#undef PG8_WAIT_V
#undef PG8_WAIT_L
#undef PG8_BAR
#undef PG8_SCHED
}
}
namespace pg8 {
struct EpiStoreBf16 {
    static constexpr bool PERM = true;
    bf16_t* O; int ldc;
    __device__ __forceinline__ void operator()(Acc& acc, const Unit& u, int wr, int wc, int fr, int fq) const {
        const int row0 = u.pm * BM + wr * 64 + fr, col0 = u.pn * BM + wc * 32 + 8 * fq;
#pragma unroll
        for (int ai = 0; ai < 2; ++ai)
#pragma unroll
            for (int m = 0; m < 4; ++m) { bf16_t* rowp = O + (size_t)(row0 + ai * HALF + m * 16) * ldc + col0;
#pragma unroll
                for (int bj = 0; bj < 2; ++bj) { const f32x4 v0 = acc[ai][bj][m][0], v1 = acc[ai][bj][m][1];
                    u32x4 w; w.x = cvt_pk_bf16(v0[0], v0[1]); w.y = cvt_pk_bf16(v0[2], v0[3]); w.z = cvt_pk_bf16(v1[0], v1[1]); w.w = cvt_pk_bf16(v1[2], v1[3]);
                    *(u32x4*)(rowp + bj * HALF) = w; } }
        zero_acc(acc);
    }
};
struct EpiInProj {
    static constexpr bool PERM = true;
    bf16_t* PROJ; bf16_t* VTG;
    __device__ __forceinline__ void operator()(Acc& acc, const Unit& u, int wr, int wc, int fr, int fq) const {
        const int row0 = u.pm * BM + wr * 64 + fr, col0 = u.pn * BM + wc * 32 + 8 * fq;
        const bool gate = !u.aux && u.pn >= C_BG / BM;
#pragma unroll
        for (int ai = 0; ai < 2; ++ai)
#pragma unroll
            for (int m = 0; m < 4; ++m) { const int row = row0 + ai * HALF + m * 16;
#pragma unroll
                for (int bj = 0; bj < 2; ++bj) { f32x4 v0 = acc[ai][bj][m][0], v1 = acc[ai][bj][m][1]; const int col = col0 + bj * HALF;
                    if (gate) {
#pragma unroll
                        for (int j = 0; j < 4; ++j) { v0[j] = fast_rcp(1.0f + fast_exp(-v0[j])); v1[j] = fast_rcp(1.0f + fast_exp(-v1[j])); } }
                    u32x4 w; w.x = cvt_pk_bf16(v0[0], v0[1]); w.y = cvt_pk_bf16(v0[2], v0[3]); w.z = cvt_pk_bf16(v1[0], v1[1]); w.w = cvt_pk_bf16(v1[2], v1[3]);
                    bf16_t* dst = u.aux ? VTG + ((size_t)(col >> 6) * 1536 + row) * 64 + (col & 63) : PROJ + (size_t)row * NPROJ + col;
                    *(u32x4*)dst = w; } }
        zero_acc(acc);
    }
};
struct EpiSwiGLU {
    static constexpr bool PERM = true;
    bf16_t* O; int ldc;
    __device__ __forceinline__ void operator()(Acc& acc, const Unit& u, int wr, int wc, int fr, int fq) const {
        const int row0 = u.pm * BM + wr * 64 + fr, col0 = u.pn * HALF + wc * 32 + 8 * fq;
#pragma unroll
        for (int ai = 0; ai < 2; ++ai)
#pragma unroll
            for (int m = 0; m < 4; ++m) { bf16_t* rowp = O + (size_t)(row0 + ai * HALF + m * 16) * ldc + col0;
                float h[8];
#pragma unroll
                for (int n = 0; n < 2; ++n)
#pragma unroll
                    for (int j = 0; j < 4; ++j) { const float a = acc[ai][0][m][n][j], g = acc[ai][1][m][n][j]; h[4 * n + j] = a * fast_rcp(1.0f + fast_exp(-a)) * g; }
                u32x4 w; w.x = cvt_pk_bf16(h[0], h[1]); w.y = cvt_pk_bf16(h[2], h[3]); w.z = cvt_pk_bf16(h[4], h[5]); w.w = cvt_pk_bf16(h[6], h[7]);
                *(u32x4*)rowp = w; }
        zero_acc(acc);
    }
};
struct EpiResid {
    static constexpr bool PERM = false;
    float* H; const float* mod;
    __device__ __forceinline__ void operator()(Acc& acc, const Unit& u, int wr, int wc, int fr, int fq) const {
        const int row0 = u.pm * BM + wr * 64 + fr, col0 = u.pn * BM + wc * 32 + 4 * fq;
        const int r = (u.pm % 17 == 0) ? 4 : u.pm / 17;
        const float* mp = mod + (size_t)r * 6144 + col0;
        f32x4 mv[2][2];
#pragma unroll
        for (int bj = 0; bj < 2; ++bj)
#pragma unroll
            for (int n = 0; n < 2; ++n) mv[bj][n] = *(const f32x4*)(mp + bj * HALF + n * 16);
#pragma unroll
        for (int ai = 0; ai < 2; ++ai) {
            f32x4 hv[4][2][2];
#pragma unroll
            for (int m = 0; m < 4; ++m) { const float* rowp = H + (size_t)(row0 + ai * HALF + m * 16) * DM + col0;
#pragma unroll
                for (int bj = 0; bj < 2; ++bj)
#pragma unroll
                    for (int n = 0; n < 2; ++n) hv[m][bj][n] = *(const f32x4*)(rowp + bj * HALF + n * 16); }
#pragma unroll
            for (int m = 0; m < 4; ++m) { float* rowp = H + (size_t)(row0 + ai * HALF + m * 16) * DM + col0;
#pragma unroll
                for (int bj = 0; bj < 2; ++bj)
#pragma unroll
                    for (int n = 0; n < 2; ++n) *(f32x4*)(rowp + bj * HALF + n * 16) = hv[m][bj][n] + mv[bj][n] * acc[ai][bj][m][n]; }
            asm volatile("" ::: "memory"); }
        zero_acc(acc);
    }
};
struct EpiMerge {
    static constexpr bool PERM = true;
    const bf16_t* P; bf16_t* Y;
    __device__ __forceinline__ void operator()(Acc& acc, const Unit& u, int wr, int wc, int fr, int fq) const {
        const int row0 = u.pm * BM + wr * 64 + fr, col0 = u.pn * BM + wc * 32 + 8 * fq, seg = u.aux;
#pragma unroll
        for (int ai = 0; ai < 2; ++ai) {
            u32x4 xd[4][2], xn[4][2];
#pragma unroll
            for (int m = 0; m < 4; ++m) { const bf16_t* gp = P + (size_t)(row0 + ai * HALF + m * 16) * NPROJ + C_BG + seg * 1024 + col0;
#pragma unroll
                for (int bj = 0; bj < 2; ++bj) { xd[m][bj] = *(const u32x4*)(gp + bj * HALF); xn[m][bj] = xd[m][bj]; if (seg < 2) xn[m][bj] = *(const u32x4*)(gp + 1024 + bj * HALF); } }
#pragma unroll
            for (int m = 0; m < 4; ++m) { const size_t row = (size_t)(row0 + ai * HALF + m * 16);
#pragma unroll
                for (int bj = 0; bj < 2; ++bj) {
                    float f[8];
#pragma unroll
                    for (int q = 0; q < 4; ++q) {
                        const float d0 = bflo(xd[m][bj][q]), d1 = bfhi(xd[m][bj][q]);
                        f[2 * q] = seg < 2 ? d0 * fast_rcp(fmaxf(bflo(xn[m][bj][q]), 1e-30f)) : d0; f[2 * q + 1] = seg < 2 ? d1 * fast_rcp(fmaxf(bfhi(xn[m][bj][q]), 1e-30f)) : d1; }
                    f32x4 v0 = acc[ai][bj][m][0], v1 = acc[ai][bj][m][1];
                    v0 = v0 * (f32x4){f[0], f[1], f[2], f[3]}; v1 = v1 * (f32x4){f[4], f[5], f[6], f[7]};
                    if (seg == 2) {
                        u32x4 w; w.x = cvt_pk_bf16(v0[0], v0[1]); w.y = cvt_pk_bf16(v0[2], v0[3]); w.z = cvt_pk_bf16(v1[0], v1[1]); w.w = cvt_pk_bf16(v1[2], v1[3]);
                        *(u32x4*)(Y + row * DM + col0 + bj * HALF) = w;
                        v0 = (f32x4){0.f, 0.f, 0.f, 0.f}; v1 = v0; }
                    acc[ai][bj][m][0] = v0; acc[ai][bj][m][1] = v1; } } }
    }
};
}
constexpr int NWAVES = 8;
constexpr int LDS_BYTES = 163840;
constexpr int LDSCTL_OFF = 159744;

struct Args { const float* in[22]; float* out; unsigned char* ws; int ph_lo, ph_hi; };
enum { I_X = 0, I_C, I_CTX, I_CCTX, I_MODW, I_MODB, I_N1W, I_WIN, I_RPB, I_HGLB, I_HGNW, I_MLGB, I_MLNW, I_WBR, I_WOUT, I_N2W, I_FUP, I_FDN, I_ROUT, I_MUP, I_MDN, I_FNW };

struct Frame {
    LAS unsigned char* lds;
    volatile LAS unsigned* MISC;
    unsigned* ctl;
    unsigned char* ws;
    const float* const* in;
    float* out;
    int tid, lane, wave, G, bid;
};

#define XB_TMO      128
#define XB_XCNT(j)  (256  + 64 * (j))
#define XB_XSUB(j)  (1280 + 64 * (j))
#define XB_XGEN(j)  (2304 + 64 * (j))
#define XB_TOP      3328
#define XB_TOPGEN   3392
#define XCD_BAR_WORDS 3456
#define XB_SPIN_CAP (1u << 22)
__device__ __forceinline__ unsigned xb_ld(unsigned* p)              { return __hip_atomic_load(p, __ATOMIC_RELAXED, __HIP_MEMORY_SCOPE_AGENT); }
__device__ __forceinline__ unsigned xb_add(unsigned* p, unsigned v) { return __hip_atomic_fetch_add(p, v, __ATOMIC_RELAXED, __HIP_MEMORY_SCOPE_AGENT); }
__device__ __forceinline__ unsigned xb_xcc_id() { return (unsigned)__builtin_amdgcn_s_getreg((3 << 11) | 20) & 0xFu; }
#define XB_SPIN(cond, bar) do { unsigned _sp = 0; while (cond) { __builtin_amdgcn_s_sleep(1); \
    if ((++_sp & 255u) == 0u) { if (xb_ld(&(bar)[XB_TMO])) break; if (_sp > XB_SPIN_CAP) { atomicAdd(&(bar)[XB_TMO], 1u); break; } } } } while (0)
struct XcdBarrier { unsigned* bar; unsigned x; volatile LAS unsigned* st; };
__device__ __forceinline__ XcdBarrier xcd_barrier_post(unsigned* bar, volatile LAS unsigned* st) {
    XcdBarrier b; b.bar = bar; b.x = xb_xcc_id(); b.st = st;
    if (threadIdx.x == 0) (void)xb_add(&bar[XB_XCNT(b.x)], 1u);
    return b;
}
__device__ __forceinline__ void xcd_barrier_complete(unsigned* bar, unsigned x, unsigned& nloc, unsigned& nx) {
    const unsigned G = gridDim.x * gridDim.y * gridDim.z;
    unsigned sum, cnt, mine, sp = 0u;
    for (;;) {
        sum = 0u; cnt = 0u; mine = 0u;
#pragma unroll
        for (unsigned j = 0; j < 16; ++j) { const unsigned c = xb_ld(&bar[XB_XCNT(j)]); sum += c; cnt += (c > 0u) ? 1u : 0u; mine = (j == x) ? c : mine; }
        if (sum == G) break;
        __builtin_amdgcn_s_sleep(1);
        if ((++sp & 255u) == 0u) { if (xb_ld(&bar[XB_TMO])) break; if (sp > XB_SPIN_CAP) { atomicAdd(&bar[XB_TMO], 1u); break; } }
    }
    nloc = mine > 0u ? mine : 1u; nx = cnt > 0u ? cnt : 1u;
}
__device__ __forceinline__ void xcd_barrier(const XcdBarrier& b) {
    asm volatile("s_waitcnt vmcnt(0)" ::: "memory");
    __syncthreads();
    if (threadIdx.x == 0) {
        unsigned* bar = b.bar;
        __builtin_amdgcn_s_waitcnt(0);
        unsigned nloc = b.st[0], nx = b.st[1];
        if (nloc == 0u) { xcd_barrier_complete(bar, b.x, nloc, nx); b.st[0] = nloc; b.st[1] = nx; }
        const unsigned old = xb_add(&bar[XB_XSUB(b.x)], 1u);
        const unsigned gen = old / nloc;
        if (old + 1u == (gen + 1u) * nloc) {
            __builtin_amdgcn_fence(__ATOMIC_RELEASE, "agent");
            asm volatile("s_waitcnt vmcnt(0)" ::: "memory");
            const unsigned og = xb_add(&bar[XB_TOP], 1u);
            const unsigned tg = og / nx;
            if (og + 1u == (tg + 1u) * nx) xb_add(&bar[XB_TOPGEN], 1u);
            else XB_SPIN(xb_ld(&bar[XB_TOPGEN]) == tg, bar);
            __builtin_amdgcn_fence(__ATOMIC_ACQUIRE, "agent");
            xb_add(&bar[XB_XGEN(b.x)], 1u);
            asm volatile("s_waitcnt vmcnt(0)" ::: "memory");
        } else {
            XB_SPIN(xb_ld(&bar[XB_XGEN(b.x)]) == gen, bar);
            __builtin_amdgcn_fence(__ATOMIC_ACQUIRE, "agent");
            asm volatile("s_waitcnt vmcnt(0)" ::: "memory");
        }
    }
    __syncthreads();
}

__device__ __forceinline__ void xpose_item(const float* W, int ldw, bf16_t* WT, int ldd, LAS float* scr, int lane) {
    float v[32];
#pragma unroll
    for (int i = 0; i < 32; ++i) v[i] = W[(size_t)(2 * i + (lane >> 5)) * ldw + (lane & 31)];
#pragma unroll
    for (int i = 0; i < 32; ++i) scr[(2 * i + (lane >> 5)) * 33 + (lane & 31)] = v[i];
    LDS_WAIT(); asm volatile("" ::: "memory");
    const int c = lane & 7;
#pragma unroll
    for (int j = 0; j < 4; ++j) { const int n = (lane >> 3) + 8 * j; const LAS float* s = scr + (8 * c) * 33 + n;
        u32x4 o; o.x = pk2(s[0 * 33], s[1 * 33]); o.y = pk2(s[2 * 33], s[3 * 33]); o.z = pk2(s[4 * 33], s[5 * 33]); o.w = pk2(s[6 * 33], s[7 * 33]);
        *(u32x4*)(WT + (size_t)n * ldd + 8 * c) = o; }
    LDS_WAIT(); asm volatile("" ::: "memory");
}
struct XItem { const float* W; bf16_t* WT; int ldw, ldd; };
__device__ __forceinline__ bool xpose_mat(int& r, const float* W, int ldw, int K, int N, bf16_t* WT, int ldd, int pairF, XItem& X) {
    const int nblk = N / 32, items = (K / 64) * nblk;
    if (r >= items) { r -= items; return false; }
    const int kb = r / nblk, nb = r % nblk, k0 = 64 * kb, n0 = 32 * nb;
    int drow = n0;
    if (pairF) { const int isu = n0 >= pairF, idx = isu ? n0 - pairF : n0; drow = (idx / 128) * 256 + isu * 128 + (idx % 128); }
    X.W = W + (size_t)k0 * ldw + n0; X.ldw = ldw; X.WT = WT + (size_t)drow * ldd + k0; X.ldd = ldd;
    return true;
}
constexpr int MOE_XITEMS = 8 * (1024 / 64) * (7168 / 32) + 8 * (EXD / 64) * (1024 / 32);
__device__ __forceinline__ void moe_convert(Frame& F, int lo, int hi, int widx, int nw) {
    LAS float* scr = (LAS float*)(F.lds + F.wave * 16384);
    bf16_t* MUP = (bf16_t*)(F.ws + WS_MUP); bf16_t* MDN = (bf16_t*)(F.ws + WS_MDN);
    for (int it = lo + widx; it < hi; it += nw) {
        int r = it; bool done = false; XItem X;
        for (int e = 0; e < NEXP && !done; ++e) done = xpose_mat(r, F.in[I_MUP] + (size_t)e * 1024 * 7168, 7168, 1024, 7168, MUP + (size_t)e * 7168 * 1024, 1024, EXD, X);
        for (int e = 0; e < NEXP && !done; ++e) done = xpose_mat(r, F.in[I_MDN] + (size_t)e * EXD * 1024, 1024, EXD, 1024, MDN + (size_t)e * 1024 * EXD, EXD, 0, X);
        if (done) xpose_item(X.W, X.ldw, X.WT, X.ldd, scr, F.lane);
    }
}
__device__ __forceinline__ void ph_prologue(Frame& F) {
    {
        LAS float* sv = (LAS float*)F.lds;
        LAS float* red = (LAS float*)(F.lds + 5 * 1024 * 4);
        float* MOD = (float*)(F.ws + WS_MOD);
        bool have = false;
        for (int it = F.bid; it < 2 * 96; it += F.G) {
            if (!have) { for (int i = F.tid; i < 5 * 1024; i += 512) { const float v = i < 4096 ? F.in[I_C][i] : F.in[I_CCTX][i - 4096]; sv[i] = siluf_(v); } have = true; __syncthreads(); }
            const int l = it / 96, j0 = (it % 96) * 64, ks = F.wave, cj = F.lane;
            const float* w = F.in[I_MODW] + (size_t)l * 1024 * 6144 + j0 + cj;
            float a0 = 0.f, a1 = 0.f, a2 = 0.f, a3 = 0.f, a4 = 0.f;
#pragma unroll 8
            for (int k = ks * 128; k < ks * 128 + 128; ++k) { const float wv = w[(size_t)k * 6144];
                a0 += sv[k] * wv; a1 += sv[1024 + k] * wv; a2 += sv[2048 + k] * wv; a3 += sv[3072 + k] * wv; a4 += sv[4096 + k] * wv; }
            red[(ks * 5 + 0) * 64 + cj] = a0; red[(ks * 5 + 1) * 64 + cj] = a1; red[(ks * 5 + 2) * 64 + cj] = a2; red[(ks * 5 + 3) * 64 + cj] = a3; red[(ks * 5 + 4) * 64 + cj] = a4;
            __syncthreads();
            if (F.tid < 320) { const int r = F.tid / 64, c = F.tid % 64; float s = 0.f;
#pragma unroll
                for (int q = 0; q < 8; ++q) s += red[(q * 5 + r) * 64 + c];
                MOD[(size_t)(l * 5 + r) * 6144 + j0 + c] = s + F.in[I_MODB][l * 6144 + j0 + c]; }
            __syncthreads();
        }
        __syncthreads();
    }
    LAS float* scr = (LAS float*)(F.lds + F.wave * 16384);
    const int gw = F.bid * NWAVES + F.wave, NGW = F.G * NWAVES;
    bf16_t* WIN = (bf16_t*)(F.ws + WS_WIN); bf16_t* WB = (bf16_t*)(F.ws + WS_WB); bf16_t* WO = (bf16_t*)(F.ws + WS_WO);
    bf16_t* WUP = (bf16_t*)(F.ws + WS_WUP); bf16_t* WDN = (bf16_t*)(F.ws + WS_WDN);
    constexpr int NITEMS = 59008 - MOE_XITEMS;
    for (int it = gw; it < NITEMS; it += NGW) {
        int r = it; bool done = false; XItem X;
        for (int l = 0; l < 2 && !done; ++l) {
            {
                const float* wsrc = F.in[I_WIN] + (size_t)l * 1024 * INW; bf16_t* wdst = WIN + (size_t)l * NWIN * 1024;
                done = xpose_mat(r, wsrc + 0, INW, 1024, 1024, wdst + (size_t)0 * 1024, 1024, 0, X);
                if (!done) done = xpose_mat(r, wsrc + 1024, INW, 1024, 512, wdst + (size_t)(NPROJ + V_NA) * 1024, 1024, 0, X);
                if (!done) done = xpose_mat(r, wsrc + 1536, INW, 1024, 1536, wdst + (size_t)C_HGQ * 1024, 1024, 0, X);
                if (!done) done = xpose_mat(r, wsrc + 3072, INW, 1024, 512, wdst + (size_t)(NPROJ + V_HG) * 1024, 1024, 0, X);
                if (!done) done = xpose_mat(r, wsrc + 3584, INW, 1024, 512, wdst + (size_t)C_HGG * 1024, 1024, 0, X);
                if (!done) done = xpose_mat(r, wsrc + 4096, INW, 1024, 1024, wdst + (size_t)C_MLQ * 1024, 1024, 0, X);
                if (!done) done = xpose_mat(r, wsrc + 5120, INW, 1024, 512, wdst + (size_t)(NPROJ + V_ML) * 1024, 1024, 0, X);
                if (!done) done = xpose_mat(r, wsrc + 5632, INW, 1024, 512, wdst + (size_t)C_MLO * 1024, 1024, 0, X);
                if (!done) done = xpose_mat(r, wsrc + 6160, INW, 1024, 3072, wdst + (size_t)C_BG * 1024, 1024, 0, X);
            }
            for (int i = 0; i < 3 && !done; ++i) done = xpose_mat(r, F.in[I_WBR] + (size_t)(l * 3 + i) * 512 * 1024, 1024, 512, 1024, WB + (size_t)l * 1024 * 1536 + i * 512, 1536, 0, X);
            if (!done) done = xpose_mat(r, F.in[I_WOUT] + (size_t)l * 1024 * 1024, 1024, 1024, 1024, WO + (size_t)l * 1024 * 1024, 1024, 0, X);
        }
        if (!done) done = xpose_mat(r, F.in[I_FUP], 2 * FFN, 1024, 2 * FFN, WUP, 1024, FFN, X);
        if (!done) done = xpose_mat(r, F.in[I_FDN], 1024, FFN, 1024, WDN, FFN, 0, X);
        if (done) xpose_item(X.W, X.ldw, X.WT, X.ldd, scr, F.lane);
    }
}

__device__ __forceinline__ const float* src_row(const Frame& F, int layer_first, int m) {
    if (!layer_first) return (const float*)(F.ws + WS_H) + (size_t)m * DM;
    const int b = m / TT, r = m % TT;
    return r < NCTX ? F.in[I_CTX] + ((size_t)b * NCTX + r) * DM : F.in[I_X] + ((size_t)b * SEQ + (r - NCTX)) * DM;
}
__device__ __forceinline__ float reduce16(float (&g)[16], int lane) {
    float a8[8], a4[4], a2[2];
    const bool b5 = lane & 32, b4 = lane & 16, b3 = lane & 8, b2 = lane & 4;
#pragma unroll
    for (int k = 0; k < 8; ++k) { const float send = b5 ? g[k] : g[k + 8], keep = b5 ? g[k + 8] : g[k]; a8[k] = keep + __shfl_xor(send, 32); }
#pragma unroll
    for (int k = 0; k < 4; ++k) { const float send = b4 ? a8[k] : a8[k + 4], keep = b4 ? a8[k + 4] : a8[k]; a4[k] = keep + __shfl_xor(send, 16); }
#pragma unroll
    for (int k = 0; k < 2; ++k) { const float send = b3 ? a4[k] : a4[k + 2], keep = b3 ? a4[k + 2] : a4[k]; a2[k] = keep + __shfl_xor(send, 8); }
    float r = (b2 ? a2[1] : a2[0]) + __shfl_xor(b2 ? a2[0] : a2[1], 4);
    r += __shfl_xor(r, 2); r += __shfl_xor(r, 1);
    return r;
}
struct RowRegs { f32x4 v[4]; };
__device__ __forceinline__ void row_load(RowRegs& R, const float* xr, int lane) {
#pragma unroll
    for (int j = 0; j < 4; ++j) R.v[j] = *(const f32x4*)(xr + 256 * j + 4 * lane);
}
__device__ __forceinline__ void ph_norm1(Frame& F, int l) {
    LAS float* WG = (LAS float*)F.lds;
    for (int i = F.tid; i < 16384; i += 512) { const int k = i >> 4, g = i & 15; WG[g * 1028 + k] = F.in[I_WIN][(size_t)l * 1024 * INW + (size_t)k * INW + 6144 + g]; }
    __syncthreads();
    const int gw = F.bid * NWAVES + F.wave, NGW = F.G * NWAVES;
    const float* MOD = (const float*)(F.ws + WS_MOD) + (size_t)l * 5 * 6144;
    const float* nw = F.in[I_N1W] + l * DM;
    float* H = (float*)(F.ws + WS_H); bf16_t* A1 = (bf16_t*)(F.ws + WS_A1); float* G16 = (float*)(F.ws + WS_G16);
    RowRegs nx, nx2; if (gw < MT) row_load(nx, src_row(F, l == 0, gw), F.lane);
    if (gw + NGW < MT) row_load(nx2, src_row(F, l == 0, gw + NGW), F.lane);
    for (int m = gw; m < MT; m += NGW) {
        const RowRegs cur = nx; nx = nx2; if (m + 2 * NGW < MT) row_load(nx2, src_row(F, l == 0, m + 2 * NGW), F.lane);
        const int r = (m % TT) < NCTX ? 4 : m / TT;
        const float* sh = MOD + (size_t)r * 6144; const float* sc = sh + 1024;
        float ss = 0.f;
#pragma unroll
        for (int j = 0; j < 4; ++j) ss += (cur.v[j].x * cur.v[j].x + cur.v[j].y * cur.v[j].y) + (cur.v[j].z * cur.v[j].z + cur.v[j].w * cur.v[j].w);
        if (l == 0) {
#pragma unroll
            for (int j = 0; j < 4; ++j) *(f32x4*)(H + (size_t)m * DM + 256 * j + 4 * F.lane) = cur.v[j]; }
        const float rstd = 1.0f / sqrtf(wave_sum(ss) * (1.f / DM) + EPS);
        f32x4 av[4];
#pragma unroll
        for (int j = 0; j < 4; ++j) { const int k0 = 256 * j + 4 * F.lane;
            const f32x4 w4 = *(const f32x4*)(nw + k0), s4 = *(const f32x4*)(sh + k0), c4 = *(const f32x4*)(sc + k0);
            av[j] = (cur.v[j] * rstd * w4) * (c4 + 1.0f) + s4;
            *(u32x2*)(A1 + (size_t)m * DM + k0) = (u32x2){pk2(av[j].x, av[j].y), pk2(av[j].z, av[j].w)}; }
        float g[16];
#pragma unroll
        for (int q = 0; q < 16; ++q) { float gq = 0.f;
#pragma unroll
            for (int j = 0; j < 4; ++j) { const f32x4 wg = *(const LAS f32x4*)(WG + q * 1028 + 256 * j + 4 * F.lane); gq += (av[j].x * wg.x + av[j].y * wg.y) + (av[j].z * wg.z + av[j].w * wg.w); }
            g[q] = gq; if ((q & 3) == 3) asm volatile("" ::: "memory"); }
        const float tot = reduce16(g, F.lane);
        if ((F.lane & 3) == 0) G16[(size_t)m * 16 + (F.lane >> 2)] = tot;
    }
}
__device__ __forceinline__ void ph_norm2(Frame& F, int l) {
    const int gw = F.bid * NWAVES + F.wave, NGW = F.G * NWAVES;
    const float* MOD = (const float*)(F.ws + WS_MOD) + (size_t)l * 5 * 6144;
    const float* nw = F.in[I_N2W] + l * DM;
    const float* H = (const float*)(F.ws + WS_H); bf16_t* A1 = (bf16_t*)(F.ws + WS_A1);
    if (l == 0) {
        RowRegs nx, nx2; if (gw < MT) row_load(nx, H + (size_t)gw * DM, F.lane);
        if (gw + NGW < MT) row_load(nx2, H + (size_t)(gw + NGW) * DM, F.lane);
        for (int m = gw; m < MT; m += NGW) {
            const RowRegs cur = nx; nx = nx2; if (m + 2 * NGW < MT) row_load(nx2, H + (size_t)(m + 2 * NGW) * DM, F.lane);
            const int r = (m % TT) < NCTX ? 4 : m / TT;
            const float* sh = MOD + (size_t)r * 6144 + 3 * 1024; const float* sc = sh + 1024;
            float ss = 0.f;
#pragma unroll
            for (int j = 0; j < 4; ++j) ss += (cur.v[j].x * cur.v[j].x + cur.v[j].y * cur.v[j].y) + (cur.v[j].z * cur.v[j].z + cur.v[j].w * cur.v[j].w);
            const float rstd = 1.0f / sqrtf(wave_sum(ss) * (1.f / DM) + EPS);
#pragma unroll
            for (int j = 0; j < 4; ++j) { const int k0 = 256 * j + 4 * F.lane;
                const f32x4 w4 = *(const f32x4*)(nw + k0), s4 = *(const f32x4*)(sh + k0), c4 = *(const f32x4*)(sc + k0);
                const f32x4 a = (cur.v[j] * rstd * w4) * (c4 + 1.0f) + s4;
                *(u32x2*)(A1 + (size_t)m * DM + k0) = (u32x2){pk2(a.x, a.y), pk2(a.z, a.w)}; }
        }
        return;
    }
    LAS float* WR = (LAS float*)F.lds;
    LAS unsigned* lcnt = (LAS unsigned*)(F.lds + 8 * 1028 * 4);
    for (int i = F.tid; i < 8192; i += 512) { const int k = i >> 3, e = i & 7; WR[e * 1028 + k] = F.in[I_ROUT][(size_t)k * 8 + e]; }
    if (F.tid < 16) lcnt[F.tid] = 0u;
    __syncthreads();
    int* TOKE = (int*)(F.ws + WS_ROUTE) + RT_TOKE; float* TOKW = (float*)(F.ws + WS_ROUTE) + RT_TOKW; int* TOKS = (int*)(F.ws + WS_ROUTE) + RT_TOKS;
    RowRegs nx, nx2; if (gw < NB * SEQ) row_load(nx, H + (size_t)((gw / SEQ) * TT + NCTX + (gw % SEQ)) * DM, F.lane);
    if (gw + NGW < NB * SEQ) { const int n2 = gw + NGW; row_load(nx2, H + (size_t)((n2 / SEQ) * TT + NCTX + (n2 % SEQ)) * DM, F.lane); }
    for (int n = gw; n < NB * SEQ; n += NGW) {
        const int b = n / SEQ, m = b * TT + NCTX + (n % SEQ);
        const RowRegs cur = nx; nx = nx2; if (n + 2 * NGW < NB * SEQ) { const int n2 = n + 2 * NGW; row_load(nx2, H + (size_t)((n2 / SEQ) * TT + NCTX + (n2 % SEQ)) * DM, F.lane); }
        const float* sh = MOD + (size_t)b * 6144 + 3 * 1024; const float* sc = sh + 1024;
        float ss = 0.f;
#pragma unroll
        for (int j = 0; j < 4; ++j) ss += (cur.v[j].x * cur.v[j].x + cur.v[j].y * cur.v[j].y) + (cur.v[j].z * cur.v[j].z + cur.v[j].w * cur.v[j].w);
        const float rstd = 1.0f / sqrtf(wave_sum(ss) * (1.f / DM) + EPS);
        float g[16];
#pragma unroll
        for (int q = 0; q < 16; ++q) g[q] = 0.f;
#pragma unroll
        for (int j = 0; j < 4; ++j) { const int k0 = 256 * j + 4 * F.lane;
            const f32x4 w4 = *(const f32x4*)(nw + k0), s4 = *(const f32x4*)(sh + k0), c4 = *(const f32x4*)(sc + k0);
            const f32x4 a = (cur.v[j] * rstd * w4) * (c4 + 1.0f) + s4;
            *(u32x2*)(A1 + (size_t)m * DM + k0) = (u32x2){pk2(a.x, a.y), pk2(a.z, a.w)};
#pragma unroll
            for (int q = 0; q < 8; ++q) { const f32x4 wg = *(const LAS f32x4*)(WR + q * 1028 + k0); g[q] += (a.x * wg.x + a.y * wg.y) + (a.z * wg.z + a.w * wg.w); } }
        const float tot = reduce16(g, F.lane);
        float lg[8];
#pragma unroll
        for (int q = 0; q < 8; ++q) lg[q] = __shfl(tot, 4 * q);
        int e1 = 0; float v1 = lg[0];
#pragma unroll
        for (int q = 1; q < 8; ++q) if (lg[q] > v1) { v1 = lg[q]; e1 = q; }
        int e2 = (e1 == 0) ? 1 : 0; float v2 = lg[e1 == 0 ? 1 : 0];
#pragma unroll
        for (int q = 0; q < 8; ++q) if (q != e1 && lg[q] > v2) { v2 = lg[q]; e2 = q; }
        if (F.lane < 2) {
            const float w1 = 1.0f / (1.0f + fast_exp(v2 - v1));
            const int e = F.lane ? e2 : e1;
            const unsigned pos = __hip_atomic_fetch_add(lcnt + e, 1u, __ATOMIC_RELAXED, __HIP_MEMORY_SCOPE_WORKGROUP);
            TOKE[2 * n + F.lane] = e; TOKW[2 * n + F.lane] = F.lane ? 1.0f - w1 : w1; TOKS[2 * n + F.lane] = (int)pos;
        }
    }
    __syncthreads();
    if (F.tid < 8) lcnt[8 + F.tid] = xb_add(F.ctl + CW_CNT + F.tid, lcnt[F.tid]);
    __syncthreads();
    VM_WAIT();
    for (int n = gw; n < NB * SEQ; n += NGW) {
        if (F.lane < 2) { const int e = TOKE[2 * n + F.lane]; TOKS[2 * n + F.lane] += (int)lcnt[8 + e]; }
    }
}
__device__ __forceinline__ void ph_moe_gather(Frame& F) {
    const int gw = F.bid * NWAVES + F.wave, NGW = F.G * NWAVES;
    int pstart[NEXP]; int acc = 0;
#pragma unroll
    for (int e = 0; e < NEXP; ++e) { const int c = (int)xb_ld(F.ctl + CW_CNT + e); pstart[e] = acc; acc += (c + 255) & ~255; }
    int* RT = (int*)(F.ws + WS_ROUTE);
    if (F.bid == 0 && F.tid == 0) {
        int nt = 0;
        for (int e = 0; e < NEXP; ++e) { const int c = (int)xb_ld(F.ctl + CW_CNT + e); for (int t = 0; t * 256 < c; ++t) { RT[RT_TILE + 2 * nt] = e; RT[RT_TILE + 2 * nt + 1] = pstart[e] + 256 * t; ++nt; } }
        RT[RT_NT] = nt;
        const int nwg = nt * 4; int full = (nwg / F.G) * F.G; if (nwg - full > F.G / 4 || nwg - full > 64) full = nwg;
        RT[RT_NT + 1] = full; RT[RT_NT + 2] = nwg - full;
        for (int i = 0; i < nwg; ++i) RT[RT_SPLITX + i] = -1;
        for (int L = full; L < nwg; ++L) { int pm, pn; pg8::static_tile(L, nt, 4, pm, pn); RT[RT_SPLITX + pm * 4 + pn] = L - full; }
    }
    const int* TOKE = RT + RT_TOKE; int* TOKS = RT + RT_TOKS;
    const bf16_t* A1 = (const bf16_t*)(F.ws + WS_A1); bf16_t* XG = (bf16_t*)(F.ws + WS_XG);
    for (int n = gw; n < NB * SEQ; n += NGW) {
        const int b = n / SEQ, m = b * TT + NCTX + (n % SEQ);
        const int e1 = TOKE[2 * n], e2 = TOKE[2 * n + 1];
        int s1 = TOKS[2 * n], s2 = TOKS[2 * n + 1];
        int p1 = 0, p2 = 0;
#pragma unroll
        for (int e = 0; e < NEXP; ++e) { p1 = (e == e1) ? pstart[e] : p1; p2 = (e == e2) ? pstart[e] : p2; }
        s1 += p1; s2 += p2;
        const u32x4* src = (const u32x4*)(A1 + (size_t)m * DM);
        const u32x4 a = src[F.lane], c = src[64 + F.lane];
        u32x4* d1 = (u32x4*)(XG + (size_t)s1 * DM); u32x4* d2 = (u32x4*)(XG + (size_t)s2 * DM);
        d1[F.lane] = a; d1[64 + F.lane] = c; d2[F.lane] = a; d2[64 + F.lane] = c;
        if (F.lane == 0) { TOKS[2 * n] = s1; TOKS[2 * n + 1] = s2; }
    }
}
__device__ __forceinline__ void ph_final(Frame& F) {
    const int gw = F.bid * NWAVES + F.wave, NGW = F.G * NWAVES;
    const float* MOD = (const float*)(F.ws + WS_MOD) + (size_t)1 * 5 * 6144;
    const float* H = (const float*)(F.ws + WS_H); const bf16_t* YM = (const bf16_t*)(F.ws + WS_YM); const bf16_t* YMP = (const bf16_t*)(F.ws + WS_YMP);
    const int* RT = (const int*)(F.ws + WS_ROUTE); const float* TOKW = (const float*)(F.ws + WS_ROUTE) + RT_TOKW;
    const float* fw = F.in[I_FNW];
    for (int n = gw; n < NB * SEQ; n += NGW) {
        const int b = n / SEQ, m = b * TT + NCTX + (n % SEQ);
        const int s1 = RT[RT_TOKS + 2 * n], s2 = RT[RT_TOKS + 2 * n + 1]; const float w1 = TOKW[2 * n], w2 = TOKW[2 * n + 1];
        const float* g5 = MOD + (size_t)b * 6144 + 5 * 1024;
        f32x4 v[4]; float ss = 0.f;
#pragma unroll
        for (int j = 0; j < 4; ++j) { const int k0 = 256 * j + 4 * F.lane;
            const f32x4 h = *(const f32x4*)(H + (size_t)m * DM + k0), gg = *(const f32x4*)(g5 + k0);
            f32x4 ya, yb;
            { const int x1 = RT[RT_SPLITX + (s1 >> 8) * 4 + j], x2 = RT[RT_SPLITX + (s2 >> 8) * 4 + j];
              if (x1 < 0) { const u32x2 t = *(const u32x2*)(YM + (size_t)s1 * DM + k0); ya = (f32x4){bflo(t.x), bfhi(t.x), bflo(t.y), bfhi(t.y)}; }
              else { ya = (f32x4){0.f, 0.f, 0.f, 0.f};
                  for (int sl = 0; sl < pg8::MOE_S; ++sl) { const u32x2 t = *(const u32x2*)(YMP + ((size_t)(x1 * pg8::MOE_S + sl) * 256 + (s1 & 255)) * 256 + 4 * F.lane); ya = ya + (f32x4){bflo(t.x), bfhi(t.x), bflo(t.y), bfhi(t.y)}; } }
              if (x2 < 0) { const u32x2 t = *(const u32x2*)(YM + (size_t)s2 * DM + k0); yb = (f32x4){bflo(t.x), bfhi(t.x), bflo(t.y), bfhi(t.y)}; }
              else { yb = (f32x4){0.f, 0.f, 0.f, 0.f};
                  for (int sl = 0; sl < pg8::MOE_S; ++sl) { const u32x2 t = *(const u32x2*)(YMP + ((size_t)(x2 * pg8::MOE_S + sl) * 256 + (s2 & 255)) * 256 + 4 * F.lane); yb = yb + (f32x4){bflo(t.x), bfhi(t.x), bflo(t.y), bfhi(t.y)}; } } }
            const f32x4 y = ya * w1 + yb * w2;
            v[j] = h + gg * y; ss += (v[j].x * v[j].x + v[j].y * v[j].y) + (v[j].z * v[j].z + v[j].w * v[j].w); }
        const float rstd = 1.0f / sqrtf(wave_sum(ss) * (1.f / DM) + EPS);
#pragma unroll
        for (int j = 0; j < 4; ++j) { const int k0 = 256 * j + 4 * F.lane; const f32x4 w4 = *(const f32x4*)(fw + k0);
            *(f32x4*)(F.out + (size_t)n * DM + k0) = v[j] * rstd * w4; }
    }
}
__device__ __forceinline__ int tokrow(int b, int dir, int P) { return b * TT + (dir == 0 ? P : (P < NCTX ? (NCTX - 1) - P : (TT + NCTX - 1) - P)); }
__device__ __forceinline__ int iclamp(int v, int lo, int hi) { return v < lo ? lo : (v > hi ? hi : v); }
__device__ __forceinline__ bf16x8 cat4(bf16x4 a, bf16x4 b) { return __builtin_shufflevector(a, b, 0, 1, 2, 3, 4, 5, 6, 7); }
__device__ __forceinline__ f32x4 mfma16(bf16x8 a, bf16x8 b, f32x4 c) { return __builtin_amdgcn_mfma_f32_16x16x32_bf16(a, b, c, 0, 0, 0); }
__device__ __forceinline__ float wave_scan_add(float v, int lane) {
#pragma unroll
    for (int o = 1; o < 64; o <<= 1) { const float t = __shfl_up(v, o); if (lane >= o) v += t; }
    return v;
}
__device__ __forceinline__ float wave_scan_max(float v, int lane) {
#pragma unroll
    for (int o = 1; o < 64; o <<= 1) { const float t = __shfl_up(v, o); if (lane >= o) v = fmaxf(v, t); }
    return v;
}
__device__ __forceinline__ float wave_max(float v) {
#pragma unroll
    for (int o = 1; o < 64; o <<= 1) v = fmaxf(v, __shfl_xor(v, o));
    return v;
}
__device__ __forceinline__ float logsigmoidf_(float x) { return fminf(x, 0.f) - __logf(1.0f + fast_exp(-fabsf(x))); }

constexpr int NA_VTC = 0, NA_VTL = 33792, NA_RPB = 108544;
template <bool LOCAL>
__device__ __forceinline__ void na_unit(Frame& F, int l, int b, int h, int sub) {
    const bf16_t* P = (const bf16_t*)(F.ws + WS_PROJ); bf16_t* BR = (bf16_t*)(F.ws + WS_BR);
    LAS bf16_t* VTC = (LAS bf16_t*)(F.lds + NA_VTC); LAS bf16_t* VTL = (LAS bf16_t*)(F.lds + NA_VTL); LAS float* RPB = (LAS float*)(F.lds + NA_RPB);
    int tid = F.tid; asm volatile("" : "+v"(tid));
    const int lane = tid & 63, w = F.wave, g = lane >> 4, c = lane & 15;
    const int ubase = LOCAL ? iclamp(2 * sub - 4, 0, 56) : 0;
    __syncthreads();
    {   const bf16_t* VG = (const bf16_t*)(F.ws + WS_VTG) + ((size_t)(b * NCH) * 1536 + V_NA + 64 * h) * 64;
#pragma unroll
        for (int it = 0; it < 4; ++it) { const int q = tid + 512 * it, dv = q >> 5, k8 = q & 31;
            *(LAS u32x4*)(VTC + dv * 264 + 8 * k8) = *(const u32x4*)(VG + ((size_t)(k8 >> 3) * 1536 + dv) * 64 + 8 * (k8 & 7)); }
        if (LOCAL) {
            const int npc = ((64 - ubase) < 9 ? (64 - ubase) : 9) * 8;
#pragma unroll
            for (int it = 0; it < 9; ++it) { const int q = tid + 512 * it, dv = q / 72, k8 = q % 72;
                if (k8 < npc) *(LAS u32x4*)(VTL + dv * 584 + 8 * k8) = *(const u32x4*)(VG + ((size_t)(4 + ubase + (k8 >> 3)) * 1536 + dv) * 64 + 8 * (k8 & 7)); }
            if (tid < 465) RPB[tid] = F.in[I_RPB][(size_t)(l * 8 + h) * 465 + tid];
        }
    }
    __syncthreads();
    const int qrow = LOCAL ? 2 * sub + (w >> 2) : 0, cb = w & 3;
    const int r0 = iclamp(qrow - 4, 0, 56), bs = iclamp(16 * cb - 8, 0, 32);
    const int mq = LOCAL ? b * TT + NCTX + qrow * 64 + 16 * cb + c : b * TT + 128 * sub + 16 * w + c;
    bf16x8 qf[2];
    qf[0] = *(const bf16x8*)(P + (size_t)mq * NPROJ + C_NAQ + 64 * h + 8 * g);
    qf[1] = *(const bf16x8*)(P + (size_t)mq * NPROJ + C_NAQ + 64 * h + 32 + 8 * g);
    constexpr int NKB = LOCAL ? 32 : 16, LB = LOCAL ? 16 : 0;
    float s[NKB][4];
    if (LOCAL) {
        const int qc = 16 * cb + c, wst = iclamp(qc - 8, 0, 48);
#pragma unroll
        for (int kb = 0; kb < 16; ++kb) { const int wr = kb >> 1, hf = kb & 1;
            const int mk = b * TT + NCTX + (r0 + wr) * 64 + bs + 16 * hf + c;
            const bf16x8 a0 = *(const bf16x8*)(P + (size_t)mk * NPROJ + C_NAK + 64 * h + 8 * g), a1 = *(const bf16x8*)(P + (size_t)mk * NPROJ + C_NAK + 64 * h + 32 + 8 * g);
            f32x4 z = (f32x4){0.f, 0.f, 0.f, 0.f}; z = mfma16(a0, qf[0], z); z = mfma16(a1, qf[1], z);
            const int dr = r0 + wr - qrow + 7;
#pragma unroll
            for (int r = 0; r < 4; ++r) { const int kc = bs + 16 * hf + 4 * g + r; const bool valid = (kc >= wst) && (kc < wst + 16); const int dc = iclamp(kc - qc + 15, 0, 30);
                s[kb][r] = valid ? z[r] * 0.125f + RPB[dr * 31 + dc] : -1e30f; } }
    }
#pragma unroll
    for (int kb = 0; kb < 16; ++kb) {
        const int mk = b * TT + 16 * kb + c;
        const bf16x8 a0 = *(const bf16x8*)(P + (size_t)mk * NPROJ + C_NAK + 64 * h + 8 * g), a1 = *(const bf16x8*)(P + (size_t)mk * NPROJ + C_NAK + 64 * h + 32 + 8 * g);
        f32x4 z = (f32x4){0.f, 0.f, 0.f, 0.f}; z = mfma16(a0, qf[0], z); z = mfma16(a1, qf[1], z);
#pragma unroll
        for (int r = 0; r < 4; ++r) s[LB + kb][r] = z[r] * 0.125f; }
    float mx = -3.0e38f;
#pragma unroll
    for (int kb = 0; kb < NKB; ++kb)
#pragma unroll
        for (int r = 0; r < 4; ++r) mx = fmaxf(mx, s[kb][r]);
    mx = fmaxf(mx, __shfl_xor(mx, 16)); mx = fmaxf(mx, __shfl_xor(mx, 32));
    float sum = 0.f;
#pragma unroll
    for (int kb = 0; kb < NKB; ++kb)
#pragma unroll
        for (int r = 0; r < 4; ++r) { const float p = fast_exp(s[kb][r] - mx); s[kb][r] = p; sum += p; }
    sum += __shfl_xor(sum, 16); sum += __shfl_xor(sum, 32);
    f32x4 o[4];
#pragma unroll
    for (int mb = 0; mb < 4; ++mb) o[mb] = (f32x4){0.f, 0.f, 0.f, 0.f};
#pragma unroll
    for (int kp = 0; kp < NKB / 2; ++kp) {
        u32x4 pw; pw.x = pk2(s[2 * kp][0], s[2 * kp][1]); pw.y = pk2(s[2 * kp][2], s[2 * kp][3]); pw.z = pk2(s[2 * kp + 1][0], s[2 * kp + 1][1]); pw.w = pk2(s[2 * kp + 1][2], s[2 * kp + 1][3]);
        const bf16x8 pf = __builtin_bit_cast(bf16x8, pw);
#pragma unroll
        for (int mb = 0; mb < 4; ++mb) { const int dv = 16 * mb + c;
            const LAS bf16_t* base = (LOCAL && kp < 8) ? VTL + dv * 584 + (r0 + kp - ubase) * 64 + bs + 4 * g : VTC + dv * 264 + 32 * (kp - (LOCAL ? 8 : 0)) + 4 * g;
            const bf16x4 lo = *(const LAS bf16x4*)base, hi = *(const LAS bf16x4*)(base + 16);
            o[mb] = mfma16(cat4(lo, hi), pf, o[mb]); } }
    const float inv = 1.0f / sum;
#pragma unroll
    for (int mb = 0; mb < 4; ++mb)
        *(u32x2*)(BR + (size_t)mq * 1536 + 64 * h + 16 * mb + 4 * g) = (u32x2){pk2(o[mb][0] * inv, o[mb][1] * inv), pk2(o[mb][2] * inv, o[mb][3] * inv)};
}

__device__ __forceinline__ void load_rope16(const bf16_t* src, int c8, int rr  , float scale, float (&x)[2][2][4]) {
#pragma unroll
    for (int hf = 0; hf < 2; ++hf)
#pragma unroll
        for (int q = 0; q < 2; ++q) { const u32x2 v = *(const u32x2*)(src + 64 * hf + 32 * q + 4 * c8);
            x[hf][q][0] = bflo(v.x) * scale; x[hf][q][1] = bfhi(v.x) * scale; x[hf][q][2] = bflo(v.y) * scale; x[hf][q][3] = bfhi(v.y) * scale; }
    if (rr >= NCTX) {
        const int t = rr - NCTX;
#pragma unroll
        for (int hf = 0; hf < 2; ++hf) { const float pos = (float)(hf ? (t & 63) : (t >> 6));
#pragma unroll
            for (int e = 0; e < 4; ++e) { const float rev = pos * (__builtin_amdgcn_exp2f(-(float)(4 * c8 + e) * 0.41524101186092030f) * 0.15915494309189535f);
                const float cs = __builtin_amdgcn_cosf(rev), sn = __builtin_amdgcn_sinf(rev);
                const float p1 = x[hf][0][e], p2 = x[hf][1][e]; x[hf][0][e] = p1 * cs - p2 * sn; x[hf][1][e] = p1 * sn + p2 * cs; } }
    }
}

constexpr int PR_LF = 0, PR_KT = 33792, PR_WSC = PR_KT + 18432;
struct PrepRegs { u32x4 z0, z1; u32x2 kq[4]; float gi, gf; };
template <bool ML>
__device__ __forceinline__ void prep_load(Frame& F, int v, int tid, PrepRegs& R) {
    const bf16_t* P = (const bf16_t*)(F.ws + WS_PROJ);
    const int C = v % NCH, sq = v / NCH, dir = sq & 1, h = (sq >> 1) & 3, b = sq >> 3, p_ = tid >> 3, c8 = tid & 7;
    const int mrow = tokrow(b, dir, 64 * C + p_);
    if (!ML) { const bf16_t* zp = P + (size_t)mrow * NPROJ + C_HGF + 512 * dir + 128 * h + 16 * c8; R.z0 = *(const u32x4*)zp; R.z1 = *(const u32x4*)(zp + 8); }
    else {
#pragma unroll
        for (int q = 0; q < 4; ++q) R.kq[q] = *(const u32x2*)(P + (size_t)mrow * NPROJ + C_MLK + 128 * h + 64 * (q >> 1) + 32 * (q & 1) + 4 * c8);
        if (tid < 64) { const float* G16 = (const float*)(F.ws + WS_G16); const int mr = tokrow(b, dir, 64 * C + tid);
            R.gi = G16[(size_t)mr * 16 + dir * 8 + h]; R.gf = G16[(size_t)mr * 16 + dir * 8 + 4 + h]; }
    }
}
template <bool ML>
__device__ __forceinline__ void prep_body(Frame& F, int l, int v, int tid, const PrepRegs& R) {
    const int C = v % NCH, sq = v / NCH, dir = sq & 1, h = (sq >> 1) & 3, b = sq >> 3;
    const int sc_ = sq * NCH + C;
    bf16_t* KTG = (bf16_t*)(F.ws + (ML ? WS_KTG1 : WS_KTG0)) + (size_t)sc_ * 8192;
    LAS float* LF = (LAS float*)(F.lds + PR_LF); LAS bf16_t* KT = (LAS bf16_t*)(F.lds + PR_KT); LAS float* WSC = (LAS float*)(F.lds + PR_WSC);
    const int lane = tid & 63, w = F.wave, g = lane >> 4, c = lane & 15;
    const int p_ = tid >> 3, c8 = tid & 7;
    const int mrow = tokrow(b, dir, 64 * C + p_);
    __syncthreads();
    if (!ML) {
        float lf[16];
#pragma unroll
        for (int q = 0; q < 4; ++q) { const unsigned wa = R.z0[q], wb = R.z1[q];
            lf[2 * q] = bflo(wa); lf[2 * q + 1] = bfhi(wa); lf[8 + 2 * q] = bflo(wb); lf[8 + 2 * q + 1] = bfhi(wb); }
#pragma unroll
        for (int e = 0; e < 16; ++e) { const int ch = dir * 512 + 128 * h + 16 * c8 + e; const float lb = (l == 0) ? 0.f : sigmoidf_(F.in[I_HGLB][1024 + ch] - F.in[I_HGLB][ch]);
            const float f = lb + (1.0f - lb) * sigmoidf_(lf[e]); lf[e] = __logf(fmaxf(f, 1e-30f)); }
        {
            unsigned lw[8];
#pragma unroll
            for (int q = 0; q < 8; ++q) { lw[q] = pk2(lf[2 * q], lf[2 * q + 1]); lf[2 * q] = bflo(lw[q]); lf[2 * q + 1] = bfhi(lw[q]); }
            bf16_t* zp = (bf16_t*)(F.ws + WS_PROJ) + (size_t)mrow * NPROJ + C_HGF + 512 * dir + 128 * h + 16 * c8;
            *(u32x4*)zp = (u32x4){lw[0], lw[1], lw[2], lw[3]}; *(u32x4*)(zp + 8) = (u32x4){lw[4], lw[5], lw[6], lw[7]}; }
#pragma unroll
        for (int q = 0; q < 4; ++q) *(LAS f32x4*)(LF + p_ * 132 + 16 * c8 + 4 * q) = (f32x4){lf[4 * q], lf[4 * q + 1], lf[4 * q + 2], lf[4 * q + 3]};
        __syncthreads();
        const int d = 16 * w + c;
        float pre[16], raw[16]; float run = 0.f;
#pragma unroll
        for (int i = 0; i < 16; ++i) { raw[i] = LF[(16 * g + i) * 132 + d]; run += raw[i]; pre[i] = run; }
        float off = 0.f, tot = 0.f;
#pragma unroll
        for (int q = 0; q < 4; ++q) { const float t = __shfl(run, c + 16 * q); tot += t; off += (q < g) ? t : 0.f; }
        unsigned pkd[8];
#pragma unroll
        for (int i = 0; i < 8; ++i) { const float k0 = (1.0f - fast_exp(raw[2 * i])) * fast_exp(tot - (off + pre[2 * i])), k1 = (1.0f - fast_exp(raw[2 * i + 1])) * fast_exp(tot - (off + pre[2 * i + 1])); pkd[i] = pk2(k0, k1); }
        if (dir == 0) {
            *(LAS u32x4*)(KT + d * 72 + 16 * g) = (u32x4){pkd[0], pkd[1], pkd[2], pkd[3]};
            *(LAS u32x4*)(KT + d * 72 + 16 * g + 8) = (u32x4){pkd[4], pkd[5], pkd[6], pkd[7]};
        } else {
#pragma unroll
            for (int i = 0; i < 8; ++i) pkd[i] = (pkd[i] >> 16) | (pkd[i] << 16);
            *(LAS u32x4*)(KT + d * 72 + 16 * (3 - g)) = (u32x4){pkd[7], pkd[6], pkd[5], pkd[4]};
            *(LAS u32x4*)(KT + d * 72 + 16 * (3 - g) + 8) = (u32x4){pkd[3], pkd[2], pkd[1], pkd[0]};
        }
        if (g == 0) ((float*)(F.ws + WS_DEC))[(size_t)sc_ * 128 + d] = fast_exp(tot);
    } else {
        if (w == 0) {
            const float gbi = F.in[I_MLGB][((l * 2 + dir) * 2 + 0) * 4 + h], gbf = F.in[I_MLGB][((l * 2 + dir) * 2 + 1) * 4 + h];
            const float ig = R.gi + gbi, lfg = logsigmoidf_(R.gf + gbf);
            const float bb = wave_scan_add(lfg, lane), bend = __shfl(bb, 63);
            const float e = bend - bb + ig, mloc = wave_max(e);
            WSC[lane] = fast_exp(e - mloc);
            if (lane == 0) { float* ms = (float*)(F.ws + WS_MLS) + (size_t)sc_ * 2; ms[0] = bend; ms[1] = mloc; }
        }
        __syncthreads();
        float x[2][2][4];
        const float scale = 0.08838834764831845f * WSC[p_];
#pragma unroll
        for (int hf = 0; hf < 2; ++hf)
#pragma unroll
            for (int q = 0; q < 2; ++q) { const u32x2 vq = R.kq[2 * hf + q];
                x[hf][q][0] = bflo(vq.x) * scale; x[hf][q][1] = bfhi(vq.x) * scale; x[hf][q][2] = bflo(vq.y) * scale; x[hf][q][3] = bfhi(vq.y) * scale; }
        const int rr = mrow % TT;
        if (rr >= NCTX) { const int t = rr - NCTX;
#pragma unroll
            for (int hf = 0; hf < 2; ++hf) { const float pos = (float)(hf ? (t & 63) : (t >> 6));
#pragma unroll
                for (int e = 0; e < 4; ++e) { const float rev = pos * (__builtin_amdgcn_exp2f(-(float)(4 * c8 + e) * 0.41524101186092030f) * 0.15915494309189535f);
                    const float cs = __builtin_amdgcn_cosf(rev), sn = __builtin_amdgcn_sinf(rev);
                    const float p1 = x[hf][0][e], p2 = x[hf][1][e]; x[hf][0][e] = p1 * cs - p2 * sn; x[hf][1][e] = p1 * sn + p2 * cs; } } }
        const int n_ = dir == 0 ? p_ : 63 - p_;
#pragma unroll
        for (int hf = 0; hf < 2; ++hf)
#pragma unroll
            for (int q = 0; q < 2; ++q)
#pragma unroll
                for (int e = 0; e < 4; ++e) KT[(64 * hf + 32 * q + 4 * c8 + e) * 72 + n_] = (bf16_t)f2bf(x[hf][q][e]);
    }
    __syncthreads();
#pragma unroll
    for (int it = 0; it < 2; ++it) { const int q = tid + 512 * it, row = q >> 3, c16 = q & 7;
        *(u32x4*)(KTG + row * 64 + 8 * c16) = *(const LAS u32x4*)(KT + row * 72 + 8 * c16); }
    if (ML && tid < 128) {
        float ns = 0.f;
#pragma unroll
        for (int q = 0; q < 8; ++q) { const u32x4 vq = *(const LAS u32x4*)(KT + tid * 72 + 8 * q);
            ns += (bflo(vq.x) + bfhi(vq.x)) + (bflo(vq.y) + bfhi(vq.y)) + (bflo(vq.z) + bfhi(vq.z)) + (bflo(vq.w) + bfhi(vq.w)); }
        ((float*)(F.ws + WS_NSG))[(size_t)sc_ * 128 + tid] = ns;
    }
}
template <bool ML>
__device__ __forceinline__ void prep_loop(Frame& F, int l) {
    int tid = F.tid; asm volatile("" : "+v"(tid));
    const int nblk = F.G, first = F.bid;
    PrepRegs nxt;
    if (first < 32 * NCH) prep_load<ML>(F, first, tid, nxt);
    for (int v = first; v < 32 * NCH; v += nblk) {
        const PrepRegs cur = nxt;
        if (v + nblk < 32 * NCH) prep_load<ML>(F, v + nblk, tid, nxt);
        prep_body<ML>(F, l, v, tid, cur);
    }
}

constexpr int SCAN_RD = 8;
constexpr int SC_SM = 0, SC_SM2 = 34816, SC_SLOT = 35840, SC_SLOTB = 27648;
struct ScanRegs { u32x4 k0, k1, v0; };
template <bool ML>
__device__ __forceinline__ void scan_unit(Frame& F, int b, int h, int dir, int vs) {
    const int sq = (b * 4 + h) * 2 + dir;
    const bf16_t* KTG = (const bf16_t*)(F.ws + (ML ? WS_KTG1 : WS_KTG0)) + (size_t)sq * NCH * 8192;
    const bf16_t* VG = (const bf16_t*)(F.ws + WS_VTG) + ((size_t)(b * NCH) * 1536 + (ML ? V_ML : V_HG) + 128 * h + 64 * vs) * 64;
    bf16_t* SP = (bf16_t*)(F.ws + WS_SP) + ((size_t)(((ML ? 1 : 0) * 32 + sq) * NCH)) * 16384;
    float* NST = (float*)(F.ws + WS_NST) + (size_t)(sq * NCH) * 132;
    int tid = F.tid; asm volatile("" : "+v"(tid));
    const int lane = tid & 63, w = F.wave, g = lane >> 4, c = lane & 15, ks = w & 3, nbh = w >> 2;
    LAS float* SM = (LAS float*)(F.lds + SC_SM); LAS float* SM2 = (LAS float*)(F.lds + SC_SM2);
    const int krow = tid >> 3, kc8 = tid & 7;
#define SCAN_LOAD(R, Cc) do { const int cc_ = (Cc); const int cn_ = dir == 0 ? cc_ : (cc_ < 4 ? 3 - cc_ : 71 - cc_); \
        const bf16_t* kp_ = KTG + (size_t)cc_ * 8192 + krow * 64 + 8 * kc8; (R).k0 = *(const u32x4*)kp_; (R).k1 = *(const u32x4*)(kp_ + 64 * 64); \
        (R).v0 = *(const u32x4*)(VG + ((size_t)cn_ * 1536 + krow) * 64 + 8 * kc8); } while (0)
#define SCAN_PARK(R, slot) do { LAS bf16_t* kt_ = (LAS bf16_t*)(F.lds + SC_SLOT + (slot) * SC_SLOTB); \
        *(LAS u32x4*)(kt_ + krow * 72 + 8 * kc8) = (R).k0; *(LAS u32x4*)(kt_ + (krow + 64) * 72 + 8 * kc8) = (R).k1; *(LAS u32x4*)(kt_ + 128 * 72 + krow * 72 + 8 * kc8) = (R).v0; } while (0)
    ScanRegs ring[SCAN_RD];
    __syncthreads();
    {   ScanRegs r0; SCAN_LOAD(r0, 0);
#pragma unroll
        for (int j = 0; j < SCAN_RD; ++j) SCAN_LOAD(ring[(j + 1) % SCAN_RD], j + 1);
        const float* src = (const float*)(F.ws + (ML ? WS_NSG : WS_DEC)) + (size_t)sq * NCH * 128;
        for (int i = tid; i < NCH * 128 / 4; i += 512) *(LAS f32x4*)(SM + 4 * i) = *(const f32x4*)(src + 4 * i);
        if (ML && tid < NCH * 2) SM2[tid] = ((const float*)(F.ws + WS_MLS))[(size_t)sq * NCH * 2 + tid];
        SCAN_PARK(r0, 0); }
    __syncthreads();
    f32x4 acc[2][2];
#pragma unroll
    for (int mb = 0; mb < 2; ++mb)
#pragma unroll
        for (int nb = 0; nb < 2; ++nb) acc[mb][nb] = (f32x4){0.f, 0.f, 0.f, 0.f};
    float m_old = 0.f, nreg = 0.f;
    for (int C0 = 0; C0 < NCH; C0 += SCAN_RD) {
#pragma unroll
        for (int j = 0; j < SCAN_RD; ++j) {
            const int C = C0 + j;
            if (C >= NCH) break;
            SCAN_PARK(ring[(j + 1) % SCAN_RD], (C + 1) & 1); { const int cl_ = C + 1 + SCAN_RD; SCAN_LOAD(ring[(j + 1) % SCAN_RD], cl_ < NCH ? cl_ : NCH - 1); }
            const LAS bf16_t* kt = (const LAS bf16_t*)(F.lds + SC_SLOT + (C & 1) * SC_SLOTB); const LAS bf16_t* vt = kt + 128 * 72;
            const bf16x8 a00 = *(const LAS bf16x8*)(kt + (32 * ks + c) * 72 + 8 * g), a01 = *(const LAS bf16x8*)(kt + (32 * ks + c) * 72 + 32 + 8 * g);
            const bf16x8 a10 = *(const LAS bf16x8*)(kt + (32 * ks + 16 + c) * 72 + 8 * g), a11 = *(const LAS bf16x8*)(kt + (32 * ks + 16 + c) * 72 + 32 + 8 * g);
            float sc = 1.f; f32x4 d0, d1;
            if (ML) {
                const float bend = SM2[2 * C], mloc = SM2[2 * C + 1];
                const float mnew = fmaxf(bend + m_old, mloc), w_old = fast_exp(bend + m_old - mnew);
                sc = fast_exp(mloc - mnew);
                if (tid < 128) { const float nsv = SM[C * 128 + tid]; SM[C * 128 + tid] = nreg; nreg = w_old * nreg + sc * nsv; }
                if (tid == 0) SM2[2 * NCH + C] = m_old;
                m_old = mnew; d0 = (f32x4){w_old, w_old, w_old, w_old}; d1 = d0;
            } else { d0 = *(const LAS f32x4*)(SM + C * 128 + 32 * ks + 4 * g); d1 = *(const LAS f32x4*)(SM + C * 128 + 32 * ks + 16 + 4 * g); }
#pragma unroll
            for (int nb = 0; nb < 2; ++nb)
                *(u32x4*)(SP + (size_t)C * 16384 + (size_t)(((ks * 8 + 4 * vs + 2 * nbh + nb) * 64 + lane) * 8)) =
                    (u32x4){pk2(acc[0][nb][0], acc[0][nb][1]), pk2(acc[0][nb][2], acc[0][nb][3]), pk2(acc[1][nb][0], acc[1][nb][1]), pk2(acc[1][nb][2], acc[1][nb][3])};
#pragma unroll
            for (int nb = 0; nb < 2; ++nb) {
                const bf16x8 bk0 = *(const LAS bf16x8*)(vt + (32 * nbh + 16 * nb + c) * 72 + 8 * g), bk1 = *(const LAS bf16x8*)(vt + (32 * nbh + 16 * nb + c) * 72 + 32 + 8 * g);
                if (ML) {
                    f32x4 t0 = (f32x4){0.f, 0.f, 0.f, 0.f}, t1 = t0;
                    t0 = mfma16(a00, bk0, t0); t0 = mfma16(a01, bk1, t0); t1 = mfma16(a10, bk0, t1); t1 = mfma16(a11, bk1, t1);
                    acc[0][nb] = acc[0][nb] * d0 + t0 * sc; acc[1][nb] = acc[1][nb] * d1 + t1 * sc;
                } else {
                    acc[0][nb] = acc[0][nb] * d0; acc[1][nb] = acc[1][nb] * d1;
                    acc[0][nb] = mfma16(a00, bk0, acc[0][nb]); acc[0][nb] = mfma16(a01, bk1, acc[0][nb]); acc[1][nb] = mfma16(a10, bk0, acc[1][nb]); acc[1][nb] = mfma16(a11, bk1, acc[1][nb]); }
            }
            __syncthreads();
        }
    }
    if (ML && vs == 0) {
        __syncthreads();
        for (int i = tid; i < NCH * 128; i += 512) NST[(size_t)(i >> 7) * 132 + (i & 127)] = SM[i];
        if (tid < NCH) NST[(size_t)tid * 132 + 128] = SM2[2 * NCH + tid];
    }
#undef SCAN_LOAD
#undef SCAN_PARK
}

constexpr int R2_QS = 0, R2_GT = 17408, R2_KS = 51200, R2_ST = 51200  , R2_VT = 83968, R2_AM = 102400, R2_OT = 111616, R2_SEG = 145408, R2_SC = 147456;
__device__ __forceinline__ bf16x8 hg_frag(const LAS bf16_t* X, const LAS float* G, int row, int ks, int g, const LAS float* ref, float sgn) {
    const u32x4 xv = *(const LAS u32x4*)(X + row * 136 + 32 * ks + 8 * g);
    f32x4 g0 = *(const LAS f32x4*)(G + row * 132 + 32 * ks + 8 * g), g1 = *(const LAS f32x4*)(G + row * 132 + 32 * ks + 8 * g + 4);
    if (ref) { g0 = g0 - *(const LAS f32x4*)(ref + 32 * ks + 8 * g); g1 = g1 - *(const LAS f32x4*)(ref + 32 * ks + 8 * g + 4); }
    u32x4 o;
    o.x = pk2(bflo(xv.x) * fast_exp(sgn * g0.x), bfhi(xv.x) * fast_exp(sgn * g0.y)); o.y = pk2(bflo(xv.y) * fast_exp(sgn * g0.z), bfhi(xv.y) * fast_exp(sgn * g0.w));
    o.z = pk2(bflo(xv.z) * fast_exp(sgn * g1.x), bfhi(xv.z) * fast_exp(sgn * g1.y)); o.w = pk2(bflo(xv.w) * fast_exp(sgn * g1.z), bfhi(xv.w) * fast_exp(sgn * g1.w));
    return __builtin_bit_cast(bf16x8, o);
}
__device__ __forceinline__ bf16x8 hg_frag_perm(const LAS bf16_t* X, const LAS float* G, int row, int ks, int g) {
    const u32x2 xa = *(const LAS u32x2*)(X + row * 136 + 32 * ks + 4 * g), xb = *(const LAS u32x2*)(X + row * 136 + 32 * ks + 16 + 4 * g);
    const f32x4 g0 = *(const LAS f32x4*)(G + row * 132 + 32 * ks + 4 * g), g1 = *(const LAS f32x4*)(G + row * 132 + 32 * ks + 16 + 4 * g);
    u32x4 o;
    o.x = pk2(bflo(xa.x) * fast_exp(g0.x), bfhi(xa.x) * fast_exp(g0.y)); o.y = pk2(bflo(xa.y) * fast_exp(g0.z), bfhi(xa.y) * fast_exp(g0.w));
    o.z = pk2(bflo(xb.x) * fast_exp(g1.x), bfhi(xb.x) * fast_exp(g1.y)); o.w = pk2(bflo(xb.y) * fast_exp(g1.z), bfhi(xb.y) * fast_exp(g1.w));
    return __builtin_bit_cast(bf16x8, o);
}
struct R2Regs { u32x4 rows[4]; u32x4 aux[2]; float gi, gf; };
#define R2_DECL \
    const bf16_t* P = (const bf16_t*)(F.ws + WS_PROJ); bf16_t* BR = (bf16_t*)(F.ws + WS_BR); \
    LAS bf16_t* QS = (LAS bf16_t*)(F.lds + R2_QS); LAS bf16_t* KS = (LAS bf16_t*)(F.lds + R2_KS); LAS float* GT = (LAS float*)(F.lds + R2_GT); \
    LAS bf16_t* VT = (LAS bf16_t*)(F.lds + R2_VT); LAS bf16_t* AM = (LAS bf16_t*)(F.lds + R2_AM); LAS float* OT = (LAS float*)(F.lds + R2_OT); \
    LAS bf16_t* STL = (LAS bf16_t*)(F.lds + R2_ST); LAS float* SEG = (LAS float*)(F.lds + R2_SEG); LAS float* SC = (LAS float*)(F.lds + R2_SC); \
    LAS float* S_AS = SC, *S_MU = SC + 64, *S_WI = SC + 128, *S_FL = SC + 192, *S_QN = SC + 256, *S_DEN = SC + 320; \
    const int lane = tid & 63, w = F.wave, g = lane >> 4, c = lane & 15, p_ = tid >> 3, c8 = tid & 7; \
    (void)P; (void)BR; (void)QS; (void)KS; (void)GT; (void)VT; (void)AM; (void)OT; (void)STL; (void)SEG; (void)S_AS; (void)S_MU; (void)S_WI; (void)S_FL; (void)S_QN; (void)S_DEN; (void)lane; (void)w; (void)g; (void)c; (void)p_; (void)c8;
template <bool ML>
__device__ __forceinline__ void r2_load(Frame& F, int b, int h, int cn, int dir, int tid, R2Regs& R) {

    const bf16_t* P = (const bf16_t*)(F.ws + WS_PROJ);
    const int p_ = tid >> 3, c8 = tid & 7;
    const int C = dir == 0 ? cn : (cn < 4 ? 3 - cn : 71 - cn);
    const int mrow = tokrow(b, dir, 64 * C + p_);
    if (!ML) {
        const bf16_t* qp = P + (size_t)mrow * NPROJ + C_HGQ + 128 * h + 16 * c8;
        const bf16_t* zp = P + (size_t)mrow * NPROJ + C_HGF + 512 * dir + 128 * h + 16 * c8;
        R.rows[0] = *(const u32x4*)qp; R.rows[1] = *(const u32x4*)(qp + 8); R.rows[2] = *(const u32x4*)zp; R.rows[3] = *(const u32x4*)(zp + 8);
    } else {
#pragma unroll
        for (int q = 0; q < 4; ++q) {
            const u32x2 vq = *(const u32x2*)(P + (size_t)mrow * NPROJ + C_MLQ + 128 * h + 64 * (q >> 1) + 32 * (q & 1) + 4 * c8);
            const u32x2 vk = *(const u32x2*)(P + (size_t)mrow * NPROJ + C_MLK + 128 * h + 64 * (q >> 1) + 32 * (q & 1) + 4 * c8);
            if (q & 1) { R.rows[q >> 1].z = vq.x; R.rows[q >> 1].w = vq.y; R.rows[2 + (q >> 1)].z = vk.x; R.rows[2 + (q >> 1)].w = vk.y; }
            else { R.rows[q >> 1].x = vq.x; R.rows[q >> 1].y = vq.y; R.rows[2 + (q >> 1)].x = vk.x; R.rows[2 + (q >> 1)].y = vk.y; } }
        if (tid < 64) { const float* G16 = (const float*)(F.ws + WS_G16); const int mr = tokrow(b, dir, 64 * C + tid);
            R.gi = G16[(size_t)mr * 16 + dir * 8 + h]; R.gf = G16[(size_t)mr * 16 + dir * 8 + 4 + h]; }
    }
    if (dir == 0) {
        const bf16_t* VG = (const bf16_t*)(F.ws + WS_VTG) + ((size_t)(b * NCH + cn) * 1536 + (ML ? V_ML : V_HG) + 128 * h) * 64;
#pragma unroll
        for (int it = 0; it < 2; ++it) { const int q = tid + 512 * it; R.aux[it] = *(const u32x4*)(VG + (size_t)(q >> 3) * 64 + 8 * (q & 7)); }
    } else {
        const bf16_t* gp = P + (size_t)(b * TT + 64 * cn + p_) * NPROJ + (ML ? C_MLO : C_HGG) + 128 * h + 16 * c8;
        R.aux[0] = *(const u32x4*)gp; R.aux[1] = *(const u32x4*)(gp + 8);
    }
}
template <bool ML>
__device__ __forceinline__ void r2_dir(Frame& F, int l, int b, int h, int cn, int dir, int tid, const R2Regs& R) {

    R2_DECL
    const int C = dir == 0 ? cn : (cn < 4 ? 3 - cn : 71 - cn);
    const int mrow = tokrow(b, dir, 64 * C + p_);
    const float* NSTc = (const float*)(F.ws + WS_NST) + ((size_t)(((b * 4 + h) * 2 + dir) * NCH) + C) * 132;
    u32x4 stq[4];
    {   const bf16_t* ST = (const bf16_t*)(F.ws + WS_SP) + ((size_t)((((ML ? 1 : 0) * 4 + b) * 4 + h) * 2 + dir) * NCH + C) * 16384;
#pragma unroll
        for (int it = 0; it < 4; ++it) stq[it] = *(const u32x4*)(ST + (size_t)(tid + 512 * it) * 8); }
    __syncthreads();
    if (dir == 0) {
#pragma unroll
        for (int it = 0; it < 2; ++it) { const int q = tid + 512 * it; *(LAS u32x4*)(VT + (q >> 3) * 72 + 8 * (q & 7)) = R.aux[it]; } }
    if (!ML) {
        const u32x4 q0 = R.rows[0], q1 = R.rows[1], z0 = R.rows[2], z1 = R.rows[3];
        float qv[16], lf[16];
#pragma unroll
        for (int q = 0; q < 4; ++q) { qv[2 * q] = bflo(q0[q]); qv[2 * q + 1] = bfhi(q0[q]); qv[8 + 2 * q] = bflo(q1[q]); qv[8 + 2 * q + 1] = bfhi(q1[q]);
            lf[2 * q] = bflo(z0[q]); lf[2 * q + 1] = bfhi(z0[q]); lf[8 + 2 * q] = bflo(z1[q]); lf[8 + 2 * q + 1] = bfhi(z1[q]); }
        unsigned qk[8], kk[8];
#pragma unroll
        for (int e = 0; e < 16; e += 2) {
            const float f0 = fast_exp(lf[e]), f1 = fast_exp(lf[e + 1]);
            kk[e >> 1] = pk2(1.0f - f0, 1.0f - f1); qk[e >> 1] = pk2(siluf_(qv[e]), siluf_(qv[e + 1])); }
        *(LAS u32x4*)(QS + p_ * 136 + 16 * c8) = (u32x4){qk[0], qk[1], qk[2], qk[3]}; *(LAS u32x4*)(QS + p_ * 136 + 16 * c8 + 8) = (u32x4){qk[4], qk[5], qk[6], qk[7]};
        *(LAS u32x4*)(KS + p_ * 136 + 16 * c8) = (u32x4){kk[0], kk[1], kk[2], kk[3]}; *(LAS u32x4*)(KS + p_ * 136 + 16 * c8 + 8) = (u32x4){kk[4], kk[5], kk[6], kk[7]};
#pragma unroll
        for (int q = 0; q < 4; ++q) *(LAS f32x4*)(GT + p_ * 132 + 16 * c8 + 4 * q) = (f32x4){lf[4 * q], lf[4 * q + 1], lf[4 * q + 2], lf[4 * q + 3]};
        __syncthreads();
        {
            const int d = 16 * w + c;
            float pre[16]; float run = 0.f;
#pragma unroll
            for (int i = 0; i < 16; ++i) { run += GT[(16 * g + i) * 132 + d]; pre[i] = run; }
            float off = 0.f;
#pragma unroll
            for (int q = 0; q < 4; ++q) { const float t = __shfl(run, c + 16 * q); off += (q < g) ? t : 0.f; }
#pragma unroll
            for (int i = 0; i < 16; ++i) GT[(16 * g + i) * 132 + d] = off + pre[i]; }
    } else {
        float xq[2][2][4], xk[2][2][4];
#pragma unroll
        for (int hf = 0; hf < 2; ++hf) {
            const u32x4 vq = R.rows[hf], vk = R.rows[2 + hf];
            xq[hf][0][0] = bflo(vq.x); xq[hf][0][1] = bfhi(vq.x); xq[hf][0][2] = bflo(vq.y); xq[hf][0][3] = bfhi(vq.y); xq[hf][1][0] = bflo(vq.z); xq[hf][1][1] = bfhi(vq.z); xq[hf][1][2] = bflo(vq.w); xq[hf][1][3] = bfhi(vq.w);
            const float ksc = 0.08838834764831845f;
            xk[hf][0][0] = bflo(vk.x) * ksc; xk[hf][0][1] = bfhi(vk.x) * ksc; xk[hf][0][2] = bflo(vk.y) * ksc; xk[hf][0][3] = bfhi(vk.y) * ksc; xk[hf][1][0] = bflo(vk.z) * ksc; xk[hf][1][1] = bfhi(vk.z) * ksc; xk[hf][1][2] = bflo(vk.w) * ksc; xk[hf][1][3] = bfhi(vk.w) * ksc; }
        { const int rr = mrow % TT;
          if (rr >= NCTX) { const int t = rr - NCTX;
#pragma unroll
            for (int hf = 0; hf < 2; ++hf) { const float pos = (float)(hf ? (t & 63) : (t >> 6));
#pragma unroll
                for (int e = 0; e < 4; ++e) { const float rev = pos * (__builtin_amdgcn_exp2f(-(float)(4 * c8 + e) * 0.41524101186092030f) * 0.15915494309189535f);
                    const float cs = __builtin_amdgcn_cosf(rev), sn = __builtin_amdgcn_sinf(rev);
                    const float a1 = xq[hf][0][e], a2 = xq[hf][1][e]; xq[hf][0][e] = a1 * cs - a2 * sn; xq[hf][1][e] = a1 * sn + a2 * cs;
                    const float b1 = xk[hf][0][e], b2 = xk[hf][1][e]; xk[hf][0][e] = b1 * cs - b2 * sn; xk[hf][1][e] = b1 * sn + b2 * cs; } } } }
        float qn = 0.f;
#pragma unroll
        for (int hf = 0; hf < 2; ++hf)
#pragma unroll
            for (int q = 0; q < 2; ++q) { const int ch = 64 * hf + 32 * q + 4 * c8;
                const f32x4 nv = *(const f32x4*)(NSTc + ch);
                qn += (xq[hf][q][0] * nv.x + xq[hf][q][1] * nv.y) + (xq[hf][q][2] * nv.z + xq[hf][q][3] * nv.w);
                *(LAS u32x2*)(QS + p_ * 136 + ch) = (u32x2){pk2(xq[hf][q][0], xq[hf][q][1]), pk2(xq[hf][q][2], xq[hf][q][3])};
                *(LAS u32x2*)(KS + p_ * 136 + ch) = (u32x2){pk2(xk[hf][q][0], xk[hf][q][1]), pk2(xk[hf][q][2], xk[hf][q][3])}; }
        qn += __shfl_xor(qn, 1); qn += __shfl_xor(qn, 2); qn += __shfl_xor(qn, 4);
        if (c8 == 0) S_QN[p_] = qn;
        if (w == 0) {
            const int mr = tokrow(b, dir, 64 * C + lane);
            const float gbi = F.in[I_MLGB][((l * 2 + dir) * 2 + 0) * 4 + h], gbf = F.in[I_MLGB][((l * 2 + dir) * 2 + 1) * 4 + h];
            const float ig = R.gi + gbi, lfg = logsigmoidf_(R.gf + gbf);
            const float bb = wave_scan_add(lfg, lane), a = ig - bb, mu = fmaxf(NSTc[128], wave_scan_max(a, lane));
            S_AS[lane] = a; S_MU[lane] = mu; S_WI[lane] = fast_exp(NSTc[128] - mu); S_FL[lane] = fast_exp(-bb - mu);
        }
    }
    __syncthreads();
    if (!ML) {
        const int J = w < 4 ? w : (w == 4 ? 0 : (w == 5 ? 1 : (w == 6 ? 0 : 2)));
        const int I0 = w < 4 ? w : (w == 4 ? 1 : (w == 5 ? 2 : 3));
        const int nblk = (w == 4 || w == 5) ? 2 : 1;
        const LAS float* ref = GT + ((w < 4) ? 16 * J + 8 : 16 * J + 15) * 132;
        f32x4 z0 = (f32x4){0.f, 0.f, 0.f, 0.f}, z1 = z0;
#pragma unroll
        for (int ks = 0; ks < 4; ++ks) {
            const bf16x8 kf = hg_frag(KS, GT, 16 * J + c, ks, g, ref, -1.0f);
            z0 = mfma16(kf, hg_frag(QS, GT, 16 * I0 + c, ks, g, ref, 1.0f), z0);
            if (nblk == 2) z1 = mfma16(kf, hg_frag(QS, GT, 16 * (I0 + 1) + c, ks, g, ref, 1.0f), z1);
        }
        for (int q = 0; q < nblk; ++q) {
            const int I = I0 + q;
            f32x4 z = q ? z1 : z0;
            if (I == J) {
#pragma unroll
                for (int r = 0; r < 4; ++r) z[r] = (4 * g + r <= c) ? z[r] : 0.f; }
            if (dir == 0) *(LAS u32x2*)(AM + (16 * I + c) * 72 + 16 * J + 4 * g) = (u32x2){pk2(z[0], z[1]), pk2(z[2], z[3])};
            else *(LAS u32x2*)(AM + (16 * I + c) * 72 + 16 * (3 - J) + 12 - 4 * g) = (u32x2){pk2(z[3], z[2]), pk2(z[1], z[0])};
        }
        if (w == 7) {
            for (int i = lane; i < 6 * 16 * 2; i += 64) { const int blk = i >> 5, rr = (i >> 1) & 15, hh = i & 1;
                const int Iz = blk < 3 ? 0 : (blk < 5 ? 1 : 2), Jz = blk < 3 ? 1 + blk : (blk < 5 ? blk - 1 : 3);
                *(LAS u32x4*)(AM + (16 * Iz + rr) * 72 + 16 * (dir == 0 ? Jz : 3 - Jz) + 8 * hh) = (u32x4){0u, 0u, 0u, 0u}; }
        }
    } else {
        const int I = w & 3, par = w >> 2;
        float dsum = 0.f;
        const float mu = S_MU[16 * I + c];
        for (int J = par; J < 4; J += 2) {
            if (J <= I) {
                f32x4 z = (f32x4){0.f, 0.f, 0.f, 0.f};
#pragma unroll
                for (int ks = 0; ks < 4; ++ks) z = mfma16(*(const LAS bf16x8*)(KS + (16 * J + c) * 136 + 32 * ks + 8 * g), *(const LAS bf16x8*)(QS + (16 * I + c) * 136 + 32 * ks + 8 * g), z);
                const f32x4 as = *(const LAS f32x4*)(S_AS + 16 * J + 4 * g);
#pragma unroll
                for (int r = 0; r < 4; ++r) { const bool ok = (J < I) || (4 * g + r <= c); z[r] = ok ? fast_exp(as[r] - mu) * z[r] : 0.f; dsum += z[r]; }
                if (dir == 0) *(LAS u32x2*)(AM + (16 * I + c) * 72 + 16 * J + 4 * g) = (u32x2){pk2(z[0], z[1]), pk2(z[2], z[3])};
                else *(LAS u32x2*)(AM + (16 * I + c) * 72 + 16 * (3 - J) + 12 - 4 * g) = (u32x2){pk2(z[3], z[2]), pk2(z[1], z[0])};
            } else {
                *(LAS u32x2*)(AM + (16 * I + c) * 72 + 16 * (dir == 0 ? J : 3 - J) + 4 * g) = (u32x2){0u, 0u};
            }
        }
        dsum += __shfl_xor(dsum, 16); dsum += __shfl_xor(dsum, 32);
        if (g == 0) S_DEN[par * 64 + 16 * I + c] = dsum;
    }
    __syncthreads();
#pragma unroll
    for (int it = 0; it < 4; ++it) *(LAS u32x4*)(STL + (tid + 512 * it) * 8) = stq[it];
    __syncthreads();
    {
        const int I = w & 3, half = w >> 2;
        f32x4 o[4];
#pragma unroll
        for (int nb = 0; nb < 4; ++nb) o[nb] = (f32x4){0.f, 0.f, 0.f, 0.f};
#pragma unroll
        for (int ks = 0; ks < 4; ++ks) {
            const bf16x8 af = ML ? cat4(*(const LAS bf16x4*)(QS + (16 * I + c) * 136 + 32 * ks + 4 * g), *(const LAS bf16x4*)(QS + (16 * I + c) * 136 + 32 * ks + 16 + 4 * g)) : hg_frag_perm(QS, GT, 16 * I + c, ks, g);
#pragma unroll
            for (int nb = 0; nb < 4; ++nb) { const bf16x8 bf = *(const LAS bf16x8*)(STL + ((ks * 8 + 4 * half + nb) * 64 + lane) * 8); o[nb] = mfma16(af, bf, o[nb]); } }
        if (ML) { const f32x4 wi = *(const LAS f32x4*)(S_WI + 16 * I + 4 * g);
#pragma unroll
            for (int nb = 0; nb < 4; ++nb) o[nb] = o[nb] * wi; }
#pragma unroll
        for (int kp = 0; kp < 2; ++kp) {
            const bf16x8 af = *(const LAS bf16x8*)(AM + (16 * I + c) * 72 + 32 * kp + 8 * g);
#pragma unroll
            for (int nb = 0; nb < 4; ++nb) { const bf16x8 bf = *(const LAS bf16x8*)(VT + (64 * half + 16 * nb + c) * 72 + 32 * kp + 8 * g); o[nb] = mfma16(af, bf, o[nb]); } }
        f32x4 rs = (f32x4){1.f, 1.f, 1.f, 1.f};
        if (ML) {
#pragma unroll
            for (int r = 0; r < 4; ++r) { const int pp = 16 * I + 4 * g + r; const float den = S_DEN[pp] + S_DEN[64 + pp] + S_WI[pp] * S_QN[pp]; rs[r] = fast_rcp(fmaxf(fabsf(den), S_FL[pp])); } }
#pragma unroll
        for (int r = 0; r < 4; ++r) { const int pp = 16 * I + 4 * g + r; const int nl = dir == 0 ? pp : 63 - pp;
#pragma unroll
            for (int nb = 0; nb < 4; ++nb) { LAS float* op = OT + nl * 132 + 64 * half + 16 * nb + c; const float val = o[nb][r] * rs[r]; *op = (dir == 0) ? val : *op + val; } }
    }
}
template <bool ML>
__device__ __forceinline__ void r2_finish(Frame& F, int l, int b, int h, int cn, int tid, const R2Regs& R) {
    R2_DECL
    __syncthreads();
    {
        const int m = b * TT + 64 * cn + p_;
        float ov[16]; float ss = 0.f;
#pragma unroll
        for (int q = 0; q < 4; ++q) { const f32x4 t = *(const LAS f32x4*)(OT + p_ * 132 + 16 * c8 + 4 * q); ov[4 * q] = t.x; ov[4 * q + 1] = t.y; ov[4 * q + 2] = t.z; ov[4 * q + 3] = t.w; ss += (t.x * t.x + t.y * t.y) + (t.z * t.z + t.w * t.w); }
        ss += __shfl_xor(ss, 1); ss += __shfl_xor(ss, 2); ss += __shfl_xor(ss, 4);
        const float rstd = 1.0f / sqrtf(ss * (1.0f / 128.0f) + EPS);
        const u32x4 g0 = R.aux[0], g1 = R.aux[1];
        const float* nw = F.in[ML ? I_MLNW : I_HGNW] + l * 512 + 128 * h + 16 * c8;
        unsigned ow[8];
#pragma unroll
        for (int q = 0; q < 8; ++q) { const unsigned gw_ = q < 4 ? g0[q] : g1[q - 4]; const float ga = bflo(gw_), gb = bfhi(gw_);
            const float fa = ML ? sigmoidf_(ga) : siluf_(ga), fb = ML ? sigmoidf_(gb) : siluf_(gb);
            ow[q] = pk2(ov[2 * q] * rstd * nw[2 * q] * fa, ov[2 * q + 1] * rstd * nw[2 * q + 1] * fb); }
        bf16_t* op = BR + (size_t)m * 1536 + (ML ? 1024 : 512) + 128 * h + 16 * c8;
        *(u32x4*)op = (u32x4){ow[0], ow[1], ow[2], ow[3]}; *(u32x4*)(op + 8) = (u32x4){ow[4], ow[5], ow[6], ow[7]};
    }
}
__device__ __forceinline__ void r2_decode(int u, int G, int c0, int ncn, int& mix, int& b, int& h, int& cn) { mix = (u + u / G) & 1; const int v = u >> 1; cn = c0 + v % ncn; const int bh = v / ncn; b = bh >> 2; h = bh & 3; }
template <bool T0>
__device__ __forceinline__ void r2_loop(Frame& F, int l, int c0, int ncn, int nu) {
    int tid = F.tid; asm volatile("" : "+v"(tid));
#ifdef R2_NOPREFETCH
    for (int u = F.bid; u < nu; u += F.G) {
        int mix, b, h, cn; r2_decode(u, F.G, c0, ncn, mix, b, h, cn);
        R2Regs ra, rb;
        if (mix == 0) { r2_load<false>(F, b, h, cn, 0, tid, ra); r2_load<false>(F, b, h, cn, 1, tid, rb); r2_dir<false>(F, l, b, h, cn, 0, tid, ra); r2_dir<false>(F, l, b, h, cn, 1, tid, rb); r2_finish<false>(F, l, b, h, cn, tid, rb); }
        else { r2_load<true>(F, b, h, cn, 0, tid, ra); r2_load<true>(F, b, h, cn, 1, tid, rb); r2_dir<true>(F, l, b, h, cn, 0, tid, ra); r2_dir<true>(F, l, b, h, cn, 1, tid, rb); r2_finish<true>(F, l, b, h, cn, tid, rb); }
    }
#else
    R2Regs ra, rb; int mix, b, h, cn, b2, h2, cn2;
    int u = F.bid; if (u >= nu) return;
    r2_decode(u, F.G, c0, ncn, mix, b, h, cn);
    r2_load<T0>(F, b, h, cn, 0, tid, ra);
    for (;;) {
        r2_load<T0>(F, b, h, cn, 1, tid, rb);
        r2_dir<T0>(F, l, b, h, cn, 0, tid, ra);
        const int u2 = u + F.G; const bool has2 = u2 < nu;
        if (has2) { r2_decode(u2, F.G, c0, ncn, mix, b2, h2, cn2); r2_load<!T0>(F, b2, h2, cn2, 0, tid, ra); }
        r2_dir<T0>(F, l, b, h, cn, 1, tid, rb);
        r2_finish<T0>(F, l, b, h, cn, tid, rb);
        if (!has2) break;
        r2_load<!T0>(F, b2, h2, cn2, 1, tid, rb);
        r2_dir<!T0>(F, l, b2, h2, cn2, 0, tid, ra);
        const int u3 = u2 + F.G; const bool has3 = u3 < nu;
        if (has3) { r2_decode(u3, F.G, c0, ncn, mix, b, h, cn); r2_load<T0>(F, b, h, cn, 0, tid, ra); }
        r2_dir<!T0>(F, l, b2, h2, cn2, 1, tid, rb);
        r2_finish<!T0>(F, l, b2, h2, cn2, tid, rb);
        if (!has3) break;
        u = u3;
    }
#endif
}
constexpr int MOE_T1 = 17600, MOE_T2 = 27000;
constexpr int SPL = 11, N_PHASES = 2 + 2 * SPL, PH_FINAL = N_PHASES - 1, PH_EMPTY = 1 + 10;
__device__ __forceinline__ void init_frame(Frame& F, const Args& args, unsigned char* lds_raw) {
    F.lds = (LAS unsigned char*)lds_raw;
    F.MISC = (volatile LAS unsigned*)(F.lds + LDSCTL_OFF);
    F.tid = threadIdx.x; F.lane = F.tid & 63; F.wave = __builtin_amdgcn_readfirstlane(F.tid >> 6);
    F.G = gridDim.x; F.bid = blockIdx.x;
    F.ws = args.ws; F.ctl = (unsigned*)(args.ws + WS_CTL); F.in = args.in; F.out = args.out;
}
template <int PH>
__device__ __forceinline__ void run_phase(Frame& F) {
    LAS unsigned char* lds = F.lds;
    bf16_t* A1 = (bf16_t*)(F.ws + WS_A1); bf16_t* PROJ = (bf16_t*)(F.ws + WS_PROJ); bf16_t* BRb = (bf16_t*)(F.ws + WS_BR); bf16_t* Yb = (bf16_t*)(F.ws + WS_Y);
    bf16_t* HMID = (bf16_t*)(F.ws + WS_HMID); bf16_t* XG = (bf16_t*)(F.ws + WS_XG); bf16_t* YM = (bf16_t*)(F.ws + WS_YM);
    float* H = (float*)(F.ws + WS_H); const float* MOD = (const float*)(F.ws + WS_MOD);
    if constexpr (PH == 0) ph_prologue(F);
    else if constexpr (PH == PH_FINAL) ph_final(F);
    else {
        constexpr int l = (PH - 1) / SPL, sp0 = (PH - 1) % SPL, sp = sp0 <= 2 ? sp0 : (sp0 == 3 ? 100 : sp0 - 1);
        if constexpr (sp == 0) ph_norm1(F, l);
        else if constexpr (sp == 1) {
            pg8::InProjOrder S{(const char*)A1, (const char*)(F.ws + WS_WIN) + (size_t)l * NWIN * 1024 * 2, F.G, F.bid};
            pg8::EpiInProj E{PROJ, (bf16_t*)(F.ws + WS_VTG)};
#ifdef STAGGER_US
            if ((F.bid >> 3) & 1) { const unsigned long long t0 = __builtin_amdgcn_s_memrealtime(); while (__builtin_amdgcn_s_memrealtime() - t0 < (unsigned long long)(STAGGER_US * 100)) __builtin_amdgcn_s_sleep(32); }
#endif
            pg8::gemm_phase(lds, F.tid, 1024, 1024, 1024, S, E);
        } else if constexpr (sp == 2) {
            prep_loop<false>(F, l); prep_loop<true>(F, l);
        } else if constexpr (sp == 100) {
            for (int u = F.bid; u < 128; u += F.G) {
                const int vs = u & 1, sq = (u >> 1) & 31, dir = sq & 1, h = (sq >> 1) & 3, b = sq >> 3;
                if (u < 64) scan_unit<false>(F, b, h, dir, vs); else scan_unit<true>(F, b, h, dir, vs); }
            constexpr int nna = (l == 0) ? 1024 + 64 : 1024;
            for (;;) {
                __syncthreads();
                if (F.tid == 0) F.MISC[16] = xb_add(F.ctl + CW_NAQ + 64 * l, 1u);
                __syncthreads();
                const int u = (int)F.MISC[16];
                if (u >= nna) break;
                if (u < 1024) na_unit<true>(F, l, u >> 8, (u >> 5) & 7, u & 31);
                else { const int v = u - 1024; na_unit<false>(F, l, v >> 4, (v >> 1) & 7, v & 1); } }
        } else if constexpr (sp == 3) {
            constexpr int c0 = (l == 0) ? 0 : 4, ncn = NCH - c0, nu = 2 * 16 * ncn;
            { int mix0, b0_, h0_, cn0_; r2_decode(F.bid, F.G, c0, ncn, mix0, b0_, h0_, cn0_);
              if (mix0 == 0) r2_loop<false>(F, l, c0, ncn, nu); else r2_loop<true>(F, l, c0, ncn, nu); }
        } else if constexpr (sp == 4) {
            pg8::MergeOrder S{(const char*)BRb, (const char*)(F.ws + WS_WB) + (size_t)l * 1024 * 1536 * 2, (size_t)256 * 1536 * 2, (size_t)256 * 1536 * 2, l == 0 ? MT / 256 : 64, 4, F.G, F.bid, l == 0 ? 0 : 1};
            pg8::EpiMerge E{PROJ, Yb};
            pg8::gemm_phase(lds, F.tid, 512, 1536, 1536, S, E);
            if constexpr (l == 0) { if (F.bid >= 16) moe_convert(F, 0, MOE_T1, (F.bid - 16) * NWAVES + F.wave, (F.G - 16) * NWAVES); }
        } else if constexpr (sp == 5) {
            pg8::StaticOrder S{(const char*)Yb, (const char*)(F.ws + WS_WO) + (size_t)l * 1024 * 1024 * 2, (size_t)256 * 1024 * 2, (size_t)256 * 1024 * 2, l == 0 ? MT / 256 : 64, 4, F.G, F.bid, l == 0 ? 0 : 1};
            pg8::EpiResid E{H, MOD + (size_t)l * 5 * 6144 + 2 * 1024};
            pg8::gemm_phase(lds, F.tid, 1024, 1024, 1024, S, E);
            if constexpr (l == 0) { if (F.bid >= 16) moe_convert(F, MOE_T1, MOE_T2, (F.bid - 16) * NWAVES + F.wave, (F.G - 16) * NWAVES); }
        } else if constexpr (sp == 6) ph_norm2(F, l);
        else if constexpr (sp == 7) {
            if constexpr (l == 0) {
                pg8::StaticOrder S{(const char*)A1, (const char*)(F.ws + WS_WUP), (size_t)256 * 1024 * 2, (size_t)256 * 1024 * 2, MT / 256, 2 * FFN / 256, F.G, F.bid, 0};
                pg8::EpiSwiGLU E{HMID, FFN};
                pg8::gemm_phase(lds, F.tid, 1024, 1024, 1024, S, E);
            } else ph_moe_gather(F);
        } else if constexpr (sp == 8) {
            if constexpr (l == 0) {
                pg8::StaticOrder S{(const char*)HMID, (const char*)(F.ws + WS_WDN), (size_t)256 * FFN * 2, (size_t)256 * FFN * 2, MT / 256, 4, F.G, F.bid, 0};
                pg8::EpiResid E{H, MOD + 5 * 1024};
                pg8::gemm_phase(lds, F.tid, FFN, FFN, FFN, S, E);
                if (F.bid >= 16) moe_convert(F, MOE_T2, MOE_XITEMS, (F.bid - 16) * NWAVES + F.wave, (F.G - 16) * NWAVES);
            } else {
                const int* RT = (const int*)(F.ws + WS_ROUTE);
                pg8::MoeOrder S{(const char*)XG, (const char*)(F.ws + WS_MUP), (size_t)1024 * 2, (size_t)256 * 1024 * 2, (size_t)2 * EXD * 1024 * 2, RT + RT_TILE, RT[RT_NT], 2 * EXD / 256, F.G, F.bid, 1 << 30};
                pg8::EpiSwiGLU E{HMID, EXD};
                pg8::gemm_phase(lds, F.tid, 1024, 1024, 1024, S, E);
            }
        } else if constexpr (sp == 9) {
            if constexpr (l == 1) {
                const int* RT = (const int*)(F.ws + WS_ROUTE);
                const int nrt = RT[RT_NT], full = RT[RT_NT + 1], nextra = RT[RT_NT + 2];
                pg8::MoeOrder S{(const char*)HMID, (const char*)(F.ws + WS_MDN), (size_t)EXD * 2, (size_t)256 * EXD * 2, (size_t)1024 * EXD * 2, RT + RT_TILE, nrt, 4, F.G, F.bid, full};
                pg8::EpiStoreBf16 E{YM, 1024};
                pg8::gemm_phase(lds, F.tid, EXD, EXD, EXD, S, E);
                if (nextra > 0) {
                    pg8::MoeSplitOrder S2{(const char*)HMID, (const char*)(F.ws + WS_MDN), (size_t)256 * EXD * 2, (size_t)1024 * EXD * 2, RT + RT_TILE, nrt, 4, F.G, F.bid, full, nextra};
                    pg8::EpiStoreBf16 E2{(bf16_t*)(F.ws + WS_YMP), 256};
                    pg8::gemm_phase(lds, F.tid, 512, EXD, EXD, S2, E2);
                }
            }
        }
    }
}
#ifdef MK_ONE_LAUNCH
template <int PH> __device__ __forceinline__ void run_all(Frame& F, const Args& args, const XcdBarrier& bar) {
    if constexpr (PH < N_PHASES) {
        if constexpr (PH != PH_EMPTY) {
            { size_t zo = 0; asm volatile("" : "+s"(zo)); unsigned char* wsl = args.ws + zo; F.ws = wsl; F.ctl = (unsigned*)(wsl + WS_CTL);
              int ln = (int)__builtin_amdgcn_mbcnt_hi(~0u, __builtin_amdgcn_mbcnt_lo(~0u, 0u)); asm volatile("" : "+v"(ln)); F.lane = ln; F.tid = F.wave * 64 + ln; }
            run_phase<PH>(F);
#ifdef PROBE_DUP
            if constexpr (PH == PROBE_DUP) { xcd_barrier(bar); run_phase<PH>(F); }
#endif
            if constexpr (PH + 1 < N_PHASES) xcd_barrier(bar);
        }
        run_all<PH + 1>(F, args, bar);
    }
}
__global__ void __launch_bounds__(NWAVES * 64, 2) mega_fwd(Args args) {
    extern __shared__ __attribute__((aligned(16))) unsigned char lds_raw[];
    Frame F; init_frame(F, args, lds_raw);
    for (int u = F.tid; u < (LDS_BYTES - LDSCTL_OFF) / 4; u += NWAVES * 64) ((LAS unsigned*)(F.lds + LDSCTL_OFF))[u] = 0u;
    __syncthreads();
    const XcdBarrier bar = xcd_barrier_post(F.ctl + CW_BAR, F.MISC + 8);
    run_all<0>(F, args, bar);
}
#else
template <int PH>
__global__ void __launch_bounds__(NWAVES * 64, 2) k_phase(Args args) {
    extern __shared__ __attribute__((aligned(16))) unsigned char lds_raw[];
    Frame F; init_frame(F, args, lds_raw);
    run_phase<PH>(F);
}
template <int PH> static void launch_phases(int grid, hipStream_t stream, const Args& a) {
    if constexpr (PH < N_PHASES) {
        if constexpr (PH != PH_EMPTY) {
            static bool attr = false;
            if (!attr) { (void)hipFuncSetAttribute((const void*)k_phase<PH>, hipFuncAttributeMaxDynamicSharedMemorySize, LDS_BYTES); attr = true; }
            hipLaunchKernelGGL(k_phase<PH>, dim3(grid), dim3(NWAVES * 64), LDS_BYTES, stream, a);
        }
        launch_phases<PH + 1>(grid, stream, a);
    }
}
#endif

extern "C" void kernel_launch(void* const* d_in, const int* in_sizes, int n_in, void* d_out, int out_size, void* d_ws, size_t ws_size, hipStream_t stream) {
    static int grid = 0;
    if (grid == 0) {
        if (n_in != 22 || out_size != NB * SEQ * DM || ws_size < WS_END) { fprintf(stderr, "kernel_launch: unexpected shapes (n_in %d, out %d, ws %zu, need %zu)\n", n_in, out_size, ws_size, (size_t)WS_END); grid = -1; return; }
        int dev = 0, cus = 0;
        if (hipGetDevice(&dev) != hipSuccess || hipDeviceGetAttribute(&cus, hipDeviceAttributeMultiprocessorCount, dev) != hipSuccess) { grid = -1; return; }
#ifdef MK_ONE_LAUNCH
        int per_cu = 0;
        if (hipFuncSetAttribute((const void*)mega_fwd, hipFuncAttributeMaxDynamicSharedMemorySize, LDS_BYTES) != hipSuccess) { fprintf(stderr, "kernel_launch: hipFuncSetAttribute(%d B LDS) failed\n", LDS_BYTES); grid = -1; return; }
        if (hipOccupancyMaxActiveBlocksPerMultiprocessor(&per_cu, (const void*)mega_fwd, NWAVES * 64, LDS_BYTES) != hipSuccess || per_cu < 1) { fprintf(stderr, "kernel_launch: occupancy query reports %d workgroups per CU; nothing launched\n", per_cu); (void)hipGetLastError(); grid = -1; return; }
#endif
        grid = cus;
    }
    if (grid < 0) return;
    (void)hipMemsetAsync((char*)d_ws + WS_CTL, 0, 32768, stream);
    Args a{};
    for (int i = 0; i < 22; ++i) a.in[i] = (const float*)d_in[i];
    a.out = (float*)d_out; a.ws = (unsigned char*)d_ws; a.ph_lo = 0; a.ph_hi = N_PHASES;
#ifndef MK_ONE_LAUNCH
    launch_phases<0>(grid, stream, a);
#else
    hipLaunchKernelGGL(mega_fwd, dim3(grid), dim3(NWAVES * 64), LDS_BYTES, stream, a);
#endif
}
```

```cpp
#define MK_ONE_LAUNCH 1
#include <hip/hip_runtime.h>
#include <cstdio>
#include <cstdint>

#define LAS __attribute__((address_space(3)))
typedef unsigned short bf16_t;
typedef short bf16x8 __attribute__((ext_vector_type(8)));
typedef short bf16x4 __attribute__((ext_vector_type(4)));
typedef float f32x4 __attribute__((ext_vector_type(4)));
typedef float f32x2 __attribute__((ext_vector_type(2)));
typedef unsigned u32x4 __attribute__((ext_vector_type(4)));
typedef unsigned u32x2 __attribute__((ext_vector_type(2)));

constexpr int NB = 4, SEQ = 4096, DM = 1024, NCTX = 256, DEPTH = 2;
constexpr int TT = NCTX + SEQ;
constexpr int MT = NB * TT;
constexpr int INW = 9232;
constexpr int NPROJ = 7680;
constexpr int NWIN = 9216;
constexpr int C_NAQ = 0, C_NAK = 512, C_HGQ = 1024, C_HGF = 1536, C_HGG = 2560, C_MLQ = 3072, C_MLK = 3584, C_MLO = 4096, C_BG = 4608;
constexpr int V_NA = 0, V_HG = 512, V_ML = 1024;
constexpr int FFN = 2816, EXD = 3584, NEXP = 8;
constexpr int NCH = TT / 64;
constexpr float EPS = 1e-6f;
constexpr int MAXSLOT = 34816;
constexpr int MAXRT = MAXSLOT / 256;

constexpr size_t MiB = 1u << 20;
constexpr size_t WS_CTL = 0;
constexpr size_t WS_MOD = 1 * MiB;
constexpr size_t WS_G16 = 2 * MiB;
constexpr size_t WS_ROUTE = 4 * MiB;
constexpr size_t WS_NST = 5 * MiB;
constexpr size_t WS_WIN = 7 * MiB;
constexpr size_t WS_WB = WS_WIN + 36 * MiB;
constexpr size_t WS_WO = WS_WB + 6 * MiB;
constexpr size_t WS_WUP = WS_WO + 4 * MiB;
constexpr size_t WS_WDN = WS_WUP + 11 * MiB;
constexpr size_t WS_MUP = WS_WDN + 6 * MiB;
constexpr size_t WS_MDN = WS_MUP + 112 * MiB;
constexpr size_t WS_H = WS_MDN + 56 * MiB;
constexpr size_t WS_A1 = WS_H + 68 * MiB;
constexpr size_t WS_PROJ = WS_A1 + 34 * MiB;
constexpr size_t WS_VTG = WS_PROJ + 255 * MiB;
constexpr size_t WS_BR = WS_PROJ + 306 * MiB;
constexpr size_t WS_Y = WS_BR + 51 * MiB;
constexpr size_t WS_SP = WS_Y + 34 * MiB;
constexpr size_t WS_DEC = WS_SP + 136 * MiB;
constexpr size_t WS_NSG = WS_DEC + 2 * MiB;
constexpr size_t WS_MLS = WS_NSG + 2 * MiB;
constexpr size_t WS_END = WS_MLS + 1 * MiB;
constexpr size_t WS_KTG0 = WS_A1;
constexpr size_t WS_KTG1 = WS_Y;
constexpr size_t WS_HMID = WS_PROJ;
constexpr size_t WS_XG = WS_SP;
constexpr size_t WS_YM = WS_BR;
constexpr size_t WS_YMP = WS_SP + 68 * MiB;
static_assert(WS_END <= 896 * MiB, "workspace map exceeds the guaranteed size");
static_assert((size_t)MAXSLOT * EXD * 2 <= 255 * MiB && (size_t)MT * NPROJ * 2 <= 255 * MiB && (size_t)MAXSLOT * 1024 * 2 <= 85 * MiB && (size_t)MAXSLOT * 1024 * 2 <= 136 * MiB, "overlays");

constexpr int RT_TOKE = 0;
constexpr int RT_TOKW = 32768;
constexpr int RT_TOKS = 65536;
constexpr int RT_TILE = 98304;
constexpr int RT_NT = 98304 + 2 * 144;
constexpr int RT_SPLITX = RT_NT + 16;
constexpr int CW_CNT = 64;
constexpr int CW_CUR = 128;
constexpr int CW_NAQ = 256;
constexpr int CW_BAR = 4096;
static_assert((CW_BAR + 3456) * 4 <= 32768, "control words inside the per-call memset");

__device__ __forceinline__ unsigned f2bf(float f) { unsigned u = __builtin_bit_cast(unsigned, f); return (u + 0x7fffu + ((u >> 16) & 1u)) >> 16; }
typedef __bf16 bf16n2 __attribute__((ext_vector_type(2)));
__device__ __forceinline__ unsigned pk2(float lo, float hi) { const f32x2 f = {lo, hi}; return __builtin_bit_cast(unsigned, __builtin_convertvector(f, bf16n2)); }
__device__ __forceinline__ float bf2f(unsigned short b) { return __builtin_bit_cast(float, (unsigned)b << 16); }
__device__ __forceinline__ float bflo(unsigned w) { return __builtin_bit_cast(float, w << 16); }
__device__ __forceinline__ float bfhi(unsigned w) { return __builtin_bit_cast(float, w & 0xffff0000u); }
__device__ __forceinline__ float fast_exp(float x) { return __builtin_amdgcn_exp2f(x * 1.4426950408889634f); }
__device__ __forceinline__ float fast_rcp(float x) { return __builtin_amdgcn_rcpf(x); }
__device__ __forceinline__ float sigmoidf_(float x) { return fast_rcp(1.0f + fast_exp(-x)); }
__device__ __forceinline__ float siluf_(float x) { return x * sigmoidf_(x); }
__device__ __forceinline__ float wave_sum(float v) {
#pragma unroll
    for (int o = 1; o < 64; o <<= 1) v += __shfl_xor(v, o);
    return v;
}
#define LDS_WAIT() asm volatile("s_waitcnt lgkmcnt(0)" ::: "memory")
#define VM_WAIT() asm volatile("s_waitcnt vmcnt(0)" ::: "memory")

namespace pg8 {
#ifndef PG8_WGM
#define PG8_WGM 4
#endif
constexpr int BM = 256, BK = 64, HALF = 128, HTB = HALF * BK * 2, STAGE_BYTES = 8 * HTB, NXCD = 8, WGM = PG8_WGM;
__host__ __device__ __forceinline__ int lds_byte(int r, int c) { const int st = (r >> 4) * 2 + (c >> 5), rr = r & 15, cc = c & 31, ob = rr * 64 + cc * 2; return st * 1024 + (ob ^ (((ob >> 9) & 1) << 5)); }
__host__ __device__ __forceinline__ void stage_rc(int b, int& R, int& C) { const int st = b / 1024, sb = b % 1024, swz = sb ^ (((sb >> 9) & 1) << 5); R = (st >> 1) * 16 + swz / 64; C = (st & 1) * 32 + (swz % 64) / 2; }
__host__ __device__ __forceinline__ int perm32(int rho) { const int n = rho >> 4, i = rho & 15; return 8 * (i >> 2) + 4 * n + (i & 3); }

struct Unit { int pm, pn, aux; };

__device__ __forceinline__ bool static_tile(long L, int nM, int nN, int& pm, int& pn) {
    const int nwg = nM * nN; if (L >= nwg) return false;
    int wgid = (int)L; { const int q = nwg / NXCD, r = nwg % NXCD, xcd = wgid % NXCD, off = wgid / NXCD; wgid = (xcd < r ? xcd * (q + 1) : r * (q + 1) + (xcd - r) * q) + off; }
    const int nig = WGM * nN, gid = wgid / nig, fm = gid * WGM, gsz = (nM - fm) < WGM ? (nM - fm) : WGM;
    pm = fm + ((wgid % nig) % gsz); pn = (wgid % nig) / gsz; return true;
}
struct StaticOrder {
    const char* A; const char* Bt; size_t tstepA, tstepB; int nM, nN, G, c, skip_ctx;
    __device__ __forceinline__ bool next(int i, Unit& u) const {
        int pm, pn; if (!static_tile((long)i * G + c, nM, nN, pm, pn)) return false;
        u.pm = skip_ctx ? pm + pm / 16 + 1 : pm; u.pn = pn; u.aux = 0; return true; }
    __device__ __forceinline__ const char* Aptr(const Unit& u) const { return A + (size_t)u.pm * tstepA; }
    __device__ __forceinline__ const char* Bptr(const Unit& u) const { return Bt + (size_t)u.pn * tstepB; }
};
struct InProjOrder {
    const char* X; const char* W; int G, c;
    __device__ __forceinline__ bool next(int i, Unit& u) const {
        const long L = (long)i * G + c;
        if (L < 68 * 30) { int pm, pn; static_tile(L, 68, 30, pm, pn); u.pm = pm; u.pn = pn; u.aux = 0; return true; }
        const long L2 = L - 68 * 30; if (L2 >= 6 * 68) return false;
        u.pm = (int)(L2 % 6); u.pn = (int)(L2 / 6); u.aux = 1; return true; }
    __device__ __forceinline__ const char* Aptr(const Unit& u) const { return u.aux ? W + (size_t)(NPROJ + 256 * u.pm) * 2048 : X + (size_t)u.pm * 256 * 2048; }
    __device__ __forceinline__ const char* Bptr(const Unit& u) const { return u.aux ? X + (size_t)u.pn * 256 * 2048 : W + (size_t)u.pn * 256 * 2048; }
};
struct MergeOrder {
    const char* A; const char* Bt; size_t tstepA, tstepB; int nM, nN, G, c, skip_ctx;
    __device__ __forceinline__ bool next(int i, Unit& u) const {
        int pm, pn; if (!static_tile((long)(i / 3) * G + c, nM, nN, pm, pn)) return false;
        u.pm = skip_ctx ? pm + pm / 16 + 1 : pm; u.pn = pn; u.aux = i % 3; return true; }
    __device__ __forceinline__ const char* Aptr(const Unit& u) const { return A + (size_t)u.pm * tstepA + (size_t)u.aux * 1024; }
    __device__ __forceinline__ const char* Bptr(const Unit& u) const { return Bt + (size_t)u.pn * tstepB + (size_t)u.aux * 1024; }
};
struct MoeOrder {
    const char* A; const char* Bt; size_t rowbytesA, tstepB, estepB; const int* tiles; int nM, nN, G, c, ncap;
    __device__ __forceinline__ bool next(int i, Unit& u) const {
        const long L = (long)i * G + c; if (L >= ncap) return false;
        int pm, pn; if (!static_tile(L, nM, nN, pm, pn)) return false;
        u.pm = tiles[2 * pm + 1] >> 8; u.pn = pn; u.aux = tiles[2 * pm]; return true; }
    __device__ __forceinline__ const char* Aptr(const Unit& u) const { return A + (size_t)u.pm * 256 * rowbytesA; }
    __device__ __forceinline__ const char* Bptr(const Unit& u) const { return Bt + (size_t)u.aux * estepB + (size_t)u.pn * tstepB; }
};
constexpr int MOE_S = 7;
struct MoeSplitOrder {
    const char* A; const char* Bt; size_t tstepB, estepB; const int* tiles; int nM, nN, G, c, first, nextra;
    __device__ __forceinline__ bool next(int i, Unit& u) const {
        const int L2 = i * G + c; if (L2 >= nextra * MOE_S) return false;
        const int x = L2 % nextra, sl = L2 / nextra; int pm, pn; static_tile((long)first + x, nM, nN, pm, pn);
        u.pm = x * MOE_S + sl; u.pn = 0; u.aux = (pm << 8) | (pn << 4) | sl; return true; }
    __device__ __forceinline__ const char* Aptr(const Unit& u) const { return A + (size_t)(u.aux >> 8) * 256 * (EXD * 2) + (size_t)(u.aux & 15) * 1024; }
    __device__ __forceinline__ const char* Bptr(const Unit& u) const { return Bt + (size_t)tiles[2 * (u.aux >> 8)] * estepB + (size_t)((u.aux >> 4) & 15) * tstepB + (size_t)(u.aux & 15) * 1024; }
};

__device__ __forceinline__ unsigned cvt_pk_bf16(float lo, float hi) { return pk2(lo, hi); }

typedef f32x4 Acc[2][2][4][2];
__device__ __forceinline__ void zero_acc(Acc& acc) {
#pragma unroll
    for (int a = 0; a < 2; ++a)
#pragma unroll
        for (int b = 0; b < 2; ++b)
#pragma unroll
            for (int m = 0; m < 4; ++m)
#pragma unroll
                for (int n = 0; n < 2; ++n) acc[a][b][m][n] = (f32x4){0.f, 0.f, 0.f, 0.f};
}

template <class Epi, class Sched>
__device__ __forceinline__ void gemm_phase(LAS unsigned char* lds, const int tid, const int K, const int lda, const int ldb, const Sched& S, const Epi& E) {
    const int wid = __builtin_amdgcn_readfirstlane(tid >> 6), lane = tid & 63, wr = wid >> 2, wc = wid & 3, fr = lane & 15, fq = lane >> 4;
    const int nt = K / BK;
    unsigned voffA[2], voffB[2];
#pragma unroll
    for (int i = 0; i < 2; ++i) { int R, C; stage_rc(tid * 16 + i * 8192, R, C); const int Rb = Epi::PERM ? ((R & ~31) + perm32(R & 31)) : R;
        voffA[i] = (unsigned)(R * lda + C) * 2u; voffB[i] = (unsigned)(Rb * ldb + C) * 2u; }
    const size_t kstep = (size_t)(BK * 2);
    const size_t hstepA = (size_t)HALF * lda * 2, hstepB = (size_t)HALF * ldb * 2;
    const unsigned ldsw = (unsigned)wid * 1024u;
    const int aoff = lds_byte(wr * 64 + fr, fq * 8), boff = lds_byte(wc * 32 + fr, fq * 8);
#define PG8_SA(b, h) (((b) * 2 + (h)) * HTB)
#define PG8_SB(b, h) ((4 + (b) * 2 + (h)) * HTB)
#define PG8_STAGE(bufoff, gbase, voff) do { _Pragma("unroll") for (int _i = 0; _i < 2; ++_i) \
        __builtin_amdgcn_global_load_lds((const unsigned*)((const char*)(gbase) + (voff)[_i]), (LAS unsigned*)(lds + (bufoff) + ldsw + _i * 8192), 16, 0, 0); } while (0)
#define PG8_LDA(dst, b, h) do { _Pragma("unroll") for (int m = 0; m < 4; ++m) _Pragma("unroll") for (int k = 0; k < 2; ++k) dst[m][k] = *(const LAS bf16x8*)(lds + PG8_SA(b, h) + aoff + m * 2048 + k * 1024); } while (0)
#define PG8_LDB(dst, b, h) do { _Pragma("unroll") for (int n = 0; n < 2; ++n) _Pragma("unroll") for (int k = 0; k < 2; ++k) dst[n][k] = *(const LAS bf16x8*)(lds + PG8_SB(b, h) + boff + n * 2048 + k * 1024); } while (0)
#define PG8_MMA(ai, bj, At, Bt) do { __builtin_amdgcn_s_setprio(1); _Pragma("unroll") for (int m = 0; m < 4; ++m) _Pragma("unroll") for (int n = 0; n < 2; ++n) _Pragma("unroll") for (int k = 0; k < 2; ++k) \
        acc[ai][bj][m][n] = __builtin_amdgcn_mfma_f32_16x16x32_bf16(Bt[n][k], At[m][k], acc[ai][bj][m][n], 0, 0, 0); __builtin_amdgcn_s_setprio(0); } while (0)
#define PG8_WAIT_V(n) asm volatile("s_waitcnt vmcnt(" #n ")" ::: "memory")
#define PG8_WAIT_L(n) asm volatile("s_waitcnt lgkmcnt(" #n ")" ::: "memory")
#define PG8_BAR __builtin_amdgcn_s_barrier()
#define PG8_SCHED __builtin_amdgcn_sched_barrier(0)
    Unit cur, nxt; int ui = 0;
    if (!S.next(0, cur)) return;
    Acc acc; zero_acc(acc);
    bf16x8 At[4][2], B0[2][2], B1[2][2];
    const char* cA = S.Aptr(cur); const char* cB = S.Bptr(cur);
    PG8_STAGE(PG8_SB(0, 0), cB, voffB); PG8_STAGE(PG8_SB(0, 1), cB + hstepB, voffB); PG8_STAGE(PG8_SA(0, 0), cA, voffA); PG8_STAGE(PG8_SA(0, 1), cA + hstepA, voffA);
    if (wr == 1) PG8_BAR;
    PG8_WAIT_V(2); PG8_BAR;
    PG8_STAGE(PG8_SB(1, 0), cB + kstep, voffB); PG8_STAGE(PG8_SA(1, 0), cA + kstep, voffA); PG8_STAGE(PG8_SB(1, 1), cB + hstepB + kstep, voffB);
    PG8_WAIT_V(6); PG8_BAR;
    for (;;) {
        const bool has_next = S.next(ui + 1, nxt);
        const char* nA = has_next ? S.Aptr(nxt) : cA; const char* nB = has_next ? S.Bptr(nxt) : cB;
        for (int t = 0; t < nt; t += 2) {
            const bool last = (t == nt - 2);
            const char* a1 = cA + (size_t)(t + 1) * kstep;
            const char* a2 = last ? nA : cA + (size_t)(t + 2) * kstep; const char* b2 = last ? nB : cB + (size_t)(t + 2) * kstep;
            const char* a3 = a2 + kstep; const char* b3 = b2 + kstep;
            PG8_LDB(B0, 0, 0); PG8_LDB(B1, 0, 1); PG8_SCHED; PG8_LDA(At, 0, 0); PG8_STAGE(PG8_SA(1, 1), a1 + hstepA, voffA);
            PG8_WAIT_V(8); PG8_WAIT_L(0); PG8_BAR; PG8_MMA(0, 0, At, B0); PG8_MMA(0, 1, At, B1); PG8_BAR; PG8_SCHED;
            PG8_LDA(At, 0, 1); PG8_STAGE(PG8_SB(0, 0), b2, voffB); PG8_STAGE(PG8_SB(0, 1), b2 + hstepB, voffB); PG8_STAGE(PG8_SA(0, 0), a2, voffA);
            PG8_WAIT_V(8); PG8_WAIT_L(0); PG8_BAR; PG8_MMA(1, 0, At, B0); PG8_MMA(1, 1, At, B1); PG8_BAR; PG8_SCHED;
            PG8_LDB(B0, 1, 0); PG8_LDB(B1, 1, 1); PG8_SCHED; PG8_LDA(At, 1, 0); PG8_STAGE(PG8_SA(0, 1), a2 + hstepA, voffA);
            PG8_WAIT_V(8); PG8_WAIT_L(0); PG8_BAR; PG8_MMA(0, 0, At, B0); PG8_MMA(0, 1, At, B1); PG8_BAR; PG8_SCHED;
            PG8_LDA(At, 1, 1); PG8_STAGE(PG8_SB(1, 0), b3, voffB); PG8_STAGE(PG8_SB(1, 1), b3 + hstepB, voffB); PG8_STAGE(PG8_SA(1, 0), a3, voffA);
            PG8_WAIT_V(8); PG8_WAIT_L(0); PG8_BAR; PG8_MMA(1, 0, At, B0); PG8_MMA(1, 1, At, B1); PG8_BAR; PG8_SCHED;
        }
        if (wr == 0) PG8_BAR;
        E(acc, cur, wr, wc, fr, fq);
        if (!has_next) break;
        cur = nxt; cA = nA; cB = nB; ++ui;
        if (wr == 1) PG8_BAR;
    }
    PG8_WAIT_V(0);
    PG8_BAR;
#undef PG8_SA
#undef PG8_SB
#undef PG8_STAGE
#undef PG8_LDA
#undef PG8_LDB
#undef PG8_MMA
#undef PG8_WAIT_V
#undef PG8_WAIT_L
#undef PG8_BAR
#undef PG8_SCHED
}
}
namespace pg8 {
struct EpiStoreBf16 {
    static constexpr bool PERM = true;
    bf16_t* O; int ldc;
    __device__ __forceinline__ void operator()(Acc& acc, const Unit& u, int wr, int wc, int fr, int fq) const {
        const int row0 = u.pm * BM + wr * 64 + fr, col0 = u.pn * BM + wc * 32 + 8 * fq;
#pragma unroll
        for (int ai = 0; ai < 2; ++ai)
#pragma unroll
            for (int m = 0; m < 4; ++m) { bf16_t* rowp = O + (size_t)(row0 + ai * HALF + m * 16) * ldc + col0;
#pragma unroll
                for (int bj = 0; bj < 2; ++bj) { const f32x4 v0 = acc[ai][bj][m][0], v1 = acc[ai][bj][m][1];
                    u32x4 w; w.x = cvt_pk_bf16(v0[0], v0[1]); w.y = cvt_pk_bf16(v0[2], v0[3]); w.z = cvt_pk_bf16(v1[0], v1[1]); w.w = cvt_pk_bf16(v1[2], v1[3]);
                    *(u32x4*)(rowp + bj * HALF) = w; } }
        zero_acc(acc);
    }
};
struct EpiInProj {
    static constexpr bool PERM = true;
    bf16_t* PROJ; bf16_t* VTG;
    __device__ __forceinline__ void operator()(Acc& acc, const Unit& u, int wr, int wc, int fr, int fq) const {
        const int row0 = u.pm * BM + wr * 64 + fr, col0 = u.pn * BM + wc * 32 + 8 * fq;
        const bool gate = !u.aux && u.pn >= C_BG / BM;
#pragma unroll
        for (int ai = 0; ai < 2; ++ai)
#pragma unroll
            for (int m = 0; m < 4; ++m) { const int row = row0 + ai * HALF + m * 16;
#pragma unroll
                for (int bj = 0; bj < 2; ++bj) { f32x4 v0 = acc[ai][bj][m][0], v1 = acc[ai][bj][m][1]; const int col = col0 + bj * HALF;
                    if (gate) {
#pragma unroll
                        for (int j = 0; j < 4; ++j) { v0[j] = fast_rcp(1.0f + fast_exp(-v0[j])); v1[j] = fast_rcp(1.0f + fast_exp(-v1[j])); } }
                    u32x4 w; w.x = cvt_pk_bf16(v0[0], v0[1]); w.y = cvt_pk_bf16(v0[2], v0[3]); w.z = cvt_pk_bf16(v1[0], v1[1]); w.w = cvt_pk_bf16(v1[2], v1[3]);
                    bf16_t* dst = u.aux ? VTG + ((size_t)(col >> 6) * 1536 + row) * 64 + (col & 63) : PROJ + (size_t)row * NPROJ + col;
                    *(u32x4*)dst = w; } }
        zero_acc(acc);
    }
};
struct EpiSwiGLU {
    static constexpr bool PERM = true;
    bf16_t* O; int ldc;
    __device__ __forceinline__ void operator()(Acc& acc, const Unit& u, int wr, int wc, int fr, int fq) const {
        const int row0 = u.pm * BM + wr * 64 + fr, col0 = u.pn * HALF + wc * 32 + 8 * fq;
#pragma unroll
        for (int ai = 0; ai < 2; ++ai)
#pragma unroll
            for (int m = 0; m < 4; ++m) { bf16_t* rowp = O + (size_t)(row0 + ai * HALF + m * 16) * ldc + col0;
                float h[8];
#pragma unroll
                for (int n = 0; n < 2; ++n)
#pragma unroll
                    for (int j = 0; j < 4; ++j) { const float a = acc[ai][0][m][n][j], g = acc[ai][1][m][n][j]; h[4 * n + j] = a * fast_rcp(1.0f + fast_exp(-a)) * g; }
                u32x4 w; w.x = cvt_pk_bf16(h[0], h[1]); w.y = cvt_pk_bf16(h[2], h[3]); w.z = cvt_pk_bf16(h[4], h[5]); w.w = cvt_pk_bf16(h[6], h[7]);
                *(u32x4*)rowp = w; }
        zero_acc(acc);
    }
};
struct EpiResid {
    static constexpr bool PERM = false;
    float* H; const float* mod;
    __device__ __forceinline__ void operator()(Acc& acc, const Unit& u, int wr, int wc, int fr, int fq) const {
        const int row0 = u.pm * BM + wr * 64 + fr, col0 = u.pn * BM + wc * 32 + 4 * fq;
        const int r = (u.pm % 17 == 0) ? 4 : u.pm / 17;
        const float* mp = mod + (size_t)r * 6144 + col0;
        f32x4 mv[2][2];
#pragma unroll
        for (int bj = 0; bj < 2; ++bj)
#pragma unroll
            for (int n = 0; n < 2; ++n) mv[bj][n] = *(const f32x4*)(mp + bj * HALF + n * 16);
#pragma unroll
        for (int ai = 0; ai < 2; ++ai) {
            f32x4 hv[4][2][2];
#pragma unroll
            for (int m = 0; m < 4; ++m) { const float* rowp = H + (size_t)(row0 + ai * HALF + m * 16) * DM + col0;
#pragma unroll
                for (int bj = 0; bj < 2; ++bj)
#pragma unroll
                    for (int n = 0; n < 2; ++n) hv[m][bj][n] = *(const f32x4*)(rowp + bj * HALF + n * 16); }
#pragma unroll
            for (int m = 0; m < 4; ++m) { float* rowp = H + (size_t)(row0 + ai * HALF + m * 16) * DM + col0;
#pragma unroll
                for (int bj = 0; bj < 2; ++bj)
#pragma unroll
                    for (int n = 0; n < 2; ++n) *(f32x4*)(rowp + bj * HALF + n * 16) = hv[m][bj][n] + mv[bj][n] * acc[ai][bj][m][n]; }
            asm volatile("" ::: "memory"); }
        zero_acc(acc);
    }
};
struct EpiMerge {
    static constexpr bool PERM = true;
    const bf16_t* P; bf16_t* Y;
    __device__ __forceinline__ void operator()(Acc& acc, const Unit& u, int wr, int wc, int fr, int fq) const {
        const int row0 = u.pm * BM + wr * 64 + fr, col0 = u.pn * BM + wc * 32 + 8 * fq, seg = u.aux;
#pragma unroll
        for (int ai = 0; ai < 2; ++ai) {
            u32x4 xd[4][2], xn[4][2];
#pragma unroll
            for (int m = 0; m < 4; ++m) { const bf16_t* gp = P + (size_t)(row0 + ai * HALF + m * 16) * NPROJ + C_BG + seg * 1024 + col0;
#pragma unroll
                for (int bj = 0; bj < 2; ++bj) { xd[m][bj] = *(const u32x4*)(gp + bj * HALF); xn[m][bj] = xd[m][bj]; if (seg < 2) xn[m][bj] = *(const u32x4*)(gp + 1024 + bj * HALF); } }
#pragma unroll
            for (int m = 0; m < 4; ++m) { const size_t row = (size_t)(row0 + ai * HALF + m * 16);
#pragma unroll
                for (int bj = 0; bj < 2; ++bj) {
                    float f[8];
#pragma unroll
                    for (int q = 0; q < 4; ++q) {
                        const float d0 = bflo(xd[m][bj][q]), d1 = bfhi(xd[m][bj][q]);
                        f[2 * q] = seg < 2 ? d0 * fast_rcp(fmaxf(bflo(xn[m][bj][q]), 1e-30f)) : d0; f[2 * q + 1] = seg < 2 ? d1 * fast_rcp(fmaxf(bfhi(xn[m][bj][q]), 1e-30f)) : d1; }
                    f32x4 v0 = acc[ai][bj][m][0], v1 = acc[ai][bj][m][1];
                    v0 = v0 * (f32x4){f[0], f[1], f[2], f[3]}; v1 = v1 * (f32x4){f[4], f[5], f[6], f[7]};
                    if (seg == 2) {
                        u32x4 w; w.x = cvt_pk_bf16(v0[0], v0[1]); w.y = cvt_pk_bf16(v0[2], v0[3]); w.z = cvt_pk_bf16(v1[0], v1[1]); w.w = cvt_pk_bf16(v1[2], v1[3]);
                        *(u32x4*)(Y + row * DM + col0 + bj * HALF) = w;
                        v0 = (f32x4){0.f, 0.f, 0.f, 0.f}; v1 = v0; }
                    acc[ai][bj][m][0] = v0; acc[ai][bj][m][1] = v1; } } }
    }
};
}
constexpr int NWAVES = 8;
constexpr int LDS_BYTES = 163840;
constexpr int LDSCTL_OFF = 159744;

struct Args { const float* in[22]; float* out; unsigned char* ws; int ph_lo, ph_hi; };
enum { I_X = 0, I_C, I_CTX, I_CCTX, I_MODW, I_MODB, I_N1W, I_WIN, I_RPB, I_HGLB, I_HGNW, I_MLGB, I_MLNW, I_WBR, I_WOUT, I_N2W, I_FUP, I_FDN, I_ROUT, I_MUP, I_MDN, I_FNW };

struct Frame {
    LAS unsigned char* lds;
    volatile LAS unsigned* MISC;
    unsigned* ctl;
    unsigned char* ws;
    const float* const* in;
    float* out;
    int tid, lane, wave, G, bid;
};

#define XB_TMO      128
#define XB_XCNT(j)  (256  + 64 * (j))
#define XB_XSUB(j)  (1280 + 64 * (j))
#define XB_XGEN(j)  (2304 + 64 * (j))
#define XB_TOP      3328
#define XB_TOPGEN   3392
#define XCD_BAR_WORDS 3456
#define XB_SPIN_CAP (1u << 22)
__device__ __forceinline__ unsigned xb_ld(unsigned* p)              { return __hip_atomic_load(p, __ATOMIC_RELAXED, __HIP_MEMORY_SCOPE_AGENT); }
__device__ __forceinline__ unsigned xb_add(unsigned* p, unsigned v) { return __hip_atomic_fetch_add(p, v, __ATOMIC_RELAXED, __HIP_MEMORY_SCOPE_AGENT); }
__device__ __forceinline__ unsigned xb_xcc_id() { return (unsigned)__builtin_amdgcn_s_getreg((3 << 11) | 20) & 0xFu; }
#define XB_SPIN(cond, bar) do { unsigned _sp = 0; while (cond) { __builtin_amdgcn_s_sleep(1); \
    if ((++_sp & 255u) == 0u) { if (xb_ld(&(bar)[XB_TMO])) break; if (_sp > XB_SPIN_CAP) { atomicAdd(&(bar)[XB_TMO], 1u); break; } } } } while (0)
struct XcdBarrier { unsigned* bar; unsigned x; volatile LAS unsigned* st; };
__device__ __forceinline__ XcdBarrier xcd_barrier_post(unsigned* bar, volatile LAS unsigned* st) {
    XcdBarrier b; b.bar = bar; b.x = xb_xcc_id(); b.st = st;
    if (threadIdx.x == 0) (void)xb_add(&bar[XB_XCNT(b.x)], 1u);
    return b;
}
__device__ __forceinline__ void xcd_barrier_complete(unsigned* bar, unsigned x, unsigned& nloc, unsigned& nx) {
    const unsigned G = gridDim.x * gridDim.y * gridDim.z;
    unsigned sum, cnt, mine, sp = 0u;
    for (;;) {
        sum = 0u; cnt = 0u; mine = 0u;
#pragma unroll
        for (unsigned j = 0; j < 16; ++j) { const unsigned c = xb_ld(&bar[XB_XCNT(j)]); sum += c; cnt += (c > 0u) ? 1u : 0u; mine = (j == x) ? c : mine; }
        if (sum == G) break;
        __builtin_amdgcn_s_sleep(1);
        if ((++sp & 255u) == 0u) { if (xb_ld(&bar[XB_TMO])) break; if (sp > XB_SPIN_CAP) { atomicAdd(&bar[XB_TMO], 1u); break; } }
    }
    nloc = mine > 0u ? mine : 1u; nx = cnt > 0u ? cnt : 1u;
}
__device__ __forceinline__ void xcd_barrier(const XcdBarrier& b) {
    asm volatile("s_waitcnt vmcnt(0)" ::: "memory");
    __syncthreads();
    if (threadIdx.x == 0) {
        unsigned* bar = b.bar;
        __builtin_amdgcn_s_waitcnt(0);
        unsigned nloc = b.st[0], nx = b.st[1];
        if (nloc == 0u) { xcd_barrier_complete(bar, b.x, nloc, nx); b.st[0] = nloc; b.st[1] = nx; }
        const unsigned old = xb_add(&bar[XB_XSUB(b.x)], 1u);
        const unsigned gen = old / nloc;
        if (old + 1u == (gen + 1u) * nloc) {
            __builtin_amdgcn_fence(__ATOMIC_RELEASE, "agent");
            asm volatile("s_waitcnt vmcnt(0)" ::: "memory");
            const unsigned og = xb_add(&bar[XB_TOP], 1u);
            const unsigned tg = og / nx;
            if (og + 1u == (tg + 1u) * nx) xb_add(&bar[XB_TOPGEN], 1u);
            else XB_SPIN(xb_ld(&bar[XB_TOPGEN]) == tg, bar);
            __builtin_amdgcn_fence(__ATOMIC_ACQUIRE, "agent");
            xb_add(&bar[XB_XGEN(b.x)], 1u);
            asm volatile("s_waitcnt vmcnt(0)" ::: "memory");
        } else {
            XB_SPIN(xb_ld(&bar[XB_XGEN(b.x)]) == gen, bar);
            __builtin_amdgcn_fence(__ATOMIC_ACQUIRE, "agent");
            asm volatile("s_waitcnt vmcnt(0)" ::: "memory");
        }
    }
    __syncthreads();
}

__device__ __forceinline__ void xpose_item(const float* W, int ldw, bf16_t* WT, int ldd, LAS float* scr, int lane) {
    float v[32];
#pragma unroll
    for (int i = 0; i < 32; ++i) v[i] = W[(size_t)(2 * i + (lane >> 5)) * ldw + (lane & 31)];
#pragma unroll
    for (int i = 0; i < 32; ++i) scr[(2 * i + (lane >> 5)) * 33 + (lane & 31)] = v[i];
    LDS_WAIT(); asm volatile("" ::: "memory");
    const int c = lane & 7;
#pragma unroll
    for (int j = 0; j < 4; ++j) { const int n = (lane >> 3) + 8 * j; const LAS float* s = scr + (8 * c) * 33 + n;
        u32x4 o; o.x = pk2(s[0 * 33], s[1 * 33]); o.y = pk2(s[2 * 33], s[3 * 33]); o.z = pk2(s[4 * 33], s[5 * 33]); o.w = pk2(s[6 * 33], s[7 * 33]);
        *(u32x4*)(WT + (size_t)n * ldd + 8 * c) = o; }
    LDS_WAIT(); asm volatile("" ::: "memory");
}
struct XItem { const float* W; bf16_t* WT; int ldw, ldd; };
__device__ __forceinline__ bool xpose_mat(int& r, const float* W, int ldw, int K, int N, bf16_t* WT, int ldd, int pairF, XItem& X) {
    const int nblk = N / 32, items = (K / 64) * nblk;
    if (r >= items) { r -= items; return false; }
    const int kb = r / nblk, nb = r % nblk, k0 = 64 * kb, n0 = 32 * nb;
    int drow = n0;
    if (pairF) { const int isu = n0 >= pairF, idx = isu ? n0 - pairF : n0; drow = (idx / 128) * 256 + isu * 128 + (idx % 128); }
    X.W = W + (size_t)k0 * ldw + n0; X.ldw = ldw; X.WT = WT + (size_t)drow * ldd + k0; X.ldd = ldd;
    return true;
}
constexpr int MOE_XITEMS = 8 * (1024 / 64) * (7168 / 32) + 8 * (EXD / 64) * (1024 / 32);
__device__ __forceinline__ void moe_convert(Frame& F, int lo, int hi, int widx, int nw) {
    LAS float* scr = (LAS float*)(F.lds + F.wave * 16384);
    bf16_t* MUP = (bf16_t*)(F.ws + WS_MUP); bf16_t* MDN = (bf16_t*)(F.ws + WS_MDN);
    for (int it = lo + widx; it < hi; it += nw) {
        int r = it; bool done = false; XItem X;
        for (int e = 0; e < NEXP && !done; ++e) done = xpose_mat(r, F.in[I_MUP] + (size_t)e * 1024 * 7168, 7168, 1024, 7168, MUP + (size_t)e * 7168 * 1024, 1024, EXD, X);
        for (int e = 0; e < NEXP && !done; ++e) done = xpose_mat(r, F.in[I_MDN] + (size_t)e * EXD * 1024, 1024, EXD, 1024, MDN + (size_t)e * 1024 * EXD, EXD, 0, X);
        if (done) xpose_item(X.W, X.ldw, X.WT, X.ldd, scr, F.lane);
    }
}
__device__ __forceinline__ void ph_prologue(Frame& F) {
    {
        LAS float* sv = (LAS float*)F.lds;
        LAS float* red = (LAS float*)(F.lds + 5 * 1024 * 4);
        float* MOD = (float*)(F.ws + WS_MOD);
        bool have = false;
        for (int it = F.bid; it < 2 * 96; it += F.G) {
            if (!have) { for (int i = F.tid; i < 5 * 1024; i += 512) { const float v = i < 4096 ? F.in[I_C][i] : F.in[I_CCTX][i - 4096]; sv[i] = siluf_(v); } have = true; __syncthreads(); }
            const int l = it / 96, j0 = (it % 96) * 64, ks = F.wave, cj = F.lane;
            const float* w = F.in[I_MODW] + (size_t)l * 1024 * 6144 + j0 + cj;
            float a0 = 0.f, a1 = 0.f, a2 = 0.f, a3 = 0.f, a4 = 0.f;
#pragma unroll 8
            for (int k = ks * 128; k < ks * 128 + 128; ++k) { const float wv = w[(size_t)k * 6144];
                a0 += sv[k] * wv; a1 += sv[1024 + k] * wv; a2 += sv[2048 + k] * wv; a3 += sv[3072 + k] * wv; a4 += sv[4096 + k] * wv; }
            red[(ks * 5 + 0) * 64 + cj] = a0; red[(ks * 5 + 1) * 64 + cj] = a1; red[(ks * 5 + 2) * 64 + cj] = a2; red[(ks * 5 + 3) * 64 + cj] = a3; red[(ks * 5 + 4) * 64 + cj] = a4;
            __syncthreads();
            if (F.tid < 320) { const int r = F.tid / 64, c = F.tid % 64; float s = 0.f;
#pragma unroll
                for (int q = 0; q < 8; ++q) s += red[(q * 5 + r) * 64 + c];
                MOD[(size_t)(l * 5 + r) * 6144 + j0 + c] = s + F.in[I_MODB][l * 6144 + j0 + c]; }
            __syncthreads();
        }
        __syncthreads();
    }
    LAS float* scr = (LAS float*)(F.lds + F.wave * 16384);
    const int gw = F.bid * NWAVES + F.wave, NGW = F.G * NWAVES;
    bf16_t* WIN = (bf16_t*)(F.ws + WS_WIN); bf16_t* WB = (bf16_t*)(F.ws + WS_WB); bf16_t* WO = (bf16_t*)(F.ws + WS_WO);
    bf16_t* WUP = (bf16_t*)(F.ws + WS_WUP); bf16_t* WDN = (bf16_t*)(F.ws + WS_WDN);
    constexpr int NITEMS = 59008 - MOE_XITEMS;
    for (int it = gw; it < NITEMS; it += NGW) {
        int r = it; bool done = false; XItem X;
        for (int l = 0; l < 2 && !done; ++l) {
            {
                const float* wsrc = F.in[I_WIN] + (size_t)l * 1024 * INW; bf16_t* wdst = WIN + (size_t)l * NWIN * 1024;
                done = xpose_mat(r, wsrc + 0, INW, 1024, 1024, wdst + (size_t)0 * 1024, 1024, 0, X);
                if (!done) done = xpose_mat(r, wsrc + 1024, INW, 1024, 512, wdst + (size_t)(NPROJ + V_NA) * 1024, 1024, 0, X);
                if (!done) done = xpose_mat(r, wsrc + 1536, INW, 1024, 1536, wdst + (size_t)C_HGQ * 1024, 1024, 0, X);
                if (!done) done = xpose_mat(r, wsrc + 3072, INW, 1024, 512, wdst + (size_t)(NPROJ + V_HG) * 1024, 1024, 0, X);
                if (!done) done = xpose_mat(r, wsrc + 3584, INW, 1024, 512, wdst + (size_t)C_HGG * 1024, 1024, 0, X);
                if (!done) done = xpose_mat(r, wsrc + 4096, INW, 1024, 1024, wdst + (size_t)C_MLQ * 1024, 1024, 0, X);
                if (!done) done = xpose_mat(r, wsrc + 5120, INW, 1024, 512, wdst + (size_t)(NPROJ + V_ML) * 1024, 1024, 0, X);
                if (!done) done = xpose_mat(r, wsrc + 5632, INW, 1024, 512, wdst + (size_t)C_MLO * 1024, 1024, 0, X);
                if (!done) done = xpose_mat(r, wsrc + 6160, INW, 1024, 3072, wdst + (size_t)C_BG * 1024, 1024, 0, X);
            }
            for (int i = 0; i < 3 && !done; ++i) done = xpose_mat(r, F.in[I_WBR] + (size_t)(l * 3 + i) * 512 * 1024, 1024, 512, 1024, WB + (size_t)l * 1024 * 1536 + i * 512, 1536, 0, X);
            if (!done) done = xpose_mat(r, F.in[I_WOUT] + (size_t)l * 1024 * 1024, 1024, 1024, 1024, WO + (size_t)l * 1024 * 1024, 1024, 0, X);
        }
        if (!done) done = xpose_mat(r, F.in[I_FUP], 2 * FFN, 1024, 2 * FFN, WUP, 1024, FFN, X);
        if (!done) done = xpose_mat(r, F.in[I_FDN], 1024, FFN, 1024, WDN, FFN, 0, X);
        if (done) xpose_item(X.W, X.ldw, X.WT, X.ldd, scr, F.lane);
    }
}

__device__ __forceinline__ const float* src_row(const Frame& F, int layer_first, int m) {
    if (!layer_first) return (const float*)(F.ws + WS_H) + (size_t)m * DM;
    const int b = m / TT, r = m % TT;
    return r < NCTX ? F.in[I_CTX] + ((size_t)b * NCTX + r) * DM : F.in[I_X] + ((size_t)b * SEQ + (r - NCTX)) * DM;
}
__device__ __forceinline__ float reduce16(float (&g)[16], int lane) {
    float a8[8], a4[4], a2[2];
    const bool b5 = lane & 32, b4 = lane & 16, b3 = lane & 8, b2 = lane & 4;
#pragma unroll
    for (int k = 0; k < 8; ++k) { const float send = b5 ? g[k] : g[k + 8], keep = b5 ? g[k + 8] : g[k]; a8[k] = keep + __shfl_xor(send, 32); }
#pragma unroll
    for (int k = 0; k < 4; ++k) { const float send = b4 ? a8[k] : a8[k + 4], keep = b4 ? a8[k + 4] : a8[k]; a4[k] = keep + __shfl_xor(send, 16); }
#pragma unroll
    for (int k = 0; k < 2; ++k) { const float send = b3 ? a4[k] : a4[k + 2], keep = b3 ? a4[k + 2] : a4[k]; a2[k] = keep + __shfl_xor(send, 8); }
    float r = (b2 ? a2[1] : a2[0]) + __shfl_xor(b2 ? a2[0] : a2[1], 4);
    r += __shfl_xor(r, 2); r += __shfl_xor(r, 1);
    return r;
}
struct RowRegs { f32x4 v[4]; };
__device__ __forceinline__ void row_load(RowRegs& R, const float* xr, int lane) {
#pragma unroll
    for (int j = 0; j < 4; ++j) R.v[j] = *(const f32x4*)(xr + 256 * j + 4 * lane);
}
__device__ __forceinline__ void ph_norm1(Frame& F, int l) {
    LAS float* WG = (LAS float*)F.lds;
    for (int i = F.tid; i < 16384; i += 512) { const int k = i >> 4, g = i & 15; WG[g * 1028 + k] = F.in[I_WIN][(size_t)l * 1024 * INW + (size_t)k * INW + 6144 + g]; }
    __syncthreads();
    const int gw = F.bid * NWAVES + F.wave, NGW = F.G * NWAVES;
    const float* MOD = (const float*)(F.ws + WS_MOD) + (size_t)l * 5 * 6144;
    const float* nw = F.in[I_N1W] + l * DM;
    float* H = (float*)(F.ws + WS_H); bf16_t* A1 = (bf16_t*)(F.ws + WS_A1); float* G16 = (float*)(F.ws + WS_G16);
    RowRegs nx; if (gw < MT) row_load(nx, src_row(F, l == 0, gw), F.lane);
    for (int m = gw; m < MT; m += NGW) {
        const RowRegs cur = nx; if (m + NGW < MT) row_load(nx, src_row(F, l == 0, m + NGW), F.lane);
        const int r = (m % TT) < NCTX ? 4 : m / TT;
        const float* sh = MOD + (size_t)r * 6144; const float* sc = sh + 1024;
        float ss = 0.f;
#pragma unroll
        for (int j = 0; j < 4; ++j) ss += (cur.v[j].x * cur.v[j].x + cur.v[j].y * cur.v[j].y) + (cur.v[j].z * cur.v[j].z + cur.v[j].w * cur.v[j].w);
        if (l == 0) {
#pragma unroll
            for (int j = 0; j < 4; ++j) *(f32x4*)(H + (size_t)m * DM + 256 * j + 4 * F.lane) = cur.v[j]; }
        const float rstd = 1.0f / sqrtf(wave_sum(ss) * (1.f / DM) + EPS);
        f32x4 av[4];
#pragma unroll
        for (int j = 0; j < 4; ++j) { const int k0 = 256 * j + 4 * F.lane;
            const f32x4 w4 = *(const f32x4*)(nw + k0), s4 = *(const f32x4*)(sh + k0), c4 = *(const f32x4*)(sc + k0);
            av[j] = (cur.v[j] * rstd * w4) * (c4 + 1.0f) + s4;
            *(u32x2*)(A1 + (size_t)m * DM + k0) = (u32x2){pk2(av[j].x, av[j].y), pk2(av[j].z, av[j].w)}; }
        float g[16];
#pragma unroll
        for (int q = 0; q < 16; ++q) { float gq = 0.f;
#pragma unroll
            for (int j = 0; j < 4; ++j) { const f32x4 wg = *(const LAS f32x4*)(WG + q * 1028 + 256 * j + 4 * F.lane); gq += (av[j].x * wg.x + av[j].y * wg.y) + (av[j].z * wg.z + av[j].w * wg.w); }
            g[q] = gq; if ((q & 3) == 3) asm volatile("" ::: "memory"); }
        const float tot = reduce16(g, F.lane);
        if ((F.lane & 3) == 0) G16[(size_t)m * 16 + (F.lane >> 2)] = tot;
    }
}
__device__ __forceinline__ void ph_norm2(Frame& F, int l) {
    const int gw = F.bid * NWAVES + F.wave, NGW = F.G * NWAVES;
    const float* MOD = (const float*)(F.ws + WS_MOD) + (size_t)l * 5 * 6144;
    const float* nw = F.in[I_N2W] + l * DM;
    const float* H = (const float*)(F.ws + WS_H); bf16_t* A1 = (bf16_t*)(F.ws + WS_A1);
    if (l == 0) {
        RowRegs nx; if (gw < MT) row_load(nx, H + (size_t)gw * DM, F.lane);
        for (int m = gw; m < MT; m += NGW) {
            const RowRegs cur = nx; if (m + NGW < MT) row_load(nx, H + (size_t)(m + NGW) * DM, F.lane);
            const int r = (m % TT) < NCTX ? 4 : m / TT;
            const float* sh = MOD + (size_t)r * 6144 + 3 * 1024; const float* sc = sh + 1024;
            float ss = 0.f;
#pragma unroll
            for (int j = 0; j < 4; ++j) ss += (cur.v[j].x * cur.v[j].x + cur.v[j].y * cur.v[j].y) + (cur.v[j].z * cur.v[j].z + cur.v[j].w * cur.v[j].w);
            const float rstd = 1.0f / sqrtf(wave_sum(ss) * (1.f / DM) + EPS);
#pragma unroll
            for (int j = 0; j < 4; ++j) { const int k0 = 256 * j + 4 * F.lane;
                const f32x4 w4 = *(const f32x4*)(nw + k0), s4 = *(const f32x4*)(sh + k0), c4 = *(const f32x4*)(sc + k0);
                const f32x4 a = (cur.v[j] * rstd * w4) * (c4 + 1.0f) + s4;
                *(u32x2*)(A1 + (size_t)m * DM + k0) = (u32x2){pk2(a.x, a.y), pk2(a.z, a.w)}; }
        }
        return;
    }
    LAS float* WR = (LAS float*)F.lds;
    LAS unsigned* lcnt = (LAS unsigned*)(F.lds + 8 * 1028 * 4);
    for (int i = F.tid; i < 8192; i += 512) { const int k = i >> 3, e = i & 7; WR[e * 1028 + k] = F.in[I_ROUT][(size_t)k * 8 + e]; }
    if (F.tid < 16) lcnt[F.tid] = 0u;
    __syncthreads();
    int* TOKE = (int*)(F.ws + WS_ROUTE) + RT_TOKE; float* TOKW = (float*)(F.ws + WS_ROUTE) + RT_TOKW; int* TOKS = (int*)(F.ws + WS_ROUTE) + RT_TOKS;
    RowRegs nx; if (gw < NB * SEQ) row_load(nx, H + (size_t)((gw / SEQ) * TT + NCTX + (gw % SEQ)) * DM, F.lane);
    for (int n = gw; n < NB * SEQ; n += NGW) {
        const int b = n / SEQ, m = b * TT + NCTX + (n % SEQ);
        const RowRegs cur = nx; if (n + NGW < NB * SEQ) { const int n2 = n + NGW; row_load(nx, H + (size_t)((n2 / SEQ) * TT + NCTX + (n2 % SEQ)) * DM, F.lane); }
        const float* sh = MOD + (size_t)b * 6144 + 3 * 1024; const float* sc = sh + 1024;
        float ss = 0.f;
#pragma unroll
        for (int j = 0; j < 4; ++j) ss += (cur.v[j].x * cur.v[j].x + cur.v[j].y * cur.v[j].y) + (cur.v[j].z * cur.v[j].z + cur.v[j].w * cur.v[j].w);
        const float rstd = 1.0f / sqrtf(wave_sum(ss) * (1.f / DM) + EPS);
        float g[16];
#pragma unroll
        for (int q = 0; q < 16; ++q) g[q] = 0.f;
#pragma unroll
        for (int j = 0; j < 4; ++j) { const int k0 = 256 * j + 4 * F.lane;
            const f32x4 w4 = *(const f32x4*)(nw + k0), s4 = *(const f32x4*)(sh + k0), c4 = *(const f32x4*)(sc + k0);
            const f32x4 a = (cur.v[j] * rstd * w4) * (c4 + 1.0f) + s4;
            *(u32x2*)(A1 + (size_t)m * DM + k0) = (u32x2){pk2(a.x, a.y), pk2(a.z, a.w)};
#pragma unroll
            for (int q = 0; q < 8; ++q) { const f32x4 wg = *(const LAS f32x4*)(WR + q * 1028 + k0); g[q] += (a.x * wg.x + a.y * wg.y) + (a.z * wg.z + a.w * wg.w); } }
        const float tot = reduce16(g, F.lane);
        float lg[8];
#pragma unroll
        for (int q = 0; q < 8; ++q) lg[q] = __shfl(tot, 4 * q);
        int e1 = 0; float v1 = lg[0];
#pragma unroll
        for (int q = 1; q < 8; ++q) if (lg[q] > v1) { v1 = lg[q]; e1 = q; }
        int e2 = (e1 == 0) ? 1 : 0; float v2 = lg[e1 == 0 ? 1 : 0];
#pragma unroll
        for (int q = 0; q < 8; ++q) if (q != e1 && lg[q] > v2) { v2 = lg[q]; e2 = q; }
        if (F.lane < 2) {
            const float w1 = 1.0f / (1.0f + fast_exp(v2 - v1));
            const int e = F.lane ? e2 : e1;
            const unsigned pos = __hip_atomic_fetch_add(lcnt + e, 1u, __ATOMIC_RELAXED, __HIP_MEMORY_SCOPE_WORKGROUP);
            TOKE[2 * n + F.lane] = e; TOKW[2 * n + F.lane] = F.lane ? 1.0f - w1 : w1; TOKS[2 * n + F.lane] = (int)pos;
        }
    }
    __syncthreads();
    if (F.tid < 8) lcnt[8 + F.tid] = xb_add(F.ctl + CW_CNT + F.tid, lcnt[F.tid]);
    __syncthreads();
    VM_WAIT();
    for (int n = gw; n < NB * SEQ; n += NGW) {
        if (F.lane < 2) { const int e = TOKE[2 * n + F.lane]; TOKS[2 * n + F.lane] += (int)lcnt[8 + e]; }
    }
}
__device__ __forceinline__ void ph_moe_gather(Frame& F) {
    const int gw = F.bid * NWAVES + F.wave, NGW = F.G * NWAVES;
    int pstart[NEXP]; int acc = 0;
#pragma unroll
    for (int e = 0; e < NEXP; ++e) { const int c = (int)xb_ld(F.ctl + CW_CNT + e); pstart[e] = acc; acc += (c + 255) & ~255; }
    int* RT = (int*)(F.ws + WS_ROUTE);
    if (F.bid == 0 && F.tid == 0) {
        int nt = 0;
        for (int e = 0; e < NEXP; ++e) { const int c = (int)xb_ld(F.ctl + CW_CNT + e); for (int t = 0; t * 256 < c; ++t) { RT[RT_TILE + 2 * nt] = e; RT[RT_TILE + 2 * nt + 1] = pstart[e] + 256 * t; ++nt; } }
        RT[RT_NT] = nt;
        const int nwg = nt * 4; int full = (nwg / F.G) * F.G; if (nwg - full > F.G / 4 || nwg - full > 64) full = nwg;
        RT[RT_NT + 1] = full; RT[RT_NT + 2] = nwg - full;
        for (int i = 0; i < nwg; ++i) RT[RT_SPLITX + i] = -1;
        for (int L = full; L < nwg; ++L) { int pm, pn; pg8::static_tile(L, nt, 4, pm, pn); RT[RT_SPLITX + pm * 4 + pn] = L - full; }
    }
    const int* TOKE = RT + RT_TOKE; int* TOKS = RT + RT_TOKS;
    const bf16_t* A1 = (const bf16_t*)(F.ws + WS_A1); bf16_t* XG = (bf16_t*)(F.ws + WS_XG);
    for (int n = gw; n < NB * SEQ; n += NGW) {
        const int b = n / SEQ, m = b * TT + NCTX + (n % SEQ);
        const int e1 = TOKE[2 * n], e2 = TOKE[2 * n + 1];
        int s1 = TOKS[2 * n], s2 = TOKS[2 * n + 1];
        int p1 = 0, p2 = 0;
#pragma unroll
        for (int e = 0; e < NEXP; ++e) { p1 = (e == e1) ? pstart[e] : p1; p2 = (e == e2) ? pstart[e] : p2; }
        s1 += p1; s2 += p2;
        const u32x4* src = (const u32x4*)(A1 + (size_t)m * DM);
        const u32x4 a = src[F.lane], c = src[64 + F.lane];
        u32x4* d1 = (u32x4*)(XG + (size_t)s1 * DM); u32x4* d2 = (u32x4*)(XG + (size_t)s2 * DM);
        d1[F.lane] = a; d1[64 + F.lane] = c; d2[F.lane] = a; d2[64 + F.lane] = c;
        if (F.lane == 0) { TOKS[2 * n] = s1; TOKS[2 * n + 1] = s2; }
    }
}
__device__ __forceinline__ void ph_final(Frame& F) {
    const int gw = F.bid * NWAVES + F.wave, NGW = F.G * NWAVES;
    const float* MOD = (const float*)(F.ws + WS_MOD) + (size_t)1 * 5 * 6144;
    const float* H = (const float*)(F.ws + WS_H); const bf16_t* YM = (const bf16_t*)(F.ws + WS_YM); const bf16_t* YMP = (const bf16_t*)(F.ws + WS_YMP);
    const int* RT = (const int*)(F.ws + WS_ROUTE); const float* TOKW = (const float*)(F.ws + WS_ROUTE) + RT_TOKW;
    const float* fw = F.in[I_FNW];
    for (int n = gw; n < NB * SEQ; n += NGW) {
        const int b = n / SEQ, m = b * TT + NCTX + (n % SEQ);
        const int s1 = RT[RT_TOKS + 2 * n], s2 = RT[RT_TOKS + 2 * n + 1]; const float w1 = TOKW[2 * n], w2 = TOKW[2 * n + 1];
        const float* g5 = MOD + (size_t)b * 6144 + 5 * 1024;
        f32x4 v[4]; float ss = 0.f;
#pragma unroll
        for (int j = 0; j < 4; ++j) { const int k0 = 256 * j + 4 * F.lane;
            const f32x4 h = *(const f32x4*)(H + (size_t)m * DM + k0), gg = *(const f32x4*)(g5 + k0);
            f32x4 ya, yb;
            { const int x1 = RT[RT_SPLITX + (s1 >> 8) * 4 + j], x2 = RT[RT_SPLITX + (s2 >> 8) * 4 + j];
              if (x1 < 0) { const u32x2 t = *(const u32x2*)(YM + (size_t)s1 * DM + k0); ya = (f32x4){bflo(t.x), bfhi(t.x), bflo(t.y), bfhi(t.y)}; }
              else { ya = (f32x4){0.f, 0.f, 0.f, 0.f};
                  for (int sl = 0; sl < pg8::MOE_S; ++sl) { const u32x2 t = *(const u32x2*)(YMP + ((size_t)(x1 * pg8::MOE_S + sl) * 256 + (s1 & 255)) * 256 + 4 * F.lane); ya = ya + (f32x4){bflo(t.x), bfhi(t.x), bflo(t.y), bfhi(t.y)}; } }
              if (x2 < 0) { const u32x2 t = *(const u32x2*)(YM + (size_t)s2 * DM + k0); yb = (f32x4){bflo(t.x), bfhi(t.x), bflo(t.y), bfhi(t.y)}; }
              else { yb = (f32x4){0.f, 0.f, 0.f, 0.f};
                  for (int sl = 0; sl < pg8::MOE_S; ++sl) { const u32x2 t = *(const u32x2*)(YMP + ((size_t)(x2 * pg8::MOE_S + sl) * 256 + (s2 & 255)) * 256 + 4 * F.lane); yb = yb + (f32x4){bflo(t.x), bfhi(t.x), bflo(t.y), bfhi(t.y)}; } } }
            const f32x4 y = ya * w1 + yb * w2;
            v[j] = h + gg * y; ss += (v[j].x * v[j].x + v[j].y * v[j].y) + (v[j].z * v[j].z + v[j].w * v[j].w); }
        const float rstd = 1.0f / sqrtf(wave_sum(ss) * (1.f / DM) + EPS);
#pragma unroll
        for (int j = 0; j < 4; ++j) { const int k0 = 256 * j + 4 * F.lane; const f32x4 w4 = *(const f32x4*)(fw + k0);
            *(f32x4*)(F.out + (size_t)n * DM + k0) = v[j] * rstd * w4; }
    }
}
__device__ __forceinline__ int tokrow(int b, int dir, int P) { return b * TT + (dir == 0 ? P : (P < NCTX ? (NCTX - 1) - P : (TT + NCTX - 1) - P)); }
__device__ __forceinline__ int iclamp(int v, int lo, int hi) { return v < lo ? lo : (v > hi ? hi : v); }
__device__ __forceinline__ bf16x8 cat4(bf16x4 a, bf16x4 b) { return __builtin_shufflevector(a, b, 0, 1, 2, 3, 4, 5, 6, 7); }
__device__ __forceinline__ f32x4 mfma16(bf16x8 a, bf16x8 b, f32x4 c) { return __builtin_amdgcn_mfma_f32_16x16x32_bf16(a, b, c, 0, 0, 0); }
__device__ __forceinline__ float wave_scan_add(float v, int lane) {
#pragma unroll
    for (int o = 1; o < 64; o <<= 1) { const float t = __shfl_up(v, o); if (lane >= o) v += t; }
    return v;
}
__device__ __forceinline__ float wave_scan_max(float v, int lane) {
#pragma unroll
    for (int o = 1; o < 64; o <<= 1) { const float t = __shfl_up(v, o); if (lane >= o) v = fmaxf(v, t); }
    return v;
}
__device__ __forceinline__ float wave_max(float v) {
#pragma unroll
    for (int o = 1; o < 64; o <<= 1) v = fmaxf(v, __shfl_xor(v, o));
    return v;
}
__device__ __forceinline__ float logsigmoidf_(float x) { return fminf(x, 0.f) - __logf(1.0f + fast_exp(-fabsf(x))); }

constexpr int NA_VTC = 0, NA_VTL = 33792, NA_RPB = 108544;
template <bool LOCAL>
__device__ __forceinline__ void na_unit(Frame& F, int l, int b, int h, int sub) {
    const bf16_t* P = (const bf16_t*)(F.ws + WS_PROJ); bf16_t* BR = (bf16_t*)(F.ws + WS_BR);
    LAS bf16_t* VTC = (LAS bf16_t*)(F.lds + NA_VTC); LAS bf16_t* VTL = (LAS bf16_t*)(F.lds + NA_VTL); LAS float* RPB = (LAS float*)(F.lds + NA_RPB);
    int tid = F.tid; asm volatile("" : "+v"(tid));
    const int lane = tid & 63, w = F.wave, g = lane >> 4, c = lane & 15;
    const int ubase = LOCAL ? iclamp(2 * sub - 4, 0, 56) : 0;
    __syncthreads();
    {   const bf16_t* VG = (const bf16_t*)(F.ws + WS_VTG) + ((size_t)(b * NCH) * 1536 + V_NA + 64 * h) * 64;
#pragma unroll
        for (int it = 0; it < 4; ++it) { const int q = tid + 512 * it, dv = q >> 5, k8 = q & 31;
            *(LAS u32x4*)(VTC + dv * 264 + 8 * k8) = *(const u32x4*)(VG + ((size_t)(k8 >> 3) * 1536 + dv) * 64 + 8 * (k8 & 7)); }
        if (LOCAL) {
            const int npc = ((64 - ubase) < 9 ? (64 - ubase) : 9) * 8;
#pragma unroll
            for (int it = 0; it < 9; ++it) { const int q = tid + 512 * it, dv = q / 72, k8 = q % 72;
                if (k8 < npc) *(LAS u32x4*)(VTL + dv * 584 + 8 * k8) = *(const u32x4*)(VG + ((size_t)(4 + ubase + (k8 >> 3)) * 1536 + dv) * 64 + 8 * (k8 & 7)); }
            if (tid < 465) RPB[tid] = F.in[I_RPB][(size_t)(l * 8 + h) * 465 + tid];
        }
    }
    __syncthreads();
    const int qrow = LOCAL ? 2 * sub + (w >> 2) : 0, cb = w & 3;
    const int r0 = iclamp(qrow - 4, 0, 56), bs = iclamp(16 * cb - 8, 0, 32);
    const int mq = LOCAL ? b * TT + NCTX + qrow * 64 + 16 * cb + c : b * TT + 128 * sub + 16 * w + c;
    bf16x8 qf[2];
    qf[0] = *(const bf16x8*)(P + (size_t)mq * NPROJ + C_NAQ + 64 * h + 8 * g);
    qf[1] = *(const bf16x8*)(P + (size_t)mq * NPROJ + C_NAQ + 64 * h + 32 + 8 * g);
    constexpr int NKB = LOCAL ? 32 : 16, LB = LOCAL ? 16 : 0;
    float s[NKB][4];
    if (LOCAL) {
        const int qc = 16 * cb + c, wst = iclamp(qc - 8, 0, 48);
#pragma unroll
        for (int kb = 0; kb < 16; ++kb) { const int wr = kb >> 1, hf = kb & 1;
            const int mk = b * TT + NCTX + (r0 + wr) * 64 + bs + 16 * hf + c;
            const bf16x8 a0 = *(const bf16x8*)(P + (size_t)mk * NPROJ + C_NAK + 64 * h + 8 * g), a1 = *(const bf16x8*)(P + (size_t)mk * NPROJ + C_NAK + 64 * h + 32 + 8 * g);
            f32x4 z = (f32x4){0.f, 0.f, 0.f, 0.f}; z = mfma16(a0, qf[0], z); z = mfma16(a1, qf[1], z);
            const int dr = r0 + wr - qrow + 7;
#pragma unroll
            for (int r = 0; r < 4; ++r) { const int kc = bs + 16 * hf + 4 * g + r; const bool valid = (kc >= wst) && (kc < wst + 16); const int dc = iclamp(kc - qc + 15, 0, 30);
                s[kb][r] = valid ? z[r] * 0.125f + RPB[dr * 31 + dc] : -1e30f; } }
    }
#pragma unroll
    for (int kb = 0; kb < 16; ++kb) {
        const int mk = b * TT + 16 * kb + c;
        const bf16x8 a0 = *(const bf16x8*)(P + (size_t)mk * NPROJ + C_NAK + 64 * h + 8 * g), a1 = *(const bf16x8*)(P + (size_t)mk * NPROJ + C_NAK + 64 * h + 32 + 8 * g);
        f32x4 z = (f32x4){0.f, 0.f, 0.f, 0.f}; z = mfma16(a0, qf[0], z); z = mfma16(a1, qf[1], z);
#pragma unroll
        for (int r = 0; r < 4; ++r) s[LB + kb][r] = z[r] * 0.125f; }
    float mx = -3.0e38f;
#pragma unroll
    for (int kb = 0; kb < NKB; ++kb)
#pragma unroll
        for (int r = 0; r < 4; ++r) mx = fmaxf(mx, s[kb][r]);
    mx = fmaxf(mx, __shfl_xor(mx, 16)); mx = fmaxf(mx, __shfl_xor(mx, 32));
    float sum = 0.f;
#pragma unroll
    for (int kb = 0; kb < NKB; ++kb)
#pragma unroll
        for (int r = 0; r < 4; ++r) { const float p = fast_exp(s[kb][r] - mx); s[kb][r] = p; sum += p; }
    sum += __shfl_xor(sum, 16); sum += __shfl_xor(sum, 32);
    f32x4 o[4];
#pragma unroll
    for (int mb = 0; mb < 4; ++mb) o[mb] = (f32x4){0.f, 0.f, 0.f, 0.f};
#pragma unroll
    for (int kp = 0; kp < NKB / 2; ++kp) {
        u32x4 pw; pw.x = pk2(s[2 * kp][0], s[2 * kp][1]); pw.y = pk2(s[2 * kp][2], s[2 * kp][3]); pw.z = pk2(s[2 * kp + 1][0], s[2 * kp + 1][1]); pw.w = pk2(s[2 * kp + 1][2], s[2 * kp + 1][3]);
        const bf16x8 pf = __builtin_bit_cast(bf16x8, pw);
#pragma unroll
        for (int mb = 0; mb < 4; ++mb) { const int dv = 16 * mb + c;
            const LAS bf16_t* base = (LOCAL && kp < 8) ? VTL + dv * 584 + (r0 + kp - ubase) * 64 + bs + 4 * g : VTC + dv * 264 + 32 * (kp - (LOCAL ? 8 : 0)) + 4 * g;
            const bf16x4 lo = *(const LAS bf16x4*)base, hi = *(const LAS bf16x4*)(base + 16);
            o[mb] = mfma16(cat4(lo, hi), pf, o[mb]); } }
    const float inv = 1.0f / sum;
#pragma unroll
    for (int mb = 0; mb < 4; ++mb)
        *(u32x2*)(BR + (size_t)mq * 1536 + 64 * h + 16 * mb + 4 * g) = (u32x2){pk2(o[mb][0] * inv, o[mb][1] * inv), pk2(o[mb][2] * inv, o[mb][3] * inv)};
}

__device__ __forceinline__ void load_rope16(const bf16_t* src, int c8, int rr  , float scale, float (&x)[2][2][4]) {
#pragma unroll
    for (int hf = 0; hf < 2; ++hf)
#pragma unroll
        for (int q = 0; q < 2; ++q) { const u32x2 v = *(const u32x2*)(src + 64 * hf + 32 * q + 4 * c8);
            x[hf][q][0] = bflo(v.x) * scale; x[hf][q][1] = bfhi(v.x) * scale; x[hf][q][2] = bflo(v.y) * scale; x[hf][q][3] = bfhi(v.y) * scale; }
    if (rr >= NCTX) {
        const int t = rr - NCTX;
#pragma unroll
        for (int hf = 0; hf < 2; ++hf) { const float pos = (float)(hf ? (t & 63) : (t >> 6));
#pragma unroll
            for (int e = 0; e < 4; ++e) { const float rev = pos * (__builtin_amdgcn_exp2f(-(float)(4 * c8 + e) * 0.41524101186092030f) * 0.15915494309189535f);
                const float cs = __builtin_amdgcn_cosf(rev), sn = __builtin_amdgcn_sinf(rev);
                const float p1 = x[hf][0][e], p2 = x[hf][1][e]; x[hf][0][e] = p1 * cs - p2 * sn; x[hf][1][e] = p1 * sn + p2 * cs; } }
    }
}

constexpr int PR_LF = 0, PR_KT = 33792, PR_WSC = PR_KT + 18432;
struct PrepRegs { u32x4 z0, z1; u32x2 kq[4]; float gi, gf; };
template <bool ML>
__device__ __forceinline__ void prep_load(Frame& F, int v, int tid, PrepRegs& R) {
    const bf16_t* P = (const bf16_t*)(F.ws + WS_PROJ);
    const int C = v % NCH, sq = v / NCH, dir = sq & 1, h = (sq >> 1) & 3, b = sq >> 3, p_ = tid >> 3, c8 = tid & 7;
    const int mrow = tokrow(b, dir, 64 * C + p_);
    if (!ML) { const bf16_t* zp = P + (size_t)mrow * NPROJ + C_HGF + 512 * dir + 128 * h + 16 * c8; R.z0 = *(const u32x4*)zp; R.z1 = *(const u32x4*)(zp + 8); }
    else {
#pragma unroll
        for (int q = 0; q < 4; ++q) R.kq[q] = *(const u32x2*)(P + (size_t)mrow * NPROJ + C_MLK + 128 * h + 64 * (q >> 1) + 32 * (q & 1) + 4 * c8);
        if (tid < 64) { const float* G16 = (const float*)(F.ws + WS_G16); const int mr = tokrow(b, dir, 64 * C + tid);
            R.gi = G16[(size_t)mr * 16 + dir * 8 + h]; R.gf = G16[(size_t)mr * 16 + dir * 8 + 4 + h]; }
    }
}
template <bool ML>
__device__ __forceinline__ void prep_body(Frame& F, int l, int v, int tid, const PrepRegs& R) {
    const int C = v % NCH, sq = v / NCH, dir = sq & 1, h = (sq >> 1) & 3, b = sq >> 3;
    const int sc_ = sq * NCH + C;
    bf16_t* KTG = (bf16_t*)(F.ws + (ML ? WS_KTG1 : WS_KTG0)) + (size_t)sc_ * 8192;
    LAS float* LF = (LAS float*)(F.lds + PR_LF); LAS bf16_t* KT = (LAS bf16_t*)(F.lds + PR_KT); LAS float* WSC = (LAS float*)(F.lds + PR_WSC);
    const int lane = tid & 63, w = F.wave, g = lane >> 4, c = lane & 15;
    const int p_ = tid >> 3, c8 = tid & 7;
    const int mrow = tokrow(b, dir, 64 * C + p_);
    __syncthreads();
    if (!ML) {
        float lf[16];
#pragma unroll
        for (int q = 0; q < 4; ++q) { const unsigned wa = R.z0[q], wb = R.z1[q];
            lf[2 * q] = bflo(wa); lf[2 * q + 1] = bfhi(wa); lf[8 + 2 * q] = bflo(wb); lf[8 + 2 * q + 1] = bfhi(wb); }
#pragma unroll
        for (int e = 0; e < 16; ++e) { const int ch = dir * 512 + 128 * h + 16 * c8 + e; const float lb = (l == 0) ? 0.f : sigmoidf_(F.in[I_HGLB][1024 + ch] - F.in[I_HGLB][ch]);
            const float f = lb + (1.0f - lb) * sigmoidf_(lf[e]); lf[e] = __logf(fmaxf(f, 1e-30f)); }
        {
            unsigned lw[8];
#pragma unroll
            for (int q = 0; q < 8; ++q) { lw[q] = pk2(lf[2 * q], lf[2 * q + 1]); lf[2 * q] = bflo(lw[q]); lf[2 * q + 1] = bfhi(lw[q]); }
            bf16_t* zp = (bf16_t*)(F.ws + WS_PROJ) + (size_t)mrow * NPROJ + C_HGF + 512 * dir + 128 * h + 16 * c8;
            *(u32x4*)zp = (u32x4){lw[0], lw[1], lw[2], lw[3]}; *(u32x4*)(zp + 8) = (u32x4){lw[4], lw[5], lw[6], lw[7]}; }
#pragma unroll
        for (int q = 0; q < 4; ++q) *(LAS f32x4*)(LF + p_ * 132 + 16 * c8 + 4 * q) = (f32x4){lf[4 * q], lf[4 * q + 1], lf[4 * q + 2], lf[4 * q + 3]};
        __syncthreads();
        const int d = 16 * w + c;
        float pre[16], raw[16]; float run = 0.f;
#pragma unroll
        for (int i = 0; i < 16; ++i) { raw[i] = LF[(16 * g + i) * 132 + d]; run += raw[i]; pre[i] = run; }
        float off = 0.f, tot = 0.f;
#pragma unroll
        for (int q = 0; q < 4; ++q) { const float t = __shfl(run, c + 16 * q); tot += t; off += (q < g) ? t : 0.f; }
        unsigned pkd[8];
#pragma unroll
        for (int i = 0; i < 8; ++i) { const float k0 = (1.0f - fast_exp(raw[2 * i])) * fast_exp(tot - (off + pre[2 * i])), k1 = (1.0f - fast_exp(raw[2 * i + 1])) * fast_exp(tot - (off + pre[2 * i + 1])); pkd[i] = pk2(k0, k1); }
        if (dir == 0) {
            *(LAS u32x4*)(KT + d * 72 + 16 * g) = (u32x4){pkd[0], pkd[1], pkd[2], pkd[3]};
            *(LAS u32x4*)(KT + d * 72 + 16 * g + 8) = (u32x4){pkd[4], pkd[5], pkd[6], pkd[7]};
        } else {
#pragma unroll
            for (int i = 0; i < 8; ++i) pkd[i] = (pkd[i] >> 16) | (pkd[i] << 16);
            *(LAS u32x4*)(KT + d * 72 + 16 * (3 - g)) = (u32x4){pkd[7], pkd[6], pkd[5], pkd[4]};
            *(LAS u32x4*)(KT + d * 72 + 16 * (3 - g) + 8) = (u32x4){pkd[3], pkd[2], pkd[1], pkd[0]};
        }
        if (g == 0) ((float*)(F.ws + WS_DEC))[(size_t)sc_ * 128 + d] = fast_exp(tot);
    } else {
        if (w == 0) {
            const float gbi = F.in[I_MLGB][((l * 2 + dir) * 2 + 0) * 4 + h], gbf = F.in[I_MLGB][((l * 2 + dir) * 2 + 1) * 4 + h];
            const float ig = R.gi + gbi, lfg = logsigmoidf_(R.gf + gbf);
            const float bb = wave_scan_add(lfg, lane), bend = __shfl(bb, 63);
            const float e = bend - bb + ig, mloc = wave_max(e);
            WSC[lane] = fast_exp(e - mloc);
            if (lane == 0) { float* ms = (float*)(F.ws + WS_MLS) + (size_t)sc_ * 2; ms[0] = bend; ms[1] = mloc; }
        }
        __syncthreads();
        float x[2][2][4];
        const float scale = 0.08838834764831845f * WSC[p_];
#pragma unroll
        for (int hf = 0; hf < 2; ++hf)
#pragma unroll
            for (int q = 0; q < 2; ++q) { const u32x2 vq = R.kq[2 * hf + q];
                x[hf][q][0] = bflo(vq.x) * scale; x[hf][q][1] = bfhi(vq.x) * scale; x[hf][q][2] = bflo(vq.y) * scale; x[hf][q][3] = bfhi(vq.y) * scale; }
        const int rr = mrow % TT;
        if (rr >= NCTX) { const int t = rr - NCTX;
#pragma unroll
            for (int hf = 0; hf < 2; ++hf) { const float pos = (float)(hf ? (t & 63) : (t >> 6));
#pragma unroll
                for (int e = 0; e < 4; ++e) { const float rev = pos * (__builtin_amdgcn_exp2f(-(float)(4 * c8 + e) * 0.41524101186092030f) * 0.15915494309189535f);
                    const float cs = __builtin_amdgcn_cosf(rev), sn = __builtin_amdgcn_sinf(rev);
                    const float p1 = x[hf][0][e], p2 = x[hf][1][e]; x[hf][0][e] = p1 * cs - p2 * sn; x[hf][1][e] = p1 * sn + p2 * cs; } } }
        const int n_ = dir == 0 ? p_ : 63 - p_;
#pragma unroll
        for (int hf = 0; hf < 2; ++hf)
#pragma unroll
            for (int q = 0; q < 2; ++q)
#pragma unroll
                for (int e = 0; e < 4; ++e) KT[(64 * hf + 32 * q + 4 * c8 + e) * 72 + n_] = (bf16_t)f2bf(x[hf][q][e]);
    }
    __syncthreads();
#pragma unroll
    for (int it = 0; it < 2; ++it) { const int q = tid + 512 * it, row = q >> 3, c16 = q & 7;
        *(u32x4*)(KTG + row * 64 + 8 * c16) = *(const LAS u32x4*)(KT + row * 72 + 8 * c16); }
    if (ML && tid < 128) {
        float ns = 0.f;
#pragma unroll
        for (int q = 0; q < 8; ++q) { const u32x4 vq = *(const LAS u32x4*)(KT + tid * 72 + 8 * q);
            ns += (bflo(vq.x) + bfhi(vq.x)) + (bflo(vq.y) + bfhi(vq.y)) + (bflo(vq.z) + bfhi(vq.z)) + (bflo(vq.w) + bfhi(vq.w)); }
        ((float*)(F.ws + WS_NSG))[(size_t)sc_ * 128 + tid] = ns;
    }
}
template <bool ML>
__device__ __forceinline__ void prep_loop(Frame& F, int l) {
    int tid = F.tid; asm volatile("" : "+v"(tid));
    const int nblk = F.G, first = F.bid;
    PrepRegs nxt;
    if (first < 32 * NCH) prep_load<ML>(F, first, tid, nxt);
    for (int v = first; v < 32 * NCH; v += nblk) {
        const PrepRegs cur = nxt;
        if (v + nblk < 32 * NCH) prep_load<ML>(F, v + nblk, tid, nxt);
        prep_body<ML>(F, l, v, tid, cur);
    }
}

constexpr int SCAN_RD = 8;
constexpr int SC_SM = 0, SC_SM2 = 34816, SC_SLOT = 35840, SC_SLOTB = 27648;
struct ScanRegs { u32x4 k0, k1, v0; };
template <bool ML>
__device__ __forceinline__ void scan_unit(Frame& F, int b, int h, int dir, int vs) {
    const int sq = (b * 4 + h) * 2 + dir;
    const bf16_t* KTG = (const bf16_t*)(F.ws + (ML ? WS_KTG1 : WS_KTG0)) + (size_t)sq * NCH * 8192;
    const bf16_t* VG = (const bf16_t*)(F.ws + WS_VTG) + ((size_t)(b * NCH) * 1536 + (ML ? V_ML : V_HG) + 128 * h + 64 * vs) * 64;
    bf16_t* SP = (bf16_t*)(F.ws + WS_SP) + ((size_t)(((ML ? 1 : 0) * 32 + sq) * NCH)) * 16384;
    float* NST = (float*)(F.ws + WS_NST) + (size_t)(sq * NCH) * 132;
    int tid = F.tid; asm volatile("" : "+v"(tid));
    const int lane = tid & 63, w = F.wave, g = lane >> 4, c = lane & 15, ks = w & 3, nbh = w >> 2;
    LAS float* SM = (LAS float*)(F.lds + SC_SM); LAS float* SM2 = (LAS float*)(F.lds + SC_SM2);
    const int krow = tid >> 3, kc8 = tid & 7;
#define SCAN_LOAD(R, Cc) do { const int cc_ = (Cc); const int cn_ = dir == 0 ? cc_ : (cc_ < 4 ? 3 - cc_ : 71 - cc_); \
        const bf16_t* kp_ = KTG + (size_t)cc_ * 8192 + krow * 64 + 8 * kc8; (R).k0 = *(const u32x4*)kp_; (R).k1 = *(const u32x4*)(kp_ + 64 * 64); \
        (R).v0 = *(const u32x4*)(VG + ((size_t)cn_ * 1536 + krow) * 64 + 8 * kc8); } while (0)
#define SCAN_PARK(R, slot) do { LAS bf16_t* kt_ = (LAS bf16_t*)(F.lds + SC_SLOT + (slot) * SC_SLOTB); \
        *(LAS u32x4*)(kt_ + krow * 72 + 8 * kc8) = (R).k0; *(LAS u32x4*)(kt_ + (krow + 64) * 72 + 8 * kc8) = (R).k1; *(LAS u32x4*)(kt_ + 128 * 72 + krow * 72 + 8 * kc8) = (R).v0; } while (0)
    ScanRegs ring[SCAN_RD];
    __syncthreads();
    {   ScanRegs r0; SCAN_LOAD(r0, 0);
#pragma unroll
        for (int j = 0; j < SCAN_RD; ++j) SCAN_LOAD(ring[(j + 1) % SCAN_RD], j + 1);
        const float* src = (const float*)(F.ws + (ML ? WS_NSG : WS_DEC)) + (size_t)sq * NCH * 128;
        for (int i = tid; i < NCH * 128 / 4; i += 512) *(LAS f32x4*)(SM + 4 * i) = *(const f32x4*)(src + 4 * i);
        if (ML && tid < NCH * 2) SM2[tid] = ((const float*)(F.ws + WS_MLS))[(size_t)sq * NCH * 2 + tid];
        SCAN_PARK(r0, 0); }
    __syncthreads();
    f32x4 acc[2][2];
#pragma unroll
    for (int mb = 0; mb < 2; ++mb)
#pragma unroll
        for (int nb = 0; nb < 2; ++nb) acc[mb][nb] = (f32x4){0.f, 0.f, 0.f, 0.f};
    float m_old = 0.f, nreg = 0.f;
    for (int C0 = 0; C0 < NCH; C0 += SCAN_RD) {
#pragma unroll
        for (int j = 0; j < SCAN_RD; ++j) {
            const int C = C0 + j;
            if (C >= NCH) break;
            SCAN_PARK(ring[(j + 1) % SCAN_RD], (C + 1) & 1); { const int cl_ = C + 1 + SCAN_RD; SCAN_LOAD(ring[(j + 1) % SCAN_RD], cl_ < NCH ? cl_ : NCH - 1); }
            const LAS bf16_t* kt = (const LAS bf16_t*)(F.lds + SC_SLOT + (C & 1) * SC_SLOTB); const LAS bf16_t* vt = kt + 128 * 72;
            const bf16x8 a00 = *(const LAS bf16x8*)(kt + (32 * ks + c) * 72 + 8 * g), a01 = *(const LAS bf16x8*)(kt + (32 * ks + c) * 72 + 32 + 8 * g);
            const bf16x8 a10 = *(const LAS bf16x8*)(kt + (32 * ks + 16 + c) * 72 + 8 * g), a11 = *(const LAS bf16x8*)(kt + (32 * ks + 16 + c) * 72 + 32 + 8 * g);
            float sc = 1.f; f32x4 d0, d1;
            if (ML) {
                const float bend = SM2[2 * C], mloc = SM2[2 * C + 1];
                const float mnew = fmaxf(bend + m_old, mloc), w_old = fast_exp(bend + m_old - mnew);
                sc = fast_exp(mloc - mnew);
                if (tid < 128) { const float nsv = SM[C * 128 + tid]; SM[C * 128 + tid] = nreg; nreg = w_old * nreg + sc * nsv; }
                if (tid == 0) SM2[2 * NCH + C] = m_old;
                m_old = mnew; d0 = (f32x4){w_old, w_old, w_old, w_old}; d1 = d0;
            } else { d0 = *(const LAS f32x4*)(SM + C * 128 + 32 * ks + 4 * g); d1 = *(const LAS f32x4*)(SM + C * 128 + 32 * ks + 16 + 4 * g); }
#pragma unroll
            for (int nb = 0; nb < 2; ++nb)
                *(u32x4*)(SP + (size_t)C * 16384 + (size_t)(((ks * 8 + 4 * vs + 2 * nbh + nb) * 64 + lane) * 8)) =
                    (u32x4){pk2(acc[0][nb][0], acc[0][nb][1]), pk2(acc[0][nb][2], acc[0][nb][3]), pk2(acc[1][nb][0], acc[1][nb][1]), pk2(acc[1][nb][2], acc[1][nb][3])};
#pragma unroll
            for (int nb = 0; nb < 2; ++nb) {
                const bf16x8 bk0 = *(const LAS bf16x8*)(vt + (32 * nbh + 16 * nb + c) * 72 + 8 * g), bk1 = *(const LAS bf16x8*)(vt + (32 * nbh + 16 * nb + c) * 72 + 32 + 8 * g);
                if (ML) {
                    f32x4 t0 = (f32x4){0.f, 0.f, 0.f, 0.f}, t1 = t0;
                    t0 = mfma16(a00, bk0, t0); t0 = mfma16(a01, bk1, t0); t1 = mfma16(a10, bk0, t1); t1 = mfma16(a11, bk1, t1);
                    acc[0][nb] = acc[0][nb] * d0 + t0 * sc; acc[1][nb] = acc[1][nb] * d1 + t1 * sc;
                } else {
                    acc[0][nb] = acc[0][nb] * d0; acc[1][nb] = acc[1][nb] * d1;
                    acc[0][nb] = mfma16(a00, bk0, acc[0][nb]); acc[0][nb] = mfma16(a01, bk1, acc[0][nb]); acc[1][nb] = mfma16(a10, bk0, acc[1][nb]); acc[1][nb] = mfma16(a11, bk1, acc[1][nb]); }
            }
            __syncthreads();
        }
    }
    if (ML && vs == 0) {
        __syncthreads();
        for (int i = tid; i < NCH * 128; i += 512) NST[(size_t)(i >> 7) * 132 + (i & 127)] = SM[i];
        if (tid < NCH) NST[(size_t)tid * 132 + 128] = SM2[2 * NCH + tid];
    }
#undef SCAN_LOAD
#undef SCAN_PARK
}

constexpr int R2_QS = 0, R2_GT = 17408, R2_KS = 51200, R2_ST = 51200  , R2_VT = 83968, R2_AM = 102400, R2_OT = 111616, R2_SEG = 145408, R2_SC = 147456;
__device__ __forceinline__ bf16x8 hg_frag(const LAS bf16_t* X, const LAS float* G, int row, int ks, int g, const LAS float* ref, float sgn) {
    const u32x4 xv = *(const LAS u32x4*)(X + row * 136 + 32 * ks + 8 * g);
    f32x4 g0 = *(const LAS f32x4*)(G + row * 132 + 32 * ks + 8 * g), g1 = *(const LAS f32x4*)(G + row * 132 + 32 * ks + 8 * g + 4);
    if (ref) { g0 = g0 - *(const LAS f32x4*)(ref + 32 * ks + 8 * g); g1 = g1 - *(const LAS f32x4*)(ref + 32 * ks + 8 * g + 4); }
    u32x4 o;
    o.x = pk2(bflo(xv.x) * fast_exp(sgn * g0.x), bfhi(xv.x) * fast_exp(sgn * g0.y)); o.y = pk2(bflo(xv.y) * fast_exp(sgn * g0.z), bfhi(xv.y) * fast_exp(sgn * g0.w));
    o.z = pk2(bflo(xv.z) * fast_exp(sgn * g1.x), bfhi(xv.z) * fast_exp(sgn * g1.y)); o.w = pk2(bflo(xv.w) * fast_exp(sgn * g1.z), bfhi(xv.w) * fast_exp(sgn * g1.w));
    return __builtin_bit_cast(bf16x8, o);
}
__device__ __forceinline__ bf16x8 hg_frag_perm(const LAS bf16_t* X, const LAS float* G, int row, int ks, int g) {
    const u32x2 xa = *(const LAS u32x2*)(X + row * 136 + 32 * ks + 4 * g), xb = *(const LAS u32x2*)(X + row * 136 + 32 * ks + 16 + 4 * g);
    const f32x4 g0 = *(const LAS f32x4*)(G + row * 132 + 32 * ks + 4 * g), g1 = *(const LAS f32x4*)(G + row * 132 + 32 * ks + 16 + 4 * g);
    u32x4 o;
    o.x = pk2(bflo(xa.x) * fast_exp(g0.x), bfhi(xa.x) * fast_exp(g0.y)); o.y = pk2(bflo(xa.y) * fast_exp(g0.z), bfhi(xa.y) * fast_exp(g0.w));
    o.z = pk2(bflo(xb.x) * fast_exp(g1.x), bfhi(xb.x) * fast_exp(g1.y)); o.w = pk2(bflo(xb.y) * fast_exp(g1.z), bfhi(xb.y) * fast_exp(g1.w));
    return __builtin_bit_cast(bf16x8, o);
}
struct R2Regs { u32x4 rows[4]; u32x4 aux[2]; u32x4 st[4]; float gi, gf; };
#define R2_DECL \
    const bf16_t* P = (const bf16_t*)(F.ws + WS_PROJ); bf16_t* BR = (bf16_t*)(F.ws + WS_BR); \
    LAS bf16_t* QS = (LAS bf16_t*)(F.lds + R2_QS); LAS bf16_t* KS = (LAS bf16_t*)(F.lds + R2_KS); LAS float* GT = (LAS float*)(F.lds + R2_GT); \
    LAS bf16_t* VT = (LAS bf16_t*)(F.lds + R2_VT); LAS bf16_t* AM = (LAS bf16_t*)(F.lds + R2_AM); LAS float* OT = (LAS float*)(F.lds + R2_OT); \
    LAS bf16_t* STL = (LAS bf16_t*)(F.lds + R2_ST); LAS float* SEG = (LAS float*)(F.lds + R2_SEG); LAS float* SC = (LAS float*)(F.lds + R2_SC); \
    LAS float* S_AS = SC, *S_MU = SC + 64, *S_WI = SC + 128, *S_FL = SC + 192, *S_QN = SC + 256, *S_DEN = SC + 320; \
    const int lane = tid & 63, w = F.wave, g = lane >> 4, c = lane & 15, p_ = tid >> 3, c8 = tid & 7; \
    (void)P; (void)BR; (void)QS; (void)KS; (void)GT; (void)VT; (void)AM; (void)OT; (void)STL; (void)SEG; (void)S_AS; (void)S_MU; (void)S_WI; (void)S_FL; (void)S_QN; (void)S_DEN; (void)lane; (void)w; (void)g; (void)c; (void)p_; (void)c8;
template <bool ML>
__device__ __forceinline__ void r2_load(Frame& F, int b, int h, int cn, int dir, int tid, R2Regs& R) {

    const bf16_t* P = (const bf16_t*)(F.ws + WS_PROJ);
    const int p_ = tid >> 3, c8 = tid & 7;
    const int C = dir == 0 ? cn : (cn < 4 ? 3 - cn : 71 - cn);
    const int mrow = tokrow(b, dir, 64 * C + p_);
    if (!ML) {
        const bf16_t* qp = P + (size_t)mrow * NPROJ + C_HGQ + 128 * h + 16 * c8;
        const bf16_t* zp = P + (size_t)mrow * NPROJ + C_HGF + 512 * dir + 128 * h + 16 * c8;
        R.rows[0] = *(const u32x4*)qp; R.rows[1] = *(const u32x4*)(qp + 8); R.rows[2] = *(const u32x4*)zp; R.rows[3] = *(const u32x4*)(zp + 8);
    } else {
#pragma unroll
        for (int q = 0; q < 4; ++q) {
            const u32x2 vq = *(const u32x2*)(P + (size_t)mrow * NPROJ + C_MLQ + 128 * h + 64 * (q >> 1) + 32 * (q & 1) + 4 * c8);
            const u32x2 vk = *(const u32x2*)(P + (size_t)mrow * NPROJ + C_MLK + 128 * h + 64 * (q >> 1) + 32 * (q & 1) + 4 * c8);
            if (q & 1) { R.rows[q >> 1].z = vq.x; R.rows[q >> 1].w = vq.y; R.rows[2 + (q >> 1)].z = vk.x; R.rows[2 + (q >> 1)].w = vk.y; }
            else { R.rows[q >> 1].x = vq.x; R.rows[q >> 1].y = vq.y; R.rows[2 + (q >> 1)].x = vk.x; R.rows[2 + (q >> 1)].y = vk.y; } }
        if (tid < 64) { const float* G16 = (const float*)(F.ws + WS_G16); const int mr = tokrow(b, dir, 64 * C + tid);
            R.gi = G16[(size_t)mr * 16 + dir * 8 + h]; R.gf = G16[(size_t)mr * 16 + dir * 8 + 4 + h]; }
    }
    {
        const bf16_t* ST = (const bf16_t*)(F.ws + WS_SP) + ((size_t)((((ML ? 1 : 0) * 4 + b) * 4 + h) * 2 + dir) * NCH + C) * 16384;
#pragma unroll
        for (int it = 0; it < 4; ++it) R.st[it] = *(const u32x4*)(ST + (size_t)(tid + 512 * it) * 8); }
    if (dir == 0) {
        const bf16_t* VG = (const bf16_t*)(F.ws + WS_VTG) + ((size_t)(b * NCH + cn) * 1536 + (ML ? V_ML : V_HG) + 128 * h) * 64;
#pragma unroll
        for (int it = 0; it < 2; ++it) { const int q = tid + 512 * it; R.aux[it] = *(const u32x4*)(VG + (size_t)(q >> 3) * 64 + 8 * (q & 7)); }
    } else {
        const bf16_t* gp = P + (size_t)(b * TT + 64 * cn + p_) * NPROJ + (ML ? C_MLO : C_HGG) + 128 * h + 16 * c8;
        R.aux[0] = *(const u32x4*)gp; R.aux[1] = *(const u32x4*)(gp + 8);
    }
}
template <bool ML>
__device__ __forceinline__ void r2_dir(Frame& F, int l, int b, int h, int cn, int dir, int tid, const R2Regs& R) {

    R2_DECL
    const int C = dir == 0 ? cn : (cn < 4 ? 3 - cn : 71 - cn);
    const int mrow = tokrow(b, dir, 64 * C + p_);
    const float* NSTc = (const float*)(F.ws + WS_NST) + ((size_t)(((b * 4 + h) * 2 + dir) * NCH) + C) * 132;
    __syncthreads();
    if (dir == 0) {
#pragma unroll
        for (int it = 0; it < 2; ++it) { const int q = tid + 512 * it; *(LAS u32x4*)(VT + (q >> 3) * 72 + 8 * (q & 7)) = R.aux[it]; } }
    if (!ML) {
        const u32x4 q0 = R.rows[0], q1 = R.rows[1], z0 = R.rows[2], z1 = R.rows[3];
        float qv[16], lf[16];
#pragma unroll
        for (int q = 0; q < 4; ++q) { qv[2 * q] = bflo(q0[q]); qv[2 * q + 1] = bfhi(q0[q]); qv[8 + 2 * q] = bflo(q1[q]); qv[8 + 2 * q + 1] = bfhi(q1[q]);
            lf[2 * q] = bflo(z0[q]); lf[2 * q + 1] = bfhi(z0[q]); lf[8 + 2 * q] = bflo(z1[q]); lf[8 + 2 * q + 1] = bfhi(z1[q]); }
        unsigned qk[8], kk[8];
#pragma unroll
        for (int e = 0; e < 16; e += 2) {
            const float f0 = fast_exp(lf[e]), f1 = fast_exp(lf[e + 1]);
            kk[e >> 1] = pk2(1.0f - f0, 1.0f - f1); qk[e >> 1] = pk2(siluf_(qv[e]), siluf_(qv[e + 1])); }
        *(LAS u32x4*)(QS + p_ * 136 + 16 * c8) = (u32x4){qk[0], qk[1], qk[2], qk[3]}; *(LAS u32x4*)(QS + p_ * 136 + 16 * c8 + 8) = (u32x4){qk[4], qk[5], qk[6], qk[7]};
        *(LAS u32x4*)(KS + p_ * 136 + 16 * c8) = (u32x4){kk[0], kk[1], kk[2], kk[3]}; *(LAS u32x4*)(KS + p_ * 136 + 16 * c8 + 8) = (u32x4){kk[4], kk[5], kk[6], kk[7]};
#pragma unroll
        for (int q = 0; q < 4; ++q) *(LAS f32x4*)(GT + p_ * 132 + 16 * c8 + 4 * q) = (f32x4){lf[4 * q], lf[4 * q + 1], lf[4 * q + 2], lf[4 * q + 3]};
        __syncthreads();
        {
            const int d = 16 * w + c;
            float pre[16]; float run = 0.f;
#pragma unroll
            for (int i = 0; i < 16; ++i) { run += GT[(16 * g + i) * 132 + d]; pre[i] = run; }
            float off = 0.f;
#pragma unroll
            for (int q = 0; q < 4; ++q) { const float t = __shfl(run, c + 16 * q); off += (q < g) ? t : 0.f; }
#pragma unroll
            for (int i = 0; i < 16; ++i) GT[(16 * g + i) * 132 + d] = off + pre[i]; }
    } else {
        float xq[2][2][4], xk[2][2][4];
#pragma unroll
        for (int hf = 0; hf < 2; ++hf) {
            const u32x4 vq = R.rows[hf], vk = R.rows[2 + hf];
            xq[hf][0][0] = bflo(vq.x); xq[hf][0][1] = bfhi(vq.x); xq[hf][0][2] = bflo(vq.y); xq[hf][0][3] = bfhi(vq.y); xq[hf][1][0] = bflo(vq.z); xq[hf][1][1] = bfhi(vq.z); xq[hf][1][2] = bflo(vq.w); xq[hf][1][3] = bfhi(vq.w);
            const float ksc = 0.08838834764831845f;
            xk[hf][0][0] = bflo(vk.x) * ksc; xk[hf][0][1] = bfhi(vk.x) * ksc; xk[hf][0][2] = bflo(vk.y) * ksc; xk[hf][0][3] = bfhi(vk.y) * ksc; xk[hf][1][0] = bflo(vk.z) * ksc; xk[hf][1][1] = bfhi(vk.z) * ksc; xk[hf][1][2] = bflo(vk.w) * ksc; xk[hf][1][3] = bfhi(vk.w) * ksc; }
        { const int rr = mrow % TT;
          if (rr >= NCTX) { const int t = rr - NCTX;
#pragma unroll
            for (int hf = 0; hf < 2; ++hf) { const float pos = (float)(hf ? (t & 63) : (t >> 6));
#pragma unroll
                for (int e = 0; e < 4; ++e) { const float rev = pos * (__builtin_amdgcn_exp2f(-(float)(4 * c8 + e) * 0.41524101186092030f) * 0.15915494309189535f);
                    const float cs = __builtin_amdgcn_cosf(rev), sn = __builtin_amdgcn_sinf(rev);
                    const float a1 = xq[hf][0][e], a2 = xq[hf][1][e]; xq[hf][0][e] = a1 * cs - a2 * sn; xq[hf][1][e] = a1 * sn + a2 * cs;
                    const float b1 = xk[hf][0][e], b2 = xk[hf][1][e]; xk[hf][0][e] = b1 * cs - b2 * sn; xk[hf][1][e] = b1 * sn + b2 * cs; } } } }
        float qn = 0.f;
#pragma unroll
        for (int hf = 0; hf < 2; ++hf)
#pragma unroll
            for (int q = 0; q < 2; ++q) { const int ch = 64 * hf + 32 * q + 4 * c8;
                const f32x4 nv = *(const f32x4*)(NSTc + ch);
                qn += (xq[hf][q][0] * nv.x + xq[hf][q][1] * nv.y) + (xq[hf][q][2] * nv.z + xq[hf][q][3] * nv.w);
                *(LAS u32x2*)(QS + p_ * 136 + ch) = (u32x2){pk2(xq[hf][q][0], xq[hf][q][1]), pk2(xq[hf][q][2], xq[hf][q][3])};
                *(LAS u32x2*)(KS + p_ * 136 + ch) = (u32x2){pk2(xk[hf][q][0], xk[hf][q][1]), pk2(xk[hf][q][2], xk[hf][q][3])}; }
        qn += __shfl_xor(qn, 1); qn += __shfl_xor(qn, 2); qn += __shfl_xor(qn, 4);
        if (c8 == 0) S_QN[p_] = qn;
        if (w == 0) {
            const int mr = tokrow(b, dir, 64 * C + lane);
            const float gbi = F.in[I_MLGB][((l * 2 + dir) * 2 + 0) * 4 + h], gbf = F.in[I_MLGB][((l * 2 + dir) * 2 + 1) * 4 + h];
            const float ig = R.gi + gbi, lfg = logsigmoidf_(R.gf + gbf);
            const float bb = wave_scan_add(lfg, lane), a = ig - bb, mu = fmaxf(NSTc[128], wave_scan_max(a, lane));
            S_AS[lane] = a; S_MU[lane] = mu; S_WI[lane] = fast_exp(NSTc[128] - mu); S_FL[lane] = fast_exp(-bb - mu);
        }
    }
    __syncthreads();
    if (!ML) {
        const int J = w < 4 ? w : (w == 4 ? 0 : (w == 5 ? 1 : (w == 6 ? 0 : 2)));
        const int I0 = w < 4 ? w : (w == 4 ? 1 : (w == 5 ? 2 : 3));
        const int nblk = (w == 4 || w == 5) ? 2 : 1;
        const LAS float* ref = GT + ((w < 4) ? 16 * J + 8 : 16 * J + 15) * 132;
        f32x4 z0 = (f32x4){0.f, 0.f, 0.f, 0.f}, z1 = z0;
#pragma unroll
        for (int ks = 0; ks < 4; ++ks) {
            const bf16x8 kf = hg_frag(KS, GT, 16 * J + c, ks, g, ref, -1.0f);
            z0 = mfma16(kf, hg_frag(QS, GT, 16 * I0 + c, ks, g, ref, 1.0f), z0);
            if (nblk == 2) z1 = mfma16(kf, hg_frag(QS, GT, 16 * (I0 + 1) + c, ks, g, ref, 1.0f), z1);
        }
        for (int q = 0; q < nblk; ++q) {
            const int I = I0 + q;
            f32x4 z = q ? z1 : z0;
            if (I == J) {
#pragma unroll
                for (int r = 0; r < 4; ++r) z[r] = (4 * g + r <= c) ? z[r] : 0.f; }
            if (dir == 0) *(LAS u32x2*)(AM + (16 * I + c) * 72 + 16 * J + 4 * g) = (u32x2){pk2(z[0], z[1]), pk2(z[2], z[3])};
            else *(LAS u32x2*)(AM + (16 * I + c) * 72 + 16 * (3 - J) + 12 - 4 * g) = (u32x2){pk2(z[3], z[2]), pk2(z[1], z[0])};
        }
        if (w == 7) {
            for (int i = lane; i < 6 * 16 * 2; i += 64) { const int blk = i >> 5, rr = (i >> 1) & 15, hh = i & 1;
                const int Iz = blk < 3 ? 0 : (blk < 5 ? 1 : 2), Jz = blk < 3 ? 1 + blk : (blk < 5 ? blk - 1 : 3);
                *(LAS u32x4*)(AM + (16 * Iz + rr) * 72 + 16 * (dir == 0 ? Jz : 3 - Jz) + 8 * hh) = (u32x4){0u, 0u, 0u, 0u}; }
        }
    } else {
        const int I = w & 3, par = w >> 2;
        float dsum = 0.f;
        const float mu = S_MU[16 * I + c];
        for (int J = par; J < 4; J += 2) {
            if (J <= I) {
                f32x4 z = (f32x4){0.f, 0.f, 0.f, 0.f};
#pragma unroll
                for (int ks = 0; ks < 4; ++ks) z = mfma16(*(const LAS bf16x8*)(KS + (16 * J + c) * 136 + 32 * ks + 8 * g), *(const LAS bf16x8*)(QS + (16 * I + c) * 136 + 32 * ks + 8 * g), z);
                const f32x4 as = *(const LAS f32x4*)(S_AS + 16 * J + 4 * g);
#pragma unroll
                for (int r = 0; r < 4; ++r) { const bool ok = (J < I) || (4 * g + r <= c); z[r] = ok ? fast_exp(as[r] - mu) * z[r] : 0.f; dsum += z[r]; }
                if (dir == 0) *(LAS u32x2*)(AM + (16 * I + c) * 72 + 16 * J + 4 * g) = (u32x2){pk2(z[0], z[1]), pk2(z[2], z[3])};
                else *(LAS u32x2*)(AM + (16 * I + c) * 72 + 16 * (3 - J) + 12 - 4 * g) = (u32x2){pk2(z[3], z[2]), pk2(z[1], z[0])};
            } else {
                *(LAS u32x2*)(AM + (16 * I + c) * 72 + 16 * (dir == 0 ? J : 3 - J) + 4 * g) = (u32x2){0u, 0u};
            }
        }
        dsum += __shfl_xor(dsum, 16); dsum += __shfl_xor(dsum, 32);
        if (g == 0) S_DEN[par * 64 + 16 * I + c] = dsum;
    }
    __syncthreads();
#pragma unroll
    for (int it = 0; it < 4; ++it) *(LAS u32x4*)(STL + (tid + 512 * it) * 8) = R.st[it];
    __syncthreads();
    {
        const int I = w & 3, half = w >> 2;
        f32x4 o[4];
#pragma unroll
        for (int nb = 0; nb < 4; ++nb) o[nb] = (f32x4){0.f, 0.f, 0.f, 0.f};
#pragma unroll
        for (int ks = 0; ks < 4; ++ks) {
            const bf16x8 af = ML ? cat4(*(const LAS bf16x4*)(QS + (16 * I + c) * 136 + 32 * ks + 4 * g), *(const LAS bf16x4*)(QS + (16 * I + c) * 136 + 32 * ks + 16 + 4 * g)) : hg_frag_perm(QS, GT, 16 * I + c, ks, g);
#pragma unroll
            for (int nb = 0; nb < 4; ++nb) { const bf16x8 bf = *(const LAS bf16x8*)(STL + ((ks * 8 + 4 * half + nb) * 64 + lane) * 8); o[nb] = mfma16(af, bf, o[nb]); } }
        if (ML) { const f32x4 wi = *(const LAS f32x4*)(S_WI + 16 * I + 4 * g);
#pragma unroll
            for (int nb = 0; nb < 4; ++nb) o[nb] = o[nb] * wi; }
#pragma unroll
        for (int kp = 0; kp < 2; ++kp) {
            const bf16x8 af = *(const LAS bf16x8*)(AM + (16 * I + c) * 72 + 32 * kp + 8 * g);
#pragma unroll
            for (int nb = 0; nb < 4; ++nb) { const bf16x8 bf = *(const LAS bf16x8*)(VT + (64 * half + 16 * nb + c) * 72 + 32 * kp + 8 * g); o[nb] = mfma16(af, bf, o[nb]); } }
        f32x4 rs = (f32x4){1.f, 1.f, 1.f, 1.f};
        if (ML) {
#pragma unroll
            for (int r = 0; r < 4; ++r) { const int pp = 16 * I + 4 * g + r; const float den = S_DEN[pp] + S_DEN[64 + pp] + S_WI[pp] * S_QN[pp]; rs[r] = fast_rcp(fmaxf(fabsf(den), S_FL[pp])); } }
#pragma unroll
        for (int r = 0; r < 4; ++r) { const int pp = 16 * I + 4 * g + r; const int nl = dir == 0 ? pp : 63 - pp;
#pragma unroll
            for (int nb = 0; nb < 4; ++nb) { LAS float* op = OT + nl * 132 + 64 * half + 16 * nb + c; const float val = o[nb][r] * rs[r]; *op = (dir == 0) ? val : *op + val; } }
    }
}
template <bool ML>
__device__ __forceinline__ void r2_finish(Frame& F, int l, int b, int h, int cn, int tid, const R2Regs& R) {
    R2_DECL
    __syncthreads();
    {
        const int m = b * TT + 64 * cn + p_;
        float ov[16]; float ss = 0.f;
#pragma unroll
        for (int q = 0; q < 4; ++q) { const f32x4 t = *(const LAS f32x4*)(OT + p_ * 132 + 16 * c8 + 4 * q); ov[4 * q] = t.x; ov[4 * q + 1] = t.y; ov[4 * q + 2] = t.z; ov[4 * q + 3] = t.w; ss += (t.x * t.x + t.y * t.y) + (t.z * t.z + t.w * t.w); }
        ss += __shfl_xor(ss, 1); ss += __shfl_xor(ss, 2); ss += __shfl_xor(ss, 4);
        const float rstd = 1.0f / sqrtf(ss * (1.0f / 128.0f) + EPS);
        const u32x4 g0 = R.aux[0], g1 = R.aux[1];
        const float* nw = F.in[ML ? I_MLNW : I_HGNW] + l * 512 + 128 * h + 16 * c8;
        unsigned ow[8];
#pragma unroll
        for (int q = 0; q < 8; ++q) { const unsigned gw_ = q < 4 ? g0[q] : g1[q - 4]; const float ga = bflo(gw_), gb = bfhi(gw_);
            const float fa = ML ? sigmoidf_(ga) : siluf_(ga), fb = ML ? sigmoidf_(gb) : siluf_(gb);
            ow[q] = pk2(ov[2 * q] * rstd * nw[2 * q] * fa, ov[2 * q + 1] * rstd * nw[2 * q + 1] * fb); }
        bf16_t* op = BR + (size_t)m * 1536 + (ML ? 1024 : 512) + 128 * h + 16 * c8;
        *(u32x4*)op = (u32x4){ow[0], ow[1], ow[2], ow[3]}; *(u32x4*)(op + 8) = (u32x4){ow[4], ow[5], ow[6], ow[7]};
    }
}
__device__ __forceinline__ void r2_decode(int u, int G, int c0, int ncn, int& mix, int& b, int& h, int& cn) { mix = (u + u / G) & 1; const int v = u >> 1; cn = c0 + v % ncn; const int bh = v / ncn; b = bh >> 2; h = bh & 3; }
template <bool T0>
__device__ __forceinline__ void r2_loop(Frame& F, int l, int c0, int ncn, int nu) {
    int tid = F.tid; asm volatile("" : "+v"(tid));
#ifdef R2_NOPREFETCH
    for (int u = F.bid; u < nu; u += F.G) {
        int mix, b, h, cn; r2_decode(u, F.G, c0, ncn, mix, b, h, cn);
        R2Regs ra, rb;
        if (mix == 0) { r2_load<false>(F, b, h, cn, 0, tid, ra); r2_load<false>(F, b, h, cn, 1, tid, rb); r2_dir<false>(F, l, b, h, cn, 0, tid, ra); r2_dir<false>(F, l, b, h, cn, 1, tid, rb); r2_finish<false>(F, l, b, h, cn, tid, rb); }
        else { r2_load<true>(F, b, h, cn, 0, tid, ra); r2_load<true>(F, b, h, cn, 1, tid, rb); r2_dir<true>(F, l, b, h, cn, 0, tid, ra); r2_dir<true>(F, l, b, h, cn, 1, tid, rb); r2_finish<true>(F, l, b, h, cn, tid, rb); }
    }
#else
    R2Regs ra, rb; int mix, b, h, cn, b2, h2, cn2;
    int u = F.bid; if (u >= nu) return;
    r2_decode(u, F.G, c0, ncn, mix, b, h, cn);
    r2_load<T0>(F, b, h, cn, 0, tid, ra);
    for (;;) {
        r2_load<T0>(F, b, h, cn, 1, tid, rb);
        r2_dir<T0>(F, l, b, h, cn, 0, tid, ra);
        const int u2 = u + F.G; const bool has2 = u2 < nu;
        if (has2) { r2_decode(u2, F.G, c0, ncn, mix, b2, h2, cn2); r2_load<!T0>(F, b2, h2, cn2, 0, tid, ra); }
        r2_dir<T0>(F, l, b, h, cn, 1, tid, rb);
        r2_finish<T0>(F, l, b, h, cn, tid, rb);
        if (!has2) break;
        r2_load<!T0>(F, b2, h2, cn2, 1, tid, rb);
        r2_dir<!T0>(F, l, b2, h2, cn2, 0, tid, ra);
        const int u3 = u2 + F.G; const bool has3 = u3 < nu;
        if (has3) { r2_decode(u3, F.G, c0, ncn, mix, b, h, cn); r2_load<T0>(F, b, h, cn, 0, tid, ra); }
        r2_dir<!T0>(F, l, b2, h2, cn2, 1, tid, rb);
        r2_finish<!T0>(F, l, b2, h2, cn2, tid, rb);
        if (!has3) break;
        u = u3;
    }
#endif
}
constexpr int MOE_T1 = 17600, MOE_T2 = 27000;
constexpr int SPL = 11, N_PHASES = 2 + 2 * SPL, PH_FINAL = N_PHASES - 1, PH_EMPTY = 1 + 10;
__device__ __forceinline__ void init_frame(Frame& F, const Args& args, unsigned char* lds_raw) {
    F.lds = (LAS unsigned char*)lds_raw;
    F.MISC = (volatile LAS unsigned*)(F.lds + LDSCTL_OFF);
    F.tid = threadIdx.x; F.lane = F.tid & 63; F.wave = __builtin_amdgcn_readfirstlane(F.tid >> 6);
    F.G = gridDim.x; F.bid = blockIdx.x;
    F.ws = args.ws; F.ctl = (unsigned*)(args.ws + WS_CTL); F.in = args.in; F.out = args.out;
}
template <int PH>
__device__ __forceinline__ void run_phase(Frame& F) {
    LAS unsigned char* lds = F.lds;
    bf16_t* A1 = (bf16_t*)(F.ws + WS_A1); bf16_t* PROJ = (bf16_t*)(F.ws + WS_PROJ); bf16_t* BRb = (bf16_t*)(F.ws + WS_BR); bf16_t* Yb = (bf16_t*)(F.ws + WS_Y);
    bf16_t* HMID = (bf16_t*)(F.ws + WS_HMID); bf16_t* XG = (bf16_t*)(F.ws + WS_XG); bf16_t* YM = (bf16_t*)(F.ws + WS_YM);
    float* H = (float*)(F.ws + WS_H); const float* MOD = (const float*)(F.ws + WS_MOD);
    if constexpr (PH == 0) ph_prologue(F);
    else if constexpr (PH == PH_FINAL) ph_final(F);
    else {
        constexpr int l = (PH - 1) / SPL, sp0 = (PH - 1) % SPL, sp = sp0 <= 2 ? sp0 : (sp0 == 3 ? 100 : sp0 - 1);
        if constexpr (sp == 0) ph_norm1(F, l);
        else if constexpr (sp == 1) {
            pg8::InProjOrder S{(const char*)A1, (const char*)(F.ws + WS_WIN) + (size_t)l * NWIN * 1024 * 2, F.G, F.bid};
            pg8::EpiInProj E{PROJ, (bf16_t*)(F.ws + WS_VTG)};
#ifdef STAGGER_US
            if ((F.bid >> 3) & 1) { const unsigned long long t0 = __builtin_amdgcn_s_memrealtime(); while (__builtin_amdgcn_s_memrealtime() - t0 < (unsigned long long)(STAGGER_US * 100)) __builtin_amdgcn_s_sleep(32); }
#endif
            pg8::gemm_phase(lds, F.tid, 1024, 1024, 1024, S, E);
        } else if constexpr (sp == 2) {
            prep_loop<false>(F, l); prep_loop<true>(F, l);
        } else if constexpr (sp == 100) {
            for (int u = F.bid; u < 128; u += F.G) {
                const int vs = u & 1, sq = (u >> 1) & 31, dir = sq & 1, h = (sq >> 1) & 3, b = sq >> 3;
                if (u < 64) scan_unit<false>(F, b, h, dir, vs); else scan_unit<true>(F, b, h, dir, vs); }
            constexpr int nna = (l == 0) ? 1024 + 64 : 1024;
            for (;;) {
                __syncthreads();
                if (F.tid == 0) F.MISC[16] = xb_add(F.ctl + CW_NAQ + 64 * l, 1u);
                __syncthreads();
                const int u = (int)F.MISC[16];
                if (u >= nna) break;
                if (u < 1024) na_unit<true>(F, l, u >> 8, (u >> 5) & 7, u & 31);
                else { const int v = u - 1024; na_unit<false>(F, l, v >> 4, (v >> 1) & 7, v & 1); } }
        } else if constexpr (sp == 3) {
            constexpr int c0 = (l == 0) ? 0 : 4, ncn = NCH - c0, nu = 2 * 16 * ncn;
            { int mix0, b0_, h0_, cn0_; r2_decode(F.bid, F.G, c0, ncn, mix0, b0_, h0_, cn0_);
              if (mix0 == 0) r2_loop<false>(F, l, c0, ncn, nu); else r2_loop<true>(F, l, c0, ncn, nu); }
        } else if constexpr (sp == 4) {
            pg8::MergeOrder S{(const char*)BRb, (const char*)(F.ws + WS_WB) + (size_t)l * 1024 * 1536 * 2, (size_t)256 * 1536 * 2, (size_t)256 * 1536 * 2, l == 0 ? MT / 256 : 64, 4, F.G, F.bid, l == 0 ? 0 : 1};
            pg8::EpiMerge E{PROJ, Yb};
            pg8::gemm_phase(lds, F.tid, 512, 1536, 1536, S, E);
            if constexpr (l == 0) { if (F.bid >= 16) moe_convert(F, 0, MOE_T1, (F.bid - 16) * NWAVES + F.wave, (F.G - 16) * NWAVES); }
        } else if constexpr (sp == 5) {
            pg8::StaticOrder S{(const char*)Yb, (const char*)(F.ws + WS_WO) + (size_t)l * 1024 * 1024 * 2, (size_t)256 * 1024 * 2, (size_t)256 * 1024 * 2, l == 0 ? MT / 256 : 64, 4, F.G, F.bid, l == 0 ? 0 : 1};
            pg8::EpiResid E{H, MOD + (size_t)l * 5 * 6144 + 2 * 1024};
            pg8::gemm_phase(lds, F.tid, 1024, 1024, 1024, S, E);
            if constexpr (l == 0) { if (F.bid >= 16) moe_convert(F, MOE_T1, MOE_T2, (F.bid - 16) * NWAVES + F.wave, (F.G - 16) * NWAVES); }
        } else if constexpr (sp == 6) ph_norm2(F, l);
        else if constexpr (sp == 7) {
            if constexpr (l == 0) {
                pg8::StaticOrder S{(const char*)A1, (const char*)(F.ws + WS_WUP), (size_t)256 * 1024 * 2, (size_t)256 * 1024 * 2, MT / 256, 2 * FFN / 256, F.G, F.bid, 0};
                pg8::EpiSwiGLU E{HMID, FFN};
                pg8::gemm_phase(lds, F.tid, 1024, 1024, 1024, S, E);
            } else ph_moe_gather(F);
        } else if constexpr (sp == 8) {
            if constexpr (l == 0) {
                pg8::StaticOrder S{(const char*)HMID, (const char*)(F.ws + WS_WDN), (size_t)256 * FFN * 2, (size_t)256 * FFN * 2, MT / 256, 4, F.G, F.bid, 0};
                pg8::EpiResid E{H, MOD + 5 * 1024};
                pg8::gemm_phase(lds, F.tid, FFN, FFN, FFN, S, E);
                if (F.bid >= 16) moe_convert(F, MOE_T2, MOE_XITEMS, (F.bid - 16) * NWAVES + F.wave, (F.G - 16) * NWAVES);
            } else {
                const int* RT = (const int*)(F.ws + WS_ROUTE);
                pg8::MoeOrder S{(const char*)XG, (const char*)(F.ws + WS_MUP), (size_t)1024 * 2, (size_t)256 * 1024 * 2, (size_t)2 * EXD * 1024 * 2, RT + RT_TILE, RT[RT_NT], 2 * EXD / 256, F.G, F.bid, 1 << 30};
                pg8::EpiSwiGLU E{HMID, EXD};
                pg8::gemm_phase(lds, F.tid, 1024, 1024, 1024, S, E);
            }
        } else if constexpr (sp == 9) {
            if constexpr (l == 1) {
                const int* RT = (const int*)(F.ws + WS_ROUTE);
                const int nrt = RT[RT_NT], full = RT[RT_NT + 1], nextra = RT[RT_NT + 2];
                pg8::MoeOrder S{(const char*)HMID, (const char*)(F.ws + WS_MDN), (size_t)EXD * 2, (size_t)256 * EXD * 2, (size_t)1024 * EXD * 2, RT + RT_TILE, nrt, 4, F.G, F.bid, full};
                pg8::EpiStoreBf16 E{YM, 1024};
                pg8::gemm_phase(lds, F.tid, EXD, EXD, EXD, S, E);
                if (nextra > 0) {
                    pg8::MoeSplitOrder S2{(const char*)HMID, (const char*)(F.ws + WS_MDN), (size_t)256 * EXD * 2, (size_t)1024 * EXD * 2, RT + RT_TILE, nrt, 4, F.G, F.bid, full, nextra};
                    pg8::EpiStoreBf16 E2{(bf16_t*)(F.ws + WS_YMP), 256};
                    pg8::gemm_phase(lds, F.tid, 512, EXD, EXD, S2, E2);
                }
            }
        }
    }
}
#ifdef MK_ONE_LAUNCH
template <int PH> __device__ __forceinline__ void run_all(Frame& F, const Args& args, const XcdBarrier& bar) {
    if constexpr (PH < N_PHASES) {
        if constexpr (PH != PH_EMPTY) {
            { size_t zo = 0; asm volatile("" : "+s"(zo)); unsigned char* wsl = args.ws + zo; F.ws = wsl; F.ctl = (unsigned*)(wsl + WS_CTL);
              int ln = (int)__builtin_amdgcn_mbcnt_hi(~0u, __builtin_amdgcn_mbcnt_lo(~0u, 0u)); asm volatile("" : "+v"(ln)); F.lane = ln; F.tid = F.wave * 64 + ln; }
            run_phase<PH>(F);
#ifdef PROBE_DUP
            if constexpr (PH == PROBE_DUP) { xcd_barrier(bar); run_phase<PH>(F); }
#endif
            if constexpr (PH + 1 < N_PHASES) xcd_barrier(bar);
        }
        run_all<PH + 1>(F, args, bar);
    }
}
__global__ void __launch_bounds__(NWAVES * 64, 2) mega_fwd(Args args) {
    extern __shared__ __attribute__((aligned(16))) unsigned char lds_raw[];
    Frame F; init_frame(F, args, lds_raw);
    for (int u = F.tid; u < (LDS_BYTES - LDSCTL_OFF) / 4; u += NWAVES * 64) ((LAS unsigned*)(F.lds + LDSCTL_OFF))[u] = 0u;
    __syncthreads();
    const XcdBarrier bar = xcd_barrier_post(F.ctl + CW_BAR, F.MISC + 8);
    run_all<0>(F, args, bar);
}
#else
template <int PH>
__global__ void __launch_bounds__(NWAVES * 64, 2) k_phase(Args args) {
    extern __shared__ __attribute__((aligned(16))) unsigned char lds_raw[];
    Frame F; init_frame(F, args, lds_raw);
    run_phase<PH>(F);
}
template <int PH> static void launch_phases(int grid, hipStream_t stream, const Args& a) {
    if constexpr (PH < N_PHASES) {
        if constexpr (PH != PH_EMPTY) {
            static bool attr = false;
            if (!attr) { (void)hipFuncSetAttribute((const void*)k_phase<PH>, hipFuncAttributeMaxDynamicSharedMemorySize, LDS_BYTES); attr = true; }
            hipLaunchKernelGGL(k_phase<PH>, dim3(grid), dim3(NWAVES * 64), LDS_BYTES, stream, a);
        }
        launch_phases<PH + 1>(grid, stream, a);
    }
}
#endif

extern "C" void kernel_launch(void* const* d_in, const int* in_sizes, int n_in, void* d_out, int out_size, void* d_ws, size_t ws_size, hipStream_t stream) {
    static int grid = 0;
    if (grid == 0) {
        if (n_in != 22 || out_size != NB * SEQ * DM || ws_size < WS_END) { fprintf(stderr, "kernel_launch: unexpected shapes (n_in %d, out %d, ws %zu, need %zu)\n", n_in, out_size, ws_size, (size_t)WS_END); grid = -1; return; }
        int dev = 0, cus = 0;
        if (hipGetDevice(&dev) != hipSuccess || hipDeviceGetAttribute(&cus, hipDeviceAttributeMultiprocessorCount, dev) != hipSuccess) { grid = -1; return; }
#ifdef MK_ONE_LAUNCH
        int per_cu = 0;
        if (hipFuncSetAttribute((const void*)mega_fwd, hipFuncAttributeMaxDynamicSharedMemorySize, LDS_BYTES) != hipSuccess) { fprintf(stderr, "kernel_launch: hipFuncSetAttribute(%d B LDS) failed\n", LDS_BYTES); grid = -1; return; }
        if (hipOccupancyMaxActiveBlocksPerMultiprocessor(&per_cu, (const void*)mega_fwd, NWAVES * 64, LDS_BYTES) != hipSuccess || per_cu < 1) { fprintf(stderr, "kernel_launch: occupancy query reports %d workgroups per CU; nothing launched\n", per_cu); (void)hipGetLastError(); grid = -1; return; }
#endif
        grid = cus;
    }
    if (grid < 0) return;
    (void)hipMemsetAsync((char*)d_ws + WS_CTL, 0, 32768, stream);
    Args a{};
    for (int i = 0; i < 22; ++i) a.in[i] = (const float*)d_in[i];
    a.out = (float*)d_out; a.ws = (unsigned char*)d_ws; a.ph_lo = 0; a.ph_hi = N_PHASES;
#ifndef MK_ONE_LAUNCH
    launch_phases<0>(grid, stream, a);
#else
    hipLaunchKernelGGL(mega_fwd, dim3(grid), dim3(NWAVES * 64), LDS_BYTES, stream, a);
#endif
}
```

```cpp
#define MK_ONE_LAUNCH 1
#include <hip/hip_runtime.h>
#include <cstdio>
#include <cstdint>

#define LAS __attribute__((address_space(3)))
typedef unsigned short bf16_t;
typedef short bf16x8 __attribute__((ext_vector_type(8)));
typedef short bf16x4 __attribute__((ext_vector_type(4)));
typedef float f32x4 __attribute__((ext_vector_type(4)));
typedef float f32x2 __attribute__((ext_vector_type(2)));
typedef unsigned u32x4 __attribute__((ext_vector_type(4)));
typedef unsigned u32x2 __attribute__((ext_vector_type(2)));

constexpr int NB = 4, SEQ = 4096, DM = 1024, NCTX = 256, DEPTH = 2;
constexpr int TT = NCTX + SEQ;
constexpr int MT = NB * TT;
constexpr int INW = 9232;
constexpr int NPROJ = 7680;
constexpr int NWIN = 9216;
constexpr int C_NAQ = 0, C_NAK = 512, C_HGQ = 1024, C_HGF = 1536, C_HGG = 2560, C_MLQ = 3072, C_MLK = 3584, C_MLO = 4096, C_BG = 4608;
constexpr int V_NA = 0, V_HG = 512, V_ML = 1024;
constexpr int FFN = 2816, EXD = 3584, NEXP = 8;
constexpr int NCH = TT / 64;
constexpr float EPS = 1e-6f;
constexpr int MAXSLOT = 34816;
constexpr int MAXRT = MAXSLOT / 256;

constexpr size_t MiB = 1u << 20;
constexpr size_t WS_CTL = 0;
constexpr size_t WS_MOD = 1 * MiB;
constexpr size_t WS_G16 = 2 * MiB;
constexpr size_t WS_ROUTE = 4 * MiB;
constexpr size_t WS_NST = 5 * MiB;
constexpr size_t WS_WIN = 7 * MiB;
constexpr size_t WS_WB = WS_WIN + 36 * MiB;
constexpr size_t WS_WO = WS_WB + 6 * MiB;
constexpr size_t WS_WUP = WS_WO + 4 * MiB;
constexpr size_t WS_WDN = WS_WUP + 11 * MiB;
constexpr size_t WS_MUP = WS_WDN + 6 * MiB;
constexpr size_t WS_MDN = WS_MUP + 112 * MiB;
constexpr size_t WS_H = WS_MDN + 56 * MiB;
constexpr size_t WS_A1 = WS_H + 68 * MiB;
constexpr size_t WS_PROJ = WS_A1 + 34 * MiB;
constexpr size_t WS_VTG = WS_PROJ + 255 * MiB;
constexpr size_t WS_BR = WS_PROJ + 306 * MiB;
constexpr size_t WS_Y = WS_BR + 51 * MiB;
constexpr size_t WS_SP = WS_Y + 34 * MiB;
constexpr size_t WS_DEC = WS_SP + 136 * MiB;
constexpr size_t WS_NSG = WS_DEC + 2 * MiB;
constexpr size_t WS_MLS = WS_NSG + 2 * MiB;
constexpr size_t WS_END = WS_MLS + 1 * MiB;
constexpr size_t WS_KTG0 = WS_A1;
constexpr size_t WS_KTG1 = WS_Y;
constexpr size_t WS_HMID = WS_PROJ;
constexpr size_t WS_XG = WS_SP;
constexpr size_t WS_YM = WS_BR;
constexpr size_t WS_YMP = WS_SP + 68 * MiB;
static_assert(WS_END <= 896 * MiB, "workspace map exceeds the guaranteed size");
static_assert((size_t)MAXSLOT * EXD * 2 <= 255 * MiB && (size_t)MT * NPROJ * 2 <= 255 * MiB && (size_t)MAXSLOT * 1024 * 2 <= 85 * MiB && (size_t)MAXSLOT * 1024 * 2 <= 136 * MiB, "overlays");

constexpr int RT_TOKE = 0;
constexpr int RT_TOKW = 32768;
constexpr int RT_TOKS = 65536;
constexpr int RT_TILE = 98304;
constexpr int RT_NT = 98304 + 2 * 144;
constexpr int RT_SPLITX = RT_NT + 16;
constexpr int CW_CNT = 64;
constexpr int CW_CUR = 128;
constexpr int CW_NAQ = 256;
constexpr int CW_BAR = 4096;
static_assert((CW_BAR + 3456) * 4 <= 32768, "control words inside the per-call memset");

__device__ __forceinline__ unsigned f2bf(float f) { unsigned u = __builtin_bit_cast(unsigned, f); return (u + 0x7fffu + ((u >> 16) & 1u)) >> 16; }
typedef __bf16 bf16n2 __attribute__((ext_vector_type(2)));
__device__ __forceinline__ unsigned pk2(float lo, float hi) { const f32x2 f = {lo, hi}; return __builtin_bit_cast(unsigned, __builtin_convertvector(f, bf16n2)); }
__device__ __forceinline__ float bf2f(unsigned short b) { return __builtin_bit_cast(float, (unsigned)b << 16); }
__device__ __forceinline__ float bflo(unsigned w) { return __builtin_bit_cast(float, w << 16); }
__device__ __forceinline__ float bfhi(unsigned w) { return __builtin_bit_cast(float, w & 0xffff0000u); }
__device__ __forceinline__ float fast_exp(float x) { return __builtin_amdgcn_exp2f(x * 1.4426950408889634f); }
__device__ __forceinline__ float fast_rcp(float x) { return __builtin_amdgcn_rcpf(x); }
__device__ __forceinline__ float sigmoidf_(float x) { return fast_rcp(1.0f + fast_exp(-x)); }
__device__ __forceinline__ float siluf_(float x) { return x * sigmoidf_(x); }
__device__ __forceinline__ float wave_sum(float v) {
#pragma unroll
    for (int o = 1; o < 64; o <<= 1) v += __shfl_xor(v, o);
    return v;
}
#define LDS_WAIT() asm volatile("s_waitcnt lgkmcnt(0)" ::: "memory")
#define VM_WAIT() asm volatile("s_waitcnt vmcnt(0)" ::: "memory")

namespace pg8 {
#ifndef PG8_WGM
#define PG8_WGM 4
#endif
constexpr int BM = 256, BK = 64, HALF = 128, HTB = HALF * BK * 2, STAGE_BYTES = 8 * HTB, NXCD = 8, WGM = PG8_WGM;
__host__ __device__ __forceinline__ int lds_byte(int r, int c) { const int st = (r >> 4) * 2 + (c >> 5), rr = r & 15, cc = c & 31, ob = rr * 64 + cc * 2; return st * 1024 + (ob ^ (((ob >> 9) & 1) << 5)); }
__host__ __device__ __forceinline__ void stage_rc(int b, int& R, int& C) { const int st = b / 1024, sb = b % 1024, swz = sb ^ (((sb >> 9) & 1) << 5); R = (st >> 1) * 16 + swz / 64; C = (st & 1) * 32 + (swz % 64) / 2; }
__host__ __device__ __forceinline__ int perm32(int rho) { const int n = rho >> 4, i = rho & 15; return 8 * (i >> 2) + 4 * n + (i & 3); }

struct Unit { int pm, pn, aux; };

__device__ __forceinline__ bool static_tile(long L, int nM, int nN, int& pm, int& pn) {
    const int nwg = nM * nN; if (L >= nwg) return false;
    int wgid = (int)L; { const int q = nwg / NXCD, r = nwg % NXCD, xcd = wgid % NXCD, off = wgid / NXCD; wgid = (xcd < r ? xcd * (q + 1) : r * (q + 1) + (xcd - r) * q) + off; }
    const int nig = WGM * nN, gid = wgid / nig, fm = gid * WGM, gsz = (nM - fm) < WGM ? (nM - fm) : WGM;
    pm = fm + ((wgid % nig) % gsz); pn = (wgid % nig) / gsz; return true;
}
struct StaticOrder {
    const char* A; const char* Bt; size_t tstepA, tstepB; int nM, nN, G, c, skip_ctx;
    __device__ __forceinline__ bool next(int i, Unit& u) const {
        int pm, pn; if (!static_tile((long)i * G + c, nM, nN, pm, pn)) return false;
        u.pm = skip_ctx ? pm + pm / 16 + 1 : pm; u.pn = pn; u.aux = 0; return true; }
    __device__ __forceinline__ const char* Aptr(const Unit& u) const { return A + (size_t)u.pm * tstepA; }
    __device__ __forceinline__ const char* Bptr(const Unit& u) const { return Bt + (size_t)u.pn * tstepB; }
};
struct InProjOrder {
    const char* X; const char* W; int G, c;
    __device__ __forceinline__ bool next(int i, Unit& u) const {
        const long L = (long)i * G + c;
        if (L < 68 * 30) { int pm, pn; static_tile(L, 68, 30, pm, pn); u.pm = pm; u.pn = pn; u.aux = 0; return true; }
        const long L2 = L - 68 * 30; if (L2 >= 6 * 68) return false;
        u.pm = (int)(L2 % 6); u.pn = (int)(L2 / 6); u.aux = 1; return true; }
    __device__ __forceinline__ const char* Aptr(const Unit& u) const { return u.aux ? W + (size_t)(NPROJ + 256 * u.pm) * 2048 : X + (size_t)u.pm * 256 * 2048; }
    __device__ __forceinline__ const char* Bptr(const Unit& u) const { return u.aux ? X + (size_t)u.pn * 256 * 2048 : W + (size_t)u.pn * 256 * 2048; }
};
struct MergeOrder {
    const char* A; const char* Bt; size_t tstepA, tstepB; int nM, nN, G, c, skip_ctx;
    __device__ __forceinline__ bool next(int i, Unit& u) const {
        int pm, pn; if (!static_tile((long)(i / 3) * G + c, nM, nN, pm, pn)) return false;
        u.pm = skip_ctx ? pm + pm / 16 + 1 : pm; u.pn = pn; u.aux = i % 3; return true; }
    __device__ __forceinline__ const char* Aptr(const Unit& u) const { return A + (size_t)u.pm * tstepA + (size_t)u.aux * 1024; }
    __device__ __forceinline__ const char* Bptr(const Unit& u) const { return Bt + (size_t)u.pn * tstepB + (size_t)u.aux * 1024; }
};
struct MoeOrder {
    const char* A; const char* Bt; size_t rowbytesA, tstepB, estepB; const int* tiles; int nM, nN, G, c, ncap;
    __device__ __forceinline__ bool next(int i, Unit& u) const {
        const long L = (long)i * G + c; if (L >= ncap) return false;
        int pm, pn; if (!static_tile(L, nM, nN, pm, pn)) return false;
        u.pm = tiles[2 * pm + 1] >> 8; u.pn = pn; u.aux = tiles[2 * pm]; return true; }
    __device__ __forceinline__ const char* Aptr(const Unit& u) const { return A + (size_t)u.pm * 256 * rowbytesA; }
    __device__ __forceinline__ const char* Bptr(const Unit& u) const { return Bt + (size_t)u.aux * estepB + (size_t)u.pn * tstepB; }
};
constexpr int MOE_S = 7;
struct MoeSplitOrder {
    const char* A; const char* Bt; size_t tstepB, estepB; const int* tiles; int nM, nN, G, c, first, nextra;
    __device__ __forceinline__ bool next(int i, Unit& u) const {
        const int L2 = i * G + c; if (L2 >= nextra * MOE_S) return false;
        const int x = L2 % nextra, sl = L2 / nextra; int pm, pn; static_tile((long)first + x, nM, nN, pm, pn);
        u.pm = x * MOE_S + sl; u.pn = 0; u.aux = (pm << 8) | (pn << 4) | sl; return true; }
    __device__ __forceinline__ const char* Aptr(const Unit& u) const { return A + (size_t)(u.aux >> 8) * 256 * (EXD * 2) + (size_t)(u.aux & 15) * 1024; }
    __device__ __forceinline__ const char* Bptr(const Unit& u) const { return Bt + (size_t)tiles[2 * (u.aux >> 8)] * estepB + (size_t)((u.aux >> 4) & 15) * tstepB + (size_t)(u.aux & 15) * 1024; }
};

__device__ __forceinline__ unsigned cvt_pk_bf16(float lo, float hi) { return pk2(lo, hi); }

typedef f32x4 Acc[2][2][4][2];
__device__ __forceinline__ void zero_acc(Acc& acc) {
#pragma unroll
    for (int a = 0; a < 2; ++a)
#pragma unroll
        for (int b = 0; b < 2; ++b)
#pragma unroll
            for (int m = 0; m < 4; ++m)
#pragma unroll
                for (int n = 0; n < 2; ++n) acc[a][b][m][n] = (f32x4){0.f, 0.f, 0.f, 0.f};
}

template <class Epi, class Sched>
__device__ __forceinline__ void gemm_phase(LAS unsigned char* lds, const int tid, const int K, const int lda, const int ldb, const Sched& S, const Epi& E) {
    const int wid = __builtin_amdgcn_readfirstlane(tid >> 6), lane = tid & 63, wr = wid >> 2, wc = wid & 3, fr = lane & 15, fq = lane >> 4;
    const int nt = K / BK;
    unsigned voffA[2], voffB[2];
#pragma unroll
    for (int i = 0; i < 2; ++i) { int R, C; stage_rc(tid * 16 + i * 8192, R, C); const int Rb = Epi::PERM ? ((R & ~31) + perm32(R & 31)) : R;
        voffA[i] = (unsigned)(R * lda + C) * 2u; voffB[i] = (unsigned)(Rb * ldb + C) * 2u; }
    const size_t kstep = (size_t)(BK * 2);
    const size_t hstepA = (size_t)HALF * lda * 2, hstepB = (size_t)HALF * ldb * 2;
    const unsigned ldsw = (unsigned)wid * 1024u;
    const int aoff = lds_byte(wr * 64 + fr, fq * 8), boff = lds_byte(wc * 32 + fr, fq * 8);
#define PG8_SA(b, h) (((b) * 2 + (h)) * HTB)
#define PG8_SB(b, h) ((4 + (b) * 2 + (h)) * HTB)
#define PG8_STAGE(bufoff, gbase, voff) do { _Pragma("unroll") for (int _i = 0; _i < 2; ++_i) \
        __builtin_amdgcn_global_load_lds((const unsigned*)((const char*)(gbase) + (voff)[_i]), (LAS unsigned*)(lds + (bufoff) + ldsw + _i * 8192), 16, 0, 0); } while (0)
#define PG8_LDA(dst, b, h) do { _Pragma("unroll") for (int m = 0; m < 4; ++m) _Pragma("unroll") for (int k = 0; k < 2; ++k) dst[m][k] = *(const LAS bf16x8*)(lds + PG8_SA(b, h) + aoff + m * 2048 + k * 1024); } while (0)
#define PG8_LDB(dst, b, h) do { _Pragma("unroll") for (int n = 0; n < 2; ++n) _Pragma("unroll") for (int k = 0; k < 2; ++k) dst[n][k] = *(const LAS bf16x8*)(lds + PG8_SB(b, h) + boff + n * 2048 + k * 1024); } while (0)
#define PG8_MMA(ai, bj, At, Bt) do { __builtin_amdgcn_s_setprio(1); _Pragma("unroll") for (int m = 0; m < 4; ++m) _Pragma("unroll") for (int n = 0; n < 2; ++n) _Pragma("unroll") for (int k = 0; k < 2; ++k) \
        acc[ai][bj][m][n] = __builtin_amdgcn_mfma_f32_16x16x32_bf16(Bt[n][k], At[m][k], acc[ai][bj][m][n], 0, 0, 0); __builtin_amdgcn_s_setprio(0); } while (0)
#define PG8_WAIT_V(n) asm volatile("s_waitcnt vmcnt(" #n ")" ::: "memory")
#define PG8_WAIT_L(n) asm volatile("s_waitcnt lgkmcnt(" #n ")" ::: "memory")
#define PG8_BAR __builtin_amdgcn_s_barrier()
#define PG8_SCHED __builtin_amdgcn_sched_barrier(0)
    Unit cur, nxt; int ui = 0;
    if (!S.next(0, cur)) return;
    Acc acc; zero_acc(acc);
    bf16x8 At[4][2], B0[2][2], B1[2][2];
    const char* cA = S.Aptr(cur); const char* cB = S.Bptr(cur);
    PG8_STAGE(PG8_SB(0, 0), cB, voffB); PG8_STAGE(PG8_SB(0, 1), cB + hstepB, voffB); PG8_STAGE(PG8_SA(0, 0), cA, voffA); PG8_STAGE(PG8_SA(0, 1), cA + hstepA, voffA);
    if (wr == 1) PG8_BAR;
    PG8_WAIT_V(2); PG8_BAR;
    PG8_STAGE(PG8_SB(1, 0), cB + kstep, voffB); PG8_STAGE(PG8_SA(1, 0), cA + kstep, voffA); PG8_STAGE(PG8_SB(1, 1), cB + hstepB + kstep, voffB);
    PG8_WAIT_V(6); PG8_BAR;
    for (;;) {
        const bool has_next = S.next(ui + 1, nxt);
        const char* nA = has_next ? S.Aptr(nxt) : cA; const char* nB = has_next ? S.Bptr(nxt) : cB;
        for (int t = 0; t < nt; t += 2) {
            const bool last = (t == nt - 2);
            const char* a1 = cA + (size_t)(t + 1) * kstep;
            const char* a2 = last ? nA : cA + (size_t)(t + 2) * kstep; const char* b2 = last ? nB : cB + (size_t)(t + 2) * kstep;
            const char* a3 = a2 + kstep; const char* b3 = b2 + kstep;
            PG8_LDB(B0, 0, 0); PG8_LDB(B1, 0, 1); PG8_SCHED; PG8_LDA(At, 0, 0); PG8_STAGE(PG8_SA(1, 1), a1 + hstepA, voffA);
            PG8_WAIT_V(8); PG8_WAIT_L(0); PG8_BAR; PG8_MMA(0, 0, At, B0); PG8_MMA(0, 1, At, B1); PG8_BAR; PG8_SCHED;
            PG8_LDA(At, 0, 1); PG8_STAGE(PG8_SB(0, 0), b2, voffB); PG8_STAGE(PG8_SB(0, 1), b2 + hstepB, voffB); PG8_STAGE(PG8_SA(0, 0), a2, voffA);
            PG8_WAIT_V(8); PG8_WAIT_L(0); PG8_BAR; PG8_MMA(1, 0, At, B0); PG8_MMA(1, 1, At, B1); PG8_BAR; PG8_SCHED;
            PG8_LDB(B0, 1, 0); PG8_LDB(B1, 1, 1); PG8_SCHED; PG8_LDA(At, 1, 0); PG8_STAGE(PG8_SA(0, 1), a2 + hstepA, voffA);
            PG8_WAIT_V(8); PG8_WAIT_L(0); PG8_BAR; PG8_MMA(0, 0, At, B0); PG8_MMA(0, 1, At, B1); PG8_BAR; PG8_SCHED;
            PG8_LDA(At, 1, 1); PG8_STAGE(PG8_SB(1, 0), b3, voffB); PG8_STAGE(PG8_SB(1, 1), b3 + hstepB, voffB); PG8_STAGE(PG8_SA(1, 0), a3, voffA);
            PG8_WAIT_V(8); PG8_WAIT_L(0); PG8_BAR; PG8_MMA(1, 0, At, B0); PG8_MMA(1, 1, At, B1); PG8_BAR; PG8_SCHED;
        }
        if (wr == 0) PG8_BAR;
        E(acc, cur, wr, wc, fr, fq);
        if (!has_next) break;
        cur = nxt; cA = nA; cB = nB; ++ui;
        if (wr == 1) PG8_BAR;
    }
    PG8_WAIT_V(0);
    PG8_BAR;
#undef PG8_SA
#undef PG8_SB
#undef PG8_STAGE
#undef PG8_LDA
#undef PG8_LDB
#undef PG8_MMA
#undef PG8_WAIT_V
#undef PG8_WAIT_L
#undef PG8_BAR
#undef PG8_SCHED
}
}
namespace pg8 {
struct EpiStoreBf16 {
    static constexpr bool PERM = true;
    bf16_t* O; int ldc;
    __device__ __forceinline__ void operator()(Acc& acc, const Unit& u, int wr, int wc, int fr, int fq) const {
        const int row0 = u.pm * BM + wr * 64 + fr, col0 = u.pn * BM + wc * 32 + 8 * fq;
#pragma unroll
        for (int ai = 0; ai < 2; ++ai)
#pragma unroll
            for (int m = 0; m < 4; ++m) { bf16_t* rowp = O + (size_t)(row0 + ai * HALF + m * 16) * ldc + col0;
#pragma unroll
                for (int bj = 0; bj < 2; ++bj) { const f32x4 v0 = acc[ai][bj][m][0], v1 = acc[ai][bj][m][1];
                    u32x4 w; w.x = cvt_pk_bf16(v0[0], v0[1]); w.y = cvt_pk_bf16(v0[2], v0[3]); w.z = cvt_pk_bf16(v1[0], v1[1]); w.w = cvt_pk_bf16(v1[2], v1[3]);
                    *(u32x4*)(rowp + bj * HALF) = w; } }
        zero_acc(acc);
    }
};
struct EpiInProj {
    static constexpr bool PERM = true;
    bf16_t* PROJ; bf16_t* VTG;
    __device__ __forceinline__ void operator()(Acc& acc, const Unit& u, int wr, int wc, int fr, int fq) const {
        const int row0 = u.pm * BM + wr * 64 + fr, col0 = u.pn * BM + wc * 32 + 8 * fq;
        const bool gate = !u.aux && u.pn >= C_BG / BM;
#pragma unroll
        for (int ai = 0; ai < 2; ++ai)
#pragma unroll
            for (int m = 0; m < 4; ++m) { const int row = row0 + ai * HALF + m * 16;
#pragma unroll
                for (int bj = 0; bj < 2; ++bj) { f32x4 v0 = acc[ai][bj][m][0], v1 = acc[ai][bj][m][1]; const int col = col0 + bj * HALF;
                    if (gate) {
#pragma unroll
                        for (int j = 0; j < 4; ++j) { v0[j] = fast_rcp(1.0f + fast_exp(-v0[j])); v1[j] = fast_rcp(1.0f + fast_exp(-v1[j])); } }
                    u32x4 w; w.x = cvt_pk_bf16(v0[0], v0[1]); w.y = cvt_pk_bf16(v0[2], v0[3]); w.z = cvt_pk_bf16(v1[0], v1[1]); w.w = cvt_pk_bf16(v1[2], v1[3]);
                    bf16_t* dst = u.aux ? VTG + ((size_t)(col >> 6) * 1536 + row) * 64 + (col & 63) : PROJ + (size_t)row * NPROJ + col;
                    *(u32x4*)dst = w; } }
        zero_acc(acc);
    }
};
struct EpiSwiGLU {
    static constexpr bool PERM = true;
    bf16_t* O; int ldc;
    __device__ __forceinline__ void operator()(Acc& acc, const Unit& u, int wr, int wc, int fr, int fq) const {
        const int row0 = u.pm * BM + wr * 64 + fr, col0 = u.pn * HALF + wc * 32 + 8 * fq;
#pragma unroll
        for (int ai = 0; ai < 2; ++ai)
#pragma unroll
            for (int m = 0; m < 4; ++m) { bf16_t* rowp = O + (size_t)(row0 + ai * HALF + m * 16) * ldc + col0;
                float h[8];
#pragma unroll
                for (int n = 0; n < 2; ++n)
#pragma unroll
                    for (int j = 0; j < 4; ++j) { const float a = acc[ai][0][m][n][j], g = acc[ai][1][m][n][j]; h[4 * n + j] = a * fast_rcp(1.0f + fast_exp(-a)) * g; }
                u32x4 w; w.x = cvt_pk_bf16(h[0], h[1]); w.y = cvt_pk_bf16(h[2], h[3]); w.z = cvt_pk_bf16(h[4], h[5]); w.w = cvt_pk_bf16(h[6], h[7]);
                *(u32x4*)rowp = w; }
        zero_acc(acc);
    }
};
struct EpiResid {
    static constexpr bool PERM = false;
    float* H; const float* mod;
    __device__ __forceinline__ void operator()(Acc& acc, const Unit& u, int wr, int wc, int fr, int fq) const {
        const int row0 = u.pm * BM + wr * 64 + fr, col0 = u.pn * BM + wc * 32 + 4 * fq;
        const int r = (u.pm % 17 == 0) ? 4 : u.pm / 17;
        const float* mp = mod + (size_t)r * 6144 + col0;
        f32x4 mv[2][2];
#pragma unroll
        for (int bj = 0; bj < 2; ++bj)
#pragma unroll
            for (int n = 0; n < 2; ++n) mv[bj][n] = *(const f32x4*)(mp + bj * HALF + n * 16);
#pragma unroll
        for (int ai = 0; ai < 2; ++ai) {
            f32x4 hv[4][2][2];
#pragma unroll
            for (int m = 0; m < 4; ++m) { const float* rowp = H + (size_t)(row0 + ai * HALF + m * 16) * DM + col0;
#pragma unroll
                for (int bj = 0; bj < 2; ++bj)
#pragma unroll
                    for (int n = 0; n < 2; ++n) hv[m][bj][n] = *(const f32x4*)(rowp + bj * HALF + n * 16); }
#pragma unroll
            for (int m = 0; m < 4; ++m) { float* rowp = H + (size_t)(row0 + ai * HALF + m * 16) * DM + col0;
#pragma unroll
                for (int bj = 0; bj < 2; ++bj)
#pragma unroll
                    for (int n = 0; n < 2; ++n) *(f32x4*)(rowp + bj * HALF + n * 16) = hv[m][bj][n] + mv[bj][n] * acc[ai][bj][m][n]; }
            asm volatile("" ::: "memory"); }
        zero_acc(acc);
    }
};
struct EpiMerge {
    static constexpr bool PERM = true;
    const bf16_t* P; bf16_t* Y;
    __device__ __forceinline__ void operator()(Acc& acc, const Unit& u, int wr, int wc, int fr, int fq) const {
        const int row0 = u.pm * BM + wr * 64 + fr, col0 = u.pn * BM + wc * 32 + 8 * fq, seg = u.aux;
#pragma unroll
        for (int ai = 0; ai < 2; ++ai) {
            u32x4 xd[4][2], xn[4][2];
#pragma unroll
            for (int m = 0; m < 4; ++m) { const bf16_t* gp = P + (size_t)(row0 + ai * HALF + m * 16) * NPROJ + C_BG + seg * 1024 + col0;
#pragma unroll
                for (int bj = 0; bj < 2; ++bj) { xd[m][bj] = *(const u32x4*)(gp + bj * HALF); xn[m][bj] = xd[m][bj]; if (seg < 2) xn[m][bj] = *(const u32x4*)(gp + 1024 + bj * HALF); } }
#pragma unroll
            for (int m = 0; m < 4; ++m) { const size_t row = (size_t)(row0 + ai * HALF + m * 16);
#pragma unroll
                for (int bj = 0; bj < 2; ++bj) {
                    float f[8];
#pragma unroll
                    for (int q = 0; q < 4; ++q) {
                        const float d0 = bflo(xd[m][bj][q]), d1 = bfhi(xd[m][bj][q]);
                        f[2 * q] = seg < 2 ? d0 * fast_rcp(fmaxf(bflo(xn[m][bj][q]), 1e-30f)) : d0; f[2 * q + 1] = seg < 2 ? d1 * fast_rcp(fmaxf(bfhi(xn[m][bj][q]), 1e-30f)) : d1; }
                    f32x4 v0 = acc[ai][bj][m][0], v1 = acc[ai][bj][m][1];
                    v0 = v0 * (f32x4){f[0], f[1], f[2], f[3]}; v1 = v1 * (f32x4){f[4], f[5], f[6], f[7]};
                    if (seg == 2) {
                        u32x4 w; w.x = cvt_pk_bf16(v0[0], v0[1]); w.y = cvt_pk_bf16(v0[2], v0[3]); w.z = cvt_pk_bf16(v1[0], v1[1]); w.w = cvt_pk_bf16(v1[2], v1[3]);
                        *(u32x4*)(Y + row * DM + col0 + bj * HALF) = w;
                        v0 = (f32x4){0.f, 0.f, 0.f, 0.f}; v1 = v0; }
                    acc[ai][bj][m][0] = v0; acc[ai][bj][m][1] = v1; } } }
    }
};
}
constexpr int NWAVES = 8;
constexpr int LDS_BYTES = 163840;
constexpr int LDSCTL_OFF = 159744;

struct Args { const float* in[22]; float* out; unsigned char* ws; int ph_lo, ph_hi; };
enum { I_X = 0, I_C, I_CTX, I_CCTX, I_MODW, I_MODB, I_N1W, I_WIN, I_RPB, I_HGLB, I_HGNW, I_MLGB, I_MLNW, I_WBR, I_WOUT, I_N2W, I_FUP, I_FDN, I_ROUT, I_MUP, I_MDN, I_FNW };

struct Frame {
    LAS unsigned char* lds;
    volatile LAS unsigned* MISC;
    unsigned* ctl;
    unsigned char* ws;
    const float* const* in;
    float* out;
    int tid, lane, wave, G, bid;
};

#define XB_TMO      128
#define XB_XCNT(j)  (256  + 64 * (j))
#define XB_XSUB(j)  (1280 + 64 * (j))
#define XB_XGEN(j)  (2304 + 64 * (j))
#define XB_TOP      3328
#define XB_TOPGEN   3392
#define XCD_BAR_WORDS 3456
#define XB_SPIN_CAP (1u << 22)
__device__ __forceinline__ unsigned xb_ld(unsigned* p)              { return __hip_atomic_load(p, __ATOMIC_RELAXED, __HIP_MEMORY_SCOPE_AGENT); }
__device__ __forceinline__ unsigned xb_add(unsigned* p, unsigned v) { return __hip_atomic_fetch_add(p, v, __ATOMIC_RELAXED, __HIP_MEMORY_SCOPE_AGENT); }
__device__ __forceinline__ unsigned xb_xcc_id() { return (unsigned)__builtin_amdgcn_s_getreg((3 << 11) | 20) & 0xFu; }
#define XB_SPIN(cond, bar) do { unsigned _sp = 0; while (cond) { __builtin_amdgcn_s_sleep(1); \
    if ((++_sp & 255u) == 0u) { if (xb_ld(&(bar)[XB_TMO])) break; if (_sp > XB_SPIN_CAP) { atomicAdd(&(bar)[XB_TMO], 1u); break; } } } } while (0)
struct XcdBarrier { unsigned* bar; unsigned x; volatile LAS unsigned* st; };
__device__ __forceinline__ XcdBarrier xcd_barrier_post(unsigned* bar, volatile LAS unsigned* st) {
    XcdBarrier b; b.bar = bar; b.x = xb_xcc_id(); b.st = st;
    if (threadIdx.x == 0) (void)xb_add(&bar[XB_XCNT(b.x)], 1u);
    return b;
}
__device__ __forceinline__ void xcd_barrier_complete(unsigned* bar, unsigned x, unsigned& nloc, unsigned& nx) {
    const unsigned G = gridDim.x * gridDim.y * gridDim.z;
    unsigned sum, cnt, mine, sp = 0u;
    for (;;) {
        sum = 0u; cnt = 0u; mine = 0u;
#pragma unroll
        for (unsigned j = 0; j < 16; ++j) { const unsigned c = xb_ld(&bar[XB_XCNT(j)]); sum += c; cnt += (c > 0u) ? 1u : 0u; mine = (j == x) ? c : mine; }
        if (sum == G) break;
        __builtin_amdgcn_s_sleep(1);
        if ((++sp & 255u) == 0u) { if (xb_ld(&bar[XB_TMO])) break; if (sp > XB_SPIN_CAP) { atomicAdd(&bar[XB_TMO], 1u); break; } }
    }
    nloc = mine > 0u ? mine : 1u; nx = cnt > 0u ? cnt : 1u;
}
__device__ __forceinline__ void xcd_barrier(const XcdBarrier& b) {
    asm volatile("s_waitcnt vmcnt(0)" ::: "memory");
    __syncthreads();
    if (threadIdx.x == 0) {
        unsigned* bar = b.bar;
        __builtin_amdgcn_s_waitcnt(0);
        unsigned nloc = b.st[0], nx = b.st[1];
        if (nloc == 0u) { xcd_barrier_complete(bar, b.x, nloc, nx); b.st[0] = nloc; b.st[1] = nx; }
        const unsigned old = xb_add(&bar[XB_XSUB(b.x)], 1u);
        const unsigned gen = old / nloc;
        if (old + 1u == (gen + 1u) * nloc) {
            __builtin_amdgcn_fence(__ATOMIC_RELEASE, "agent");
            asm volatile("s_waitcnt vmcnt(0)" ::: "memory");
            const unsigned og = xb_add(&bar[XB_TOP], 1u);
            const unsigned tg = og / nx;
            if (og + 1u == (tg + 1u) * nx) xb_add(&bar[XB_TOPGEN], 1u);
            else XB_SPIN(xb_ld(&bar[XB_TOPGEN]) == tg, bar);
            __builtin_amdgcn_fence(__ATOMIC_ACQUIRE, "agent");
            xb_add(&bar[XB_XGEN(b.x)], 1u);
            asm volatile("s_waitcnt vmcnt(0)" ::: "memory");
        } else {
            XB_SPIN(xb_ld(&bar[XB_XGEN(b.x)]) == gen, bar);
            __builtin_amdgcn_fence(__ATOMIC_ACQUIRE, "agent");
            asm volatile("s_waitcnt vmcnt(0)" ::: "memory");
        }
    }
    __syncthreads();
}

__device__ __forceinline__ void xpose_item(const float* W, int ldw, bf16_t* WT, int ldd, LAS float* scr, int lane) {
    float v[32];
#pragma unroll
    for (int i = 0; i < 32; ++i) v[i] = W[(size_t)(2 * i + (lane >> 5)) * ldw + (lane & 31)];
#pragma unroll
    for (int i = 0; i < 32; ++i) scr[(2 * i + (lane >> 5)) * 33 + (lane & 31)] = v[i];
    LDS_WAIT(); asm volatile("" ::: "memory");
    const int c = lane & 7;
#pragma unroll
    for (int j = 0; j < 4; ++j) { const int n = (lane >> 3) + 8 * j; const LAS float* s = scr + (8 * c) * 33 + n;
        u32x4 o; o.x = pk2(s[0 * 33], s[1 * 33]); o.y = pk2(s[2 * 33], s[3 * 33]); o.z = pk2(s[4 * 33], s[5 * 33]); o.w = pk2(s[6 * 33], s[7 * 33]);
        *(u32x4*)(WT + (size_t)n * ldd + 8 * c) = o; }
    LDS_WAIT(); asm volatile("" ::: "memory");
}
struct XItem { const float* W; bf16_t* WT; int ldw, ldd; };
__device__ __forceinline__ bool xpose_mat(int& r, const float* W, int ldw, int K, int N, bf16_t* WT, int ldd, int pairF, XItem& X) {
    const int nblk = N / 32, items = (K / 64) * nblk;
    if (r >= items) { r -= items; return false; }
    const int kb = r / nblk, nb = r % nblk, k0 = 64 * kb, n0 = 32 * nb;
    int drow = n0;
    if (pairF) { const int isu = n0 >= pairF, idx = isu ? n0 - pairF : n0; drow = (idx / 128) * 256 + isu * 128 + (idx % 128); }
    X.W = W + (size_t)k0 * ldw + n0; X.ldw = ldw; X.WT = WT + (size_t)drow * ldd + k0; X.ldd = ldd;
    return true;
}
constexpr int MOE_XITEMS = 8 * (1024 / 64) * (7168 / 32) + 8 * (EXD / 64) * (1024 / 32);
__device__ __forceinline__ void moe_convert(Frame& F, int lo, int hi, int widx, int nw) {
    LAS float* scr = (LAS float*)(F.lds + F.wave * 16384);
    bf16_t* MUP = (bf16_t*)(F.ws + WS_MUP); bf16_t* MDN = (bf16_t*)(F.ws + WS_MDN);
    for (int it = lo + widx; it < hi; it += nw) {
        int r = it; bool done = false; XItem X;
        for (int e = 0; e < NEXP && !done; ++e) done = xpose_mat(r, F.in[I_MUP] + (size_t)e * 1024 * 7168, 7168, 1024, 7168, MUP + (size_t)e * 7168 * 1024, 1024, EXD, X);
        for (int e = 0; e < NEXP && !done; ++e) done = xpose_mat(r, F.in[I_MDN] + (size_t)e * EXD * 1024, 1024, EXD, 1024, MDN + (size_t)e * 1024 * EXD, EXD, 0, X);
        if (done) xpose_item(X.W, X.ldw, X.WT, X.ldd, scr, F.lane);
    }
}
__device__ __forceinline__ void ph_prologue(Frame& F) {
    {
        LAS float* sv = (LAS float*)F.lds;
        LAS float* red = (LAS float*)(F.lds + 5 * 1024 * 4);
        float* MOD = (float*)(F.ws + WS_MOD);
        bool have = false;
        for (int it = F.bid; it < 2 * 96; it += F.G) {
            if (!have) { for (int i = F.tid; i < 5 * 1024; i += 512) { const float v = i < 4096 ? F.in[I_C][i] : F.in[I_CCTX][i - 4096]; sv[i] = siluf_(v); } have = true; __syncthreads(); }
            const int l = it / 96, j0 = (it % 96) * 64, ks = F.wave, cj = F.lane;
            const float* w = F.in[I_MODW] + (size_t)l * 1024 * 6144 + j0 + cj;
            float a0 = 0.f, a1 = 0.f, a2 = 0.f, a3 = 0.f, a4 = 0.f;
#pragma unroll 8
            for (int k = ks * 128; k < ks * 128 + 128; ++k) { const float wv = w[(size_t)k * 6144];
                a0 += sv[k] * wv; a1 += sv[1024 + k] * wv; a2 += sv[2048 + k] * wv; a3 += sv[3072 + k] * wv; a4 += sv[4096 + k] * wv; }
            red[(ks * 5 + 0) * 64 + cj] = a0; red[(ks * 5 + 1) * 64 + cj] = a1; red[(ks * 5 + 2) * 64 + cj] = a2; red[(ks * 5 + 3) * 64 + cj] = a3; red[(ks * 5 + 4) * 64 + cj] = a4;
            __syncthreads();
            if (F.tid < 320) { const int r = F.tid / 64, c = F.tid % 64; float s = 0.f;
#pragma unroll
                for (int q = 0; q < 8; ++q) s += red[(q * 5 + r) * 64 + c];
                MOD[(size_t)(l * 5 + r) * 6144 + j0 + c] = s + F.in[I_MODB][l * 6144 + j0 + c]; }
            __syncthreads();
        }
        __syncthreads();
    }
    LAS float* scr = (LAS float*)(F.lds + F.wave * 16384);
    const int gw = F.bid * NWAVES + F.wave, NGW = F.G * NWAVES;
    bf16_t* WIN = (bf16_t*)(F.ws + WS_WIN); bf16_t* WB = (bf16_t*)(F.ws + WS_WB); bf16_t* WO = (bf16_t*)(F.ws + WS_WO);
    bf16_t* WUP = (bf16_t*)(F.ws + WS_WUP); bf16_t* WDN = (bf16_t*)(F.ws + WS_WDN);
    constexpr int NITEMS = 59008 - MOE_XITEMS;
    for (int it = gw; it < NITEMS; it += NGW) {
        int r = it; bool done = false; XItem X;
        for (int l = 0; l < 2 && !done; ++l) {
            {
                const float* wsrc = F.in[I_WIN] + (size_t)l * 1024 * INW; bf16_t* wdst = WIN + (size_t)l * NWIN * 1024;
                done = xpose_mat(r, wsrc + 0, INW, 1024, 1024, wdst + (size_t)0 * 1024, 1024, 0, X);
                if (!done) done = xpose_mat(r, wsrc + 1024, INW, 1024, 512, wdst + (size_t)(NPROJ + V_NA) * 1024, 1024, 0, X);
                if (!done) done = xpose_mat(r, wsrc + 1536, INW, 1024, 1536, wdst + (size_t)C_HGQ * 1024, 1024, 0, X);
                if (!done) done = xpose_mat(r, wsrc + 3072, INW, 1024, 512, wdst + (size_t)(NPROJ + V_HG) * 1024, 1024, 0, X);
                if (!done) done = xpose_mat(r, wsrc + 3584, INW, 1024, 512, wdst + (size_t)C_HGG * 1024, 1024, 0, X);
                if (!done) done = xpose_mat(r, wsrc + 4096, INW, 1024, 1024, wdst + (size_t)C_MLQ * 1024, 1024, 0, X);
                if (!done) done = xpose_mat(r, wsrc + 5120, INW, 1024, 512, wdst + (size_t)(NPROJ + V_ML) * 1024, 1024, 0, X);
                if (!done) done = xpose_mat(r, wsrc + 5632, INW, 1024, 512, wdst + (size_t)C_MLO * 1024, 1024, 0, X);
                if (!done) done = xpose_mat(r, wsrc + 6160, INW, 1024, 3072, wdst + (size_t)C_BG * 1024, 1024, 0, X);
            }
            for (int i = 0; i < 3 && !done; ++i) done = xpose_mat(r, F.in[I_WBR] + (size_t)(l * 3 + i) * 512 * 1024, 1024, 512, 1024, WB + (size_t)l * 1024 * 1536 + i * 512, 1536, 0, X);
            if (!done) done = xpose_mat(r, F.in[I_WOUT] + (size_t)l * 1024 * 1024, 1024, 1024, 1024, WO + (size_t)l * 1024 * 1024, 1024, 0, X);
        }
        if (!done) done = xpose_mat(r, F.in[I_FUP], 2 * FFN, 1024, 2 * FFN, WUP, 1024, FFN, X);
        if (!done) done = xpose_mat(r, F.in[I_FDN], 1024, FFN, 1024, WDN, FFN, 0, X);
        if (done) xpose_item(X.W, X.ldw, X.WT, X.ldd, scr, F.lane);
    }
}

__device__ __forceinline__ const float* src_row(const Frame& F, int layer_first, int m) {
    if (!layer_first) return (const float*)(F.ws + WS_H) + (size_t)m * DM;
    const int b = m / TT, r = m % TT;
    return r < NCTX ? F.in[I_CTX] + ((size_t)b * NCTX + r) * DM : F.in[I_X] + ((size_t)b * SEQ + (r - NCTX)) * DM;
}
__device__ __forceinline__ float reduce16(float (&g)[16], int lane) {
    float a8[8], a4[4], a2[2];
    const bool b5 = lane & 32, b4 = lane & 16, b3 = lane & 8, b2 = lane & 4;
#pragma unroll
    for (int k = 0; k < 8; ++k) { const float send = b5 ? g[k] : g[k + 8], keep = b5 ? g[k + 8] : g[k]; a8[k] = keep + __shfl_xor(send, 32); }
#pragma unroll
    for (int k = 0; k < 4; ++k) { const float send = b4 ? a8[k] : a8[k + 4], keep = b4 ? a8[k + 4] : a8[k]; a4[k] = keep + __shfl_xor(send, 16); }
#pragma unroll
    for (int k = 0; k < 2; ++k) { const float send = b3 ? a4[k] : a4[k + 2], keep = b3 ? a4[k + 2] : a4[k]; a2[k] = keep + __shfl_xor(send, 8); }
    float r = (b2 ? a2[1] : a2[0]) + __shfl_xor(b2 ? a2[0] : a2[1], 4);
    r += __shfl_xor(r, 2); r += __shfl_xor(r, 1);
    return r;
}
struct RowRegs { f32x4 v[4]; };
__device__ __forceinline__ void row_load(RowRegs& R, const float* xr, int lane) {
#pragma unroll
    for (int j = 0; j < 4; ++j) R.v[j] = *(const f32x4*)(xr + 256 * j + 4 * lane);
}
__device__ __forceinline__ void ph_norm1(Frame& F, int l) {
    LAS float* WG = (LAS float*)F.lds;
    for (int i = F.tid; i < 16384; i += 512) { const int k = i >> 4, g = i & 15; WG[g * 1028 + k] = F.in[I_WIN][(size_t)l * 1024 * INW + (size_t)k * INW + 6144 + g]; }
    __syncthreads();
    const int gw = F.bid * NWAVES + F.wave, NGW = F.G * NWAVES;
    const float* MOD = (const float*)(F.ws + WS_MOD) + (size_t)l * 5 * 6144;
    const float* nw = F.in[I_N1W] + l * DM;
    float* H = (float*)(F.ws + WS_H); bf16_t* A1 = (bf16_t*)(F.ws + WS_A1); float* G16 = (float*)(F.ws + WS_G16);
    RowRegs nx; if (gw < MT) row_load(nx, src_row(F, l == 0, gw), F.lane);
    for (int m = gw; m < MT; m += NGW) {
        const RowRegs cur = nx; if (m + NGW < MT) row_load(nx, src_row(F, l == 0, m + NGW), F.lane);
        const int r = (m % TT) < NCTX ? 4 : m / TT;
        const float* sh = MOD + (size_t)r * 6144; const float* sc = sh + 1024;
        float ss = 0.f;
#pragma unroll
        for (int j = 0; j < 4; ++j) ss += (cur.v[j].x * cur.v[j].x + cur.v[j].y * cur.v[j].y) + (cur.v[j].z * cur.v[j].z + cur.v[j].w * cur.v[j].w);
        if (l == 0) {
#pragma unroll
            for (int j = 0; j < 4; ++j) *(f32x4*)(H + (size_t)m * DM + 256 * j + 4 * F.lane) = cur.v[j]; }
        const float rstd = 1.0f / sqrtf(wave_sum(ss) * (1.f / DM) + EPS);
        f32x4 av[4];
#pragma unroll
        for (int j = 0; j < 4; ++j) { const int k0 = 256 * j + 4 * F.lane;
            const f32x4 w4 = *(const f32x4*)(nw + k0), s4 = *(const f32x4*)(sh + k0), c4 = *(const f32x4*)(sc + k0);
            av[j] = (cur.v[j] * rstd * w4) * (c4 + 1.0f) + s4;
            *(u32x2*)(A1 + (size_t)m * DM + k0) = (u32x2){pk2(av[j].x, av[j].y), pk2(av[j].z, av[j].w)}; }
        float g[16];
#pragma unroll
        for (int q = 0; q < 16; ++q) { float gq = 0.f;
#pragma unroll
            for (int j = 0; j < 4; ++j) { const f32x4 wg = *(const LAS f32x4*)(WG + q * 1028 + 256 * j + 4 * F.lane); gq += (av[j].x * wg.x + av[j].y * wg.y) + (av[j].z * wg.z + av[j].w * wg.w); }
            g[q] = gq; if ((q & 3) == 3) asm volatile("" ::: "memory"); }
        const float tot = reduce16(g, F.lane);
        if ((F.lane & 3) == 0) G16[(size_t)m * 16 + (F.lane >> 2)] = tot;
    }
}
__device__ __forceinline__ void ph_norm2(Frame& F, int l) {
    const int gw = F.bid * NWAVES + F.wave, NGW = F.G * NWAVES;
    const float* MOD = (const float*)(F.ws + WS_MOD) + (size_t)l * 5 * 6144;
    const float* nw = F.in[I_N2W] + l * DM;
    const float* H = (const float*)(F.ws + WS_H); bf16_t* A1 = (bf16_t*)(F.ws + WS_A1);
    if (l == 0) {
        RowRegs nx; if (gw < MT) row_load(nx, H + (size_t)gw * DM, F.lane);
        for (int m = gw; m < MT; m += NGW) {
            const RowRegs cur = nx; if (m + NGW < MT) row_load(nx, H + (size_t)(m + NGW) * DM, F.lane);
            const int r = (m % TT) < NCTX ? 4 : m / TT;
            const float* sh = MOD + (size_t)r * 6144 + 3 * 1024; const float* sc = sh + 1024;
            float ss = 0.f;
#pragma unroll
            for (int j = 0; j < 4; ++j) ss += (cur.v[j].x * cur.v[j].x + cur.v[j].y * cur.v[j].y) + (cur.v[j].z * cur.v[j].z + cur.v[j].w * cur.v[j].w);
            const float rstd = 1.0f / sqrtf(wave_sum(ss) * (1.f / DM) + EPS);
#pragma unroll
            for (int j = 0; j < 4; ++j) { const int k0 = 256 * j + 4 * F.lane;
                const f32x4 w4 = *(const f32x4*)(nw + k0), s4 = *(const f32x4*)(sh + k0), c4 = *(const f32x4*)(sc + k0);
                const f32x4 a = (cur.v[j] * rstd * w4) * (c4 + 1.0f) + s4;
                *(u32x2*)(A1 + (size_t)m * DM + k0) = (u32x2){pk2(a.x, a.y), pk2(a.z, a.w)}; }
        }
        return;
    }
    LAS float* WR = (LAS float*)F.lds;
    LAS unsigned* lcnt = (LAS unsigned*)(F.lds + 8 * 1028 * 4);
    for (int i = F.tid; i < 8192; i += 512) { const int k = i >> 3, e = i & 7; WR[e * 1028 + k] = F.in[I_ROUT][(size_t)k * 8 + e]; }
    if (F.tid < 16) lcnt[F.tid] = 0u;
    __syncthreads();
    int* TOKE = (int*)(F.ws + WS_ROUTE) + RT_TOKE; float* TOKW = (float*)(F.ws + WS_ROUTE) + RT_TOKW; int* TOKS = (int*)(F.ws + WS_ROUTE) + RT_TOKS;
    RowRegs nx; if (gw < NB * SEQ) row_load(nx, H + (size_t)((gw / SEQ) * TT + NCTX + (gw % SEQ)) * DM, F.lane);
    for (int n = gw; n < NB * SEQ; n += NGW) {
        const int b = n / SEQ, m = b * TT + NCTX + (n % SEQ);
        const RowRegs cur = nx; if (n + NGW < NB * SEQ) { const int n2 = n + NGW; row_load(nx, H + (size_t)((n2 / SEQ) * TT + NCTX + (n2 % SEQ)) * DM, F.lane); }
        const float* sh = MOD + (size_t)b * 6144 + 3 * 1024; const float* sc = sh + 1024;
        float ss = 0.f;
#pragma unroll
        for (int j = 0; j < 4; ++j) ss += (cur.v[j].x * cur.v[j].x + cur.v[j].y * cur.v[j].y) + (cur.v[j].z * cur.v[j].z + cur.v[j].w * cur.v[j].w);
        const float rstd = 1.0f / sqrtf(wave_sum(ss) * (1.f / DM) + EPS);
        float g[16];
#pragma unroll
        for (int q = 0; q < 16; ++q) g[q] = 0.f;
#pragma unroll
        for (int j = 0; j < 4; ++j) { const int k0 = 256 * j + 4 * F.lane;
            const f32x4 w4 = *(const f32x4*)(nw + k0), s4 = *(const f32x4*)(sh + k0), c4 = *(const f32x4*)(sc + k0);
            const f32x4 a = (cur.v[j] * rstd * w4) * (c4 + 1.0f) + s4;
            *(u32x2*)(A1 + (size_t)m * DM + k0) = (u32x2){pk2(a.x, a.y), pk2(a.z, a.w)};
#pragma unroll
            for (int q = 0; q < 8; ++q) { const f32x4 wg = *(const LAS f32x4*)(WR + q * 1028 + k0); g[q] += (a.x * wg.x + a.y * wg.y) + (a.z * wg.z + a.w * wg.w); } }
        const float tot = reduce16(g, F.lane);
        float lg[8];
#pragma unroll
        for (int q = 0; q < 8; ++q) lg[q] = __shfl(tot, 4 * q);
        int e1 = 0; float v1 = lg[0];
#pragma unroll
        for (int q = 1; q < 8; ++q) if (lg[q] > v1) { v1 = lg[q]; e1 = q; }
        int e2 = (e1 == 0) ? 1 : 0; float v2 = lg[e1 == 0 ? 1 : 0];
#pragma unroll
        for (int q = 0; q < 8; ++q) if (q != e1 && lg[q] > v2) { v2 = lg[q]; e2 = q; }
        if (F.lane < 2) {
            const float w1 = 1.0f / (1.0f + fast_exp(v2 - v1));
            const int e = F.lane ? e2 : e1;
            const unsigned pos = __hip_atomic_fetch_add(lcnt + e, 1u, __ATOMIC_RELAXED, __HIP_MEMORY_SCOPE_WORKGROUP);
            TOKE[2 * n + F.lane] = e; TOKW[2 * n + F.lane] = F.lane ? 1.0f - w1 : w1; TOKS[2 * n + F.lane] = (int)pos;
        }
    }
    __syncthreads();
    if (F.tid < 8) lcnt[8 + F.tid] = xb_add(F.ctl + CW_CNT + F.tid, lcnt[F.tid]);
    __syncthreads();
    VM_WAIT();
    for (int n = gw; n < NB * SEQ; n += NGW) {
        if (F.lane < 2) { const int e = TOKE[2 * n + F.lane]; TOKS[2 * n + F.lane] += (int)lcnt[8 + e]; }
    }
}
__device__ __forceinline__ void ph_moe_gather(Frame& F) {
    const int gw = F.bid * NWAVES + F.wave, NGW = F.G * NWAVES;
    int pstart[NEXP]; int acc = 0;
#pragma unroll
    for (int e = 0; e < NEXP; ++e) { const int c = (int)xb_ld(F.ctl + CW_CNT + e); pstart[e] = acc; acc += (c + 255) & ~255; }
    int* RT = (int*)(F.ws + WS_ROUTE);
    if (F.bid == 0 && F.tid == 0) {
        int nt = 0;
        for (int e = 0; e < NEXP; ++e) { const int c = (int)xb_ld(F.ctl + CW_CNT + e); for (int t = 0; t * 256 < c; ++t) { RT[RT_TILE + 2 * nt] = e; RT[RT_TILE + 2 * nt + 1] = pstart[e] + 256 * t; ++nt; } }
        RT[RT_NT] = nt;
        const int nwg = nt * 4; int full = (nwg / F.G) * F.G; if (nwg - full > F.G / 4 || nwg - full > 64) full = nwg;
        RT[RT_NT + 1] = full; RT[RT_NT + 2] = nwg - full;
        for (int i = 0; i < nwg; ++i) RT[RT_SPLITX + i] = -1;
        for (int L = full; L < nwg; ++L) { int pm, pn; pg8::static_tile(L, nt, 4, pm, pn); RT[RT_SPLITX + pm * 4 + pn] = L - full; }
    }
    const int* TOKE = RT + RT_TOKE; int* TOKS = RT + RT_TOKS;
    const bf16_t* A1 = (const bf16_t*)(F.ws + WS_A1); bf16_t* XG = (bf16_t*)(F.ws + WS_XG);
    for (int n = gw; n < NB * SEQ; n += NGW) {
        const int b = n / SEQ, m = b * TT + NCTX + (n % SEQ);
        const int e1 = TOKE[2 * n], e2 = TOKE[2 * n + 1];
        int s1 = TOKS[2 * n], s2 = TOKS[2 * n + 1];
        int p1 = 0, p2 = 0;
#pragma unroll
        for (int e = 0; e < NEXP; ++e) { p1 = (e == e1) ? pstart[e] : p1; p2 = (e == e2) ? pstart[e] : p2; }
        s1 += p1; s2 += p2;
        const u32x4* src = (const u32x4*)(A1 + (size_t)m * DM);
        const u32x4 a = src[F.lane], c = src[64 + F.lane];
        u32x4* d1 = (u32x4*)(XG + (size_t)s1 * DM); u32x4* d2 = (u32x4*)(XG + (size_t)s2 * DM);
        d1[F.lane] = a; d1[64 + F.lane] = c; d2[F.lane] = a; d2[64 + F.lane] = c;
        if (F.lane == 0) { TOKS[2 * n] = s1; TOKS[2 * n + 1] = s2; }
    }
}
__device__ __forceinline__ void ph_final(Frame& F) {
    const int gw = F.bid * NWAVES + F.wave, NGW = F.G * NWAVES;
    const float* MOD = (const float*)(F.ws + WS_MOD) + (size_t)1 * 5 * 6144;
    const float* H = (const float*)(F.ws + WS_H); const bf16_t* YM = (const bf16_t*)(F.ws + WS_YM); const bf16_t* YMP = (const bf16_t*)(F.ws + WS_YMP);
    const int* RT = (const int*)(F.ws + WS_ROUTE); const float* TOKW = (const float*)(F.ws + WS_ROUTE) + RT_TOKW;
    const float* fw = F.in[I_FNW];
    for (int n = gw; n < NB * SEQ; n += NGW) {
        const int b = n / SEQ, m = b * TT + NCTX + (n % SEQ);
        const int s1 = RT[RT_TOKS + 2 * n], s2 = RT[RT_TOKS + 2 * n + 1]; const float w1 = TOKW[2 * n], w2 = TOKW[2 * n + 1];
        const float* g5 = MOD + (size_t)b * 6144 + 5 * 1024;
        f32x4 v[4]; float ss = 0.f;
#pragma unroll
        for (int j = 0; j < 4; ++j) { const int k0 = 256 * j + 4 * F.lane;
            const f32x4 h = *(const f32x4*)(H + (size_t)m * DM + k0), gg = *(const f32x4*)(g5 + k0);
            f32x4 ya, yb;
            { const int x1 = RT[RT_SPLITX + (s1 >> 8) * 4 + j], x2 = RT[RT_SPLITX + (s2 >> 8) * 4 + j];
              if (x1 < 0) { const u32x2 t = *(const u32x2*)(YM + (size_t)s1 * DM + k0); ya = (f32x4){bflo(t.x), bfhi(t.x), bflo(t.y), bfhi(t.y)}; }
              else { ya = (f32x4){0.f, 0.f, 0.f, 0.f};
                  for (int sl = 0; sl < pg8::MOE_S; ++sl) { const u32x2 t = *(const u32x2*)(YMP + ((size_t)(x1 * pg8::MOE_S + sl) * 256 + (s1 & 255)) * 256 + 4 * F.lane); ya = ya + (f32x4){bflo(t.x), bfhi(t.x), bflo(t.y), bfhi(t.y)}; } }
              if (x2 < 0) { const u32x2 t = *(const u32x2*)(YM + (size_t)s2 * DM + k0); yb = (f32x4){bflo(t.x), bfhi(t.x), bflo(t.y), bfhi(t.y)}; }
              else { yb = (f32x4){0.f, 0.f, 0.f, 0.f};
                  for (int sl = 0; sl < pg8::MOE_S; ++sl) { const u32x2 t = *(const u32x2*)(YMP + ((size_t)(x2 * pg8::MOE_S + sl) * 256 + (s2 & 255)) * 256 + 4 * F.lane); yb = yb + (f32x4){bflo(t.x), bfhi(t.x), bflo(t.y), bfhi(t.y)}; } } }
            const f32x4 y = ya * w1 + yb * w2;
            v[j] = h + gg * y; ss += (v[j].x * v[j].x + v[j].y * v[j].y) + (v[j].z * v[j].z + v[j].w * v[j].w); }
        const float rstd = 1.0f / sqrtf(wave_sum(ss) * (1.f / DM) + EPS);
#pragma unroll
        for (int j = 0; j < 4; ++j) { const int k0 = 256 * j + 4 * F.lane; const f32x4 w4 = *(const f32x4*)(fw + k0);
            *(f32x4*)(F.out + (size_t)n * DM + k0) = v[j] * rstd * w4; }
    }
}
__device__ __forceinline__ int tokrow(int b, int dir, int P) { return b * TT + (dir == 0 ? P : (P < NCTX ? (NCTX - 1) - P : (TT + NCTX - 1) - P)); }
__device__ __forceinline__ int iclamp(int v, int lo, int hi) { return v < lo ? lo : (v > hi ? hi : v); }
__device__ __forceinline__ bf16x8 cat4(bf16x4 a, bf16x4 b) { return __builtin_shufflevector(a, b, 0, 1, 2, 3, 4, 5, 6, 7); }
__device__ __forceinline__ f32x4 mfma16(bf16x8 a, bf16x8 b, f32x4 c) { return __builtin_amdgcn_mfma_f32_16x16x32_bf16(a, b, c, 0, 0, 0); }
__device__ __forceinline__ float wave_scan_add(float v, int lane) {
#pragma unroll
    for (int o = 1; o < 64; o <<= 1) { const float t = __shfl_up(v, o); if (lane >= o) v += t; }
    return v;
}
__device__ __forceinline__ float wave_scan_max(float v, int lane) {
#pragma unroll
    for (int o = 1; o < 64; o <<= 1) { const float t = __shfl_up(v, o); if (lane >= o) v = fmaxf(v, t); }
    return v;
}
__device__ __forceinline__ float wave_max(float v) {
#pragma unroll
    for (int o = 1; o < 64; o <<= 1) v = fmaxf(v, __shfl_xor(v, o));
    return v;
}
__device__ __forceinline__ float logsigmoidf_(float x) { return fminf(x, 0.f) - __logf(1.0f + fast_exp(-fabsf(x))); }

constexpr int NA_VTC = 0, NA_VTL = 33792, NA_RPB = 108544;
template <bool LOCAL>
__device__ __forceinline__ void na_unit(Frame& F, int l, int b, int h, int sub) {
    const bf16_t* P = (const bf16_t*)(F.ws + WS_PROJ); bf16_t* BR = (bf16_t*)(F.ws + WS_BR);
    LAS bf16_t* VTC = (LAS bf16_t*)(F.lds + NA_VTC); LAS bf16_t* VTL = (LAS bf16_t*)(F.lds + NA_VTL); LAS float* RPB = (LAS float*)(F.lds + NA_RPB);
    int tid = F.tid; asm volatile("" : "+v"(tid));
    const int lane = tid & 63, w = F.wave, g = lane >> 4, c = lane & 15;
    const int ubase = LOCAL ? iclamp(2 * sub - 4, 0, 56) : 0;
    __syncthreads();
    {   const bf16_t* VG = (const bf16_t*)(F.ws + WS_VTG) + ((size_t)(b * NCH) * 1536 + V_NA + 64 * h) * 64;
#pragma unroll
        for (int it = 0; it < 4; ++it) { const int q = tid + 512 * it, dv = q >> 5, k8 = q & 31;
            *(LAS u32x4*)(VTC + dv * 264 + 8 * k8) = *(const u32x4*)(VG + ((size_t)(k8 >> 3) * 1536 + dv) * 64 + 8 * (k8 & 7)); }
        if (LOCAL) {
            const int npc = ((64 - ubase) < 9 ? (64 - ubase) : 9) * 8;
#pragma unroll
            for (int it = 0; it < 9; ++it) { const int q = tid + 512 * it, dv = q / 72, k8 = q % 72;
                if (k8 < npc) *(LAS u32x4*)(VTL + dv * 584 + 8 * k8) = *(const u32x4*)(VG + ((size_t)(4 + ubase + (k8 >> 3)) * 1536 + dv) * 64 + 8 * (k8 & 7)); }
            if (tid < 465) RPB[tid] = F.in[I_RPB][(size_t)(l * 8 + h) * 465 + tid];
        }
    }
    __syncthreads();
    const int qrow = LOCAL ? 2 * sub + (w >> 2) : 0, cb = w & 3;
    const int r0 = iclamp(qrow - 4, 0, 56), bs = iclamp(16 * cb - 8, 0, 32);
    const int mq = LOCAL ? b * TT + NCTX + qrow * 64 + 16 * cb + c : b * TT + 128 * sub + 16 * w + c;
    bf16x8 qf[2];
    qf[0] = *(const bf16x8*)(P + (size_t)mq * NPROJ + C_NAQ + 64 * h + 8 * g);
    qf[1] = *(const bf16x8*)(P + (size_t)mq * NPROJ + C_NAQ + 64 * h + 32 + 8 * g);
    constexpr int NKB = LOCAL ? 32 : 16, LB = LOCAL ? 16 : 0;
    float s[NKB][4];
    if (LOCAL) {
        const int qc = 16 * cb + c, wst = iclamp(qc - 8, 0, 48);
#pragma unroll
        for (int kb = 0; kb < 16; ++kb) { const int wr = kb >> 1, hf = kb & 1;
            const int mk = b * TT + NCTX + (r0 + wr) * 64 + bs + 16 * hf + c;
            const bf16x8 a0 = *(const bf16x8*)(P + (size_t)mk * NPROJ + C_NAK + 64 * h + 8 * g), a1 = *(const bf16x8*)(P + (size_t)mk * NPROJ + C_NAK + 64 * h + 32 + 8 * g);
            f32x4 z = (f32x4){0.f, 0.f, 0.f, 0.f}; z = mfma16(a0, qf[0], z); z = mfma16(a1, qf[1], z);
            const int dr = r0 + wr - qrow + 7;
#pragma unroll
            for (int r = 0; r < 4; ++r) { const int kc = bs + 16 * hf + 4 * g + r; const bool valid = (kc >= wst) && (kc < wst + 16); const int dc = iclamp(kc - qc + 15, 0, 30);
                s[kb][r] = valid ? z[r] * 0.125f + RPB[dr * 31 + dc] : -1e30f; } }
    }
#pragma unroll
    for (int kb = 0; kb < 16; ++kb) {
        const int mk = b * TT + 16 * kb + c;
        const bf16x8 a0 = *(const bf16x8*)(P + (size_t)mk * NPROJ + C_NAK + 64 * h + 8 * g), a1 = *(const bf16x8*)(P + (size_t)mk * NPROJ + C_NAK + 64 * h + 32 + 8 * g);
        f32x4 z = (f32x4){0.f, 0.f, 0.f, 0.f}; z = mfma16(a0, qf[0], z); z = mfma16(a1, qf[1], z);
#pragma unroll
        for (int r = 0; r < 4; ++r) s[LB + kb][r] = z[r] * 0.125f; }
    float mx = -3.0e38f;
#pragma unroll
    for (int kb = 0; kb < NKB; ++kb)
#pragma unroll
        for (int r = 0; r < 4; ++r) mx = fmaxf(mx, s[kb][r]);
    mx = fmaxf(mx, __shfl_xor(mx, 16)); mx = fmaxf(mx, __shfl_xor(mx, 32));
    float sum = 0.f;
#pragma unroll
    for (int kb = 0; kb < NKB; ++kb)
#pragma unroll
        for (int r = 0; r < 4; ++r) { const float p = fast_exp(s[kb][r] - mx); s[kb][r] = p; sum += p; }
    sum += __shfl_xor(sum, 16); sum += __shfl_xor(sum, 32);
    f32x4 o[4];
#pragma unroll
    for (int mb = 0; mb < 4; ++mb) o[mb] = (f32x4){0.f, 0.f, 0.f, 0.f};
#pragma unroll
    for (int kp = 0; kp < NKB / 2; ++kp) {
        u32x4 pw; pw.x = pk2(s[2 * kp][0], s[2 * kp][1]); pw.y = pk2(s[2 * kp][2], s[2 * kp][3]); pw.z = pk2(s[2 * kp + 1][0], s[2 * kp + 1][1]); pw.w = pk2(s[2 * kp + 1][2], s[2 * kp + 1][3]);
        const bf16x8 pf = __builtin_bit_cast(bf16x8, pw);
#pragma unroll
        for (int mb = 0; mb < 4; ++mb) { const int dv = 16 * mb + c;
            const LAS bf16_t* base = (LOCAL && kp < 8) ? VTL + dv * 584 + (r0 + kp - ubase) * 64 + bs + 4 * g : VTC + dv * 264 + 32 * (kp - (LOCAL ? 8 : 0)) + 4 * g;
            const bf16x4 lo = *(const LAS bf16x4*)base, hi = *(const LAS bf16x4*)(base + 16);
            o[mb] = mfma16(cat4(lo, hi), pf, o[mb]); } }
    const float inv = 1.0f / sum;
#pragma unroll
    for (int mb = 0; mb < 4; ++mb)
        *(u32x2*)(BR + (size_t)mq * 1536 + 64 * h + 16 * mb + 4 * g) = (u32x2){pk2(o[mb][0] * inv, o[mb][1] * inv), pk2(o[mb][2] * inv, o[mb][3] * inv)};
}

__device__ __forceinline__ void load_rope16(const bf16_t* src, int c8, int rr  , float scale, float (&x)[2][2][4]) {
#pragma unroll
    for (int hf = 0; hf < 2; ++hf)
#pragma unroll
        for (int q = 0; q < 2; ++q) { const u32x2 v = *(const u32x2*)(src + 64 * hf + 32 * q + 4 * c8);
            x[hf][q][0] = bflo(v.x) * scale; x[hf][q][1] = bfhi(v.x) * scale; x[hf][q][2] = bflo(v.y) * scale; x[hf][q][3] = bfhi(v.y) * scale; }
    if (rr >= NCTX) {
        const int t = rr - NCTX;
#pragma unroll
        for (int hf = 0; hf < 2; ++hf) { const float pos = (float)(hf ? (t & 63) : (t >> 6));
#pragma unroll
            for (int e = 0; e < 4; ++e) { const float rev = pos * (__builtin_amdgcn_exp2f(-(float)(4 * c8 + e) * 0.41524101186092030f) * 0.15915494309189535f);
                const float cs = __builtin_amdgcn_cosf(rev), sn = __builtin_amdgcn_sinf(rev);
                const float p1 = x[hf][0][e], p2 = x[hf][1][e]; x[hf][0][e] = p1 * cs - p2 * sn; x[hf][1][e] = p1 * sn + p2 * cs; } }
    }
}

constexpr int PR_LF = 0, PR_KT = 33792, PR_WSC = PR_KT + 18432;
struct PrepRegs { u32x4 z0, z1; u32x2 kq[4]; float gi, gf; };
template <bool ML>
__device__ __forceinline__ void prep_load(Frame& F, int v, int tid, PrepRegs& R) {
    const bf16_t* P = (const bf16_t*)(F.ws + WS_PROJ);
    const int C = v % NCH, sq = v / NCH, dir = sq & 1, h = (sq >> 1) & 3, b = sq >> 3, p_ = tid >> 3, c8 = tid & 7;
    const int mrow = tokrow(b, dir, 64 * C + p_);
    if (!ML) { const bf16_t* zp = P + (size_t)mrow * NPROJ + C_HGF + 512 * dir + 128 * h + 16 * c8; R.z0 = *(const u32x4*)zp; R.z1 = *(const u32x4*)(zp + 8); }
    else {
#pragma unroll
        for (int q = 0; q < 4; ++q) R.kq[q] = *(const u32x2*)(P + (size_t)mrow * NPROJ + C_MLK + 128 * h + 64 * (q >> 1) + 32 * (q & 1) + 4 * c8);
        if (tid < 64) { const float* G16 = (const float*)(F.ws + WS_G16); const int mr = tokrow(b, dir, 64 * C + tid);
            R.gi = G16[(size_t)mr * 16 + dir * 8 + h]; R.gf = G16[(size_t)mr * 16 + dir * 8 + 4 + h]; }
    }
}
template <bool ML>
__device__ __forceinline__ void prep_body(Frame& F, int l, int v, int tid, const PrepRegs& R) {
    const int C = v % NCH, sq = v / NCH, dir = sq & 1, h = (sq >> 1) & 3, b = sq >> 3;
    const int sc_ = sq * NCH + C;
    bf16_t* KTG = (bf16_t*)(F.ws + (ML ? WS_KTG1 : WS_KTG0)) + (size_t)sc_ * 8192;
    LAS float* LF = (LAS float*)(F.lds + PR_LF); LAS bf16_t* KT = (LAS bf16_t*)(F.lds + PR_KT); LAS float* WSC = (LAS float*)(F.lds + PR_WSC);
    const int lane = tid & 63, w = F.wave, g = lane >> 4, c = lane & 15;
    const int p_ = tid >> 3, c8 = tid & 7;
    const int mrow = tokrow(b, dir, 64 * C + p_);
    __syncthreads();
    if (!ML) {
        float lf[16];
#pragma unroll
        for (int q = 0; q < 4; ++q) { const unsigned wa = R.z0[q], wb = R.z1[q];
            lf[2 * q] = bflo(wa); lf[2 * q + 1] = bfhi(wa); lf[8 + 2 * q] = bflo(wb); lf[8 + 2 * q + 1] = bfhi(wb); }
#pragma unroll
        for (int e = 0; e < 16; ++e) { const int ch = dir * 512 + 128 * h + 16 * c8 + e; const float lb = (l == 0) ? 0.f : sigmoidf_(F.in[I_HGLB][1024 + ch] - F.in[I_HGLB][ch]);
            const float f = lb + (1.0f - lb) * sigmoidf_(lf[e]); lf[e] = __logf(fmaxf(f, 1e-30f)); }
        {
            unsigned lw[8];
#pragma unroll
            for (int q = 0; q < 8; ++q) { lw[q] = pk2(lf[2 * q], lf[2 * q + 1]); lf[2 * q] = bflo(lw[q]); lf[2 * q + 1] = bfhi(lw[q]); }
            bf16_t* zp = (bf16_t*)(F.ws + WS_PROJ) + (size_t)mrow * NPROJ + C_HGF + 512 * dir + 128 * h + 16 * c8;
            *(u32x4*)zp = (u32x4){lw[0], lw[1], lw[2], lw[3]}; *(u32x4*)(zp + 8) = (u32x4){lw[4], lw[5], lw[6], lw[7]}; }
#pragma unroll
        for (int q = 0; q < 4; ++q) *(LAS f32x4*)(LF + p_ * 132 + 16 * c8 + 4 * q) = (f32x4){lf[4 * q], lf[4 * q + 1], lf[4 * q + 2], lf[4 * q + 3]};
        __syncthreads();
        const int d = 16 * w + c;
        float pre[16], raw[16]; float run = 0.f;
#pragma unroll
        for (int i = 0; i < 16; ++i) { raw[i] = LF[(16 * g + i) * 132 + d]; run += raw[i]; pre[i] = run; }
        float off = 0.f, tot = 0.f;
#pragma unroll
        for (int q = 0; q < 4; ++q) { const float t = __shfl(run, c + 16 * q); tot += t; off += (q < g) ? t : 0.f; }
        unsigned pkd[8];
#pragma unroll
        for (int i = 0; i < 8; ++i) { const float k0 = (1.0f - fast_exp(raw[2 * i])) * fast_exp(tot - (off + pre[2 * i])), k1 = (1.0f - fast_exp(raw[2 * i + 1])) * fast_exp(tot - (off + pre[2 * i + 1])); pkd[i] = pk2(k0, k1); }
        if (dir == 0) {
            *(LAS u32x4*)(KT + d * 72 + 16 * g) = (u32x4){pkd[0], pkd[1], pkd[2], pkd[3]};
            *(LAS u32x4*)(KT + d * 72 + 16 * g + 8) = (u32x4){pkd[4], pkd[5], pkd[6], pkd[7]};
        } else {
#pragma unroll
            for (int i = 0; i < 8; ++i) pkd[i] = (pkd[i] >> 16) | (pkd[i] << 16);
            *(LAS u32x4*)(KT + d * 72 + 16 * (3 - g)) = (u32x4){pkd[7], pkd[6], pkd[5], pkd[4]};
            *(LAS u32x4*)(KT + d * 72 + 16 * (3 - g) + 8) = (u32x4){pkd[3], pkd[2], pkd[1], pkd[0]};
        }
        if (g == 0) ((float*)(F.ws + WS_DEC))[(size_t)sc_ * 128 + d] = fast_exp(tot);
    } else {
        if (w == 0) {
            const float gbi = F.in[I_MLGB][((l * 2 + dir) * 2 + 0) * 4 + h], gbf = F.in[I_MLGB][((l * 2 + dir) * 2 + 1) * 4 + h];
            const float ig = R.gi + gbi, lfg = logsigmoidf_(R.gf + gbf);
            const float bb = wave_scan_add(lfg, lane), bend = __shfl(bb, 63);
            const float e = bend - bb + ig, mloc = wave_max(e);
            WSC[lane] = fast_exp(e - mloc);
            if (lane == 0) { float* ms = (float*)(F.ws + WS_MLS) + (size_t)sc_ * 2; ms[0] = bend; ms[1] = mloc; }
        }
        __syncthreads();
        float x[2][2][4];
        const float scale = 0.08838834764831845f * WSC[p_];
#pragma unroll
        for (int hf = 0; hf < 2; ++hf)
#pragma unroll
            for (int q = 0; q < 2; ++q) { const u32x2 vq = R.kq[2 * hf + q];
                x[hf][q][0] = bflo(vq.x) * scale; x[hf][q][1] = bfhi(vq.x) * scale; x[hf][q][2] = bflo(vq.y) * scale; x[hf][q][3] = bfhi(vq.y) * scale; }
        const int rr = mrow % TT;
        if (rr >= NCTX) { const int t = rr - NCTX;
#pragma unroll
            for (int hf = 0; hf < 2; ++hf) { const float pos = (float)(hf ? (t & 63) : (t >> 6));
#pragma unroll
                for (int e = 0; e < 4; ++e) { const float rev = pos * (__builtin_amdgcn_exp2f(-(float)(4 * c8 + e) * 0.41524101186092030f) * 0.15915494309189535f);
                    const float cs = __builtin_amdgcn_cosf(rev), sn = __builtin_amdgcn_sinf(rev);
                    const float p1 = x[hf][0][e], p2 = x[hf][1][e]; x[hf][0][e] = p1 * cs - p2 * sn; x[hf][1][e] = p1 * sn + p2 * cs; } } }
        const int n_ = dir == 0 ? p_ : 63 - p_;
#pragma unroll
        for (int hf = 0; hf < 2; ++hf)
#pragma unroll
            for (int q = 0; q < 2; ++q)
#pragma unroll
                for (int e = 0; e < 4; ++e) KT[(64 * hf + 32 * q + 4 * c8 + e) * 72 + n_] = (bf16_t)f2bf(x[hf][q][e]);
    }
    __syncthreads();
#pragma unroll
    for (int it = 0; it < 2; ++it) { const int q = tid + 512 * it, row = q >> 3, c16 = q & 7;
        *(u32x4*)(KTG + row * 64 + 8 * c16) = *(const LAS u32x4*)(KT + row * 72 + 8 * c16); }
    if (ML && tid < 128) {
        float ns = 0.f;
#pragma unroll
        for (int q = 0; q < 8; ++q) { const u32x4 vq = *(const LAS u32x4*)(KT + tid * 72 + 8 * q);
            ns += (bflo(vq.x) + bfhi(vq.x)) + (bflo(vq.y) + bfhi(vq.y)) + (bflo(vq.z) + bfhi(vq.z)) + (bflo(vq.w) + bfhi(vq.w)); }
        ((float*)(F.ws + WS_NSG))[(size_t)sc_ * 128 + tid] = ns;
    }
}
template <bool ML>
__device__ __forceinline__ void prep_loop(Frame& F, int l) {
    int tid = F.tid; asm volatile("" : "+v"(tid));
    const int nblk = F.G, first = F.bid;
    PrepRegs nxt;
    if (first < 32 * NCH) prep_load<ML>(F, first, tid, nxt);
    for (int v = first; v < 32 * NCH; v += nblk) {
        const PrepRegs cur = nxt;
        if (v + nblk < 32 * NCH) prep_load<ML>(F, v + nblk, tid, nxt);
        prep_body<ML>(F, l, v, tid, cur);
    }
}

constexpr int SCAN_RD = 8;
constexpr int SC_SM = 0, SC_SM2 = 34816, SC_SLOT = 35840, SC_SLOTB = 27648;
struct ScanRegs { u32x4 k0, k1, v0; };
template <bool ML>
__device__ __forceinline__ void scan_unit(Frame& F, int b, int h, int dir, int vs) {
    const int sq = (b * 4 + h) * 2 + dir;
    const bf16_t* KTG = (const bf16_t*)(F.ws + (ML ? WS_KTG1 : WS_KTG0)) + (size_t)sq * NCH * 8192;
    const bf16_t* VG = (const bf16_t*)(F.ws + WS_VTG) + ((size_t)(b * NCH) * 1536 + (ML ? V_ML : V_HG) + 128 * h + 64 * vs) * 64;
    bf16_t* SP = (bf16_t*)(F.ws + WS_SP) + ((size_t)(((ML ? 1 : 0) * 32 + sq) * NCH)) * 16384;
    float* NST = (float*)(F.ws + WS_NST) + (size_t)(sq * NCH) * 132;
    int tid = F.tid; asm volatile("" : "+v"(tid));
    const int lane = tid & 63, w = F.wave, g = lane >> 4, c = lane & 15, ks = w & 3, nbh = w >> 2;
    LAS float* SM = (LAS float*)(F.lds + SC_SM); LAS float* SM2 = (LAS float*)(F.lds + SC_SM2);
    const int krow = tid >> 3, kc8 = tid & 7;
#define SCAN_LOAD(R, Cc) do { const int cc_ = (Cc); const int cn_ = dir == 0 ? cc_ : (cc_ < 4 ? 3 - cc_ : 71 - cc_); \
        const bf16_t* kp_ = KTG + (size_t)cc_ * 8192 + krow * 64 + 8 * kc8; (R).k0 = *(const u32x4*)kp_; (R).k1 = *(const u32x4*)(kp_ + 64 * 64); \
        (R).v0 = *(const u32x4*)(VG + ((size_t)cn_ * 1536 + krow) * 64 + 8 * kc8); } while (0)
#define SCAN_PARK(R, slot) do { LAS bf16_t* kt_ = (LAS bf16_t*)(F.lds + SC_SLOT + (slot) * SC_SLOTB); \
        *(LAS u32x4*)(kt_ + krow * 72 + 8 * kc8) = (R).k0; *(LAS u32x4*)(kt_ + (krow + 64) * 72 + 8 * kc8) = (R).k1; *(LAS u32x4*)(kt_ + 128 * 72 + krow * 72 + 8 * kc8) = (R).v0; } while (0)
    ScanRegs ring[SCAN_RD];
    __syncthreads();
    {   ScanRegs r0; SCAN_LOAD(r0, 0);
#pragma unroll
        for (int j = 0; j < SCAN_RD; ++j) SCAN_LOAD(ring[(j + 1) % SCAN_RD], j + 1);
        const float* src = (const float*)(F.ws + (ML ? WS_NSG : WS_DEC)) + (size_t)sq * NCH * 128;
        for (int i = tid; i < NCH * 128 / 4; i += 512) *(LAS f32x4*)(SM + 4 * i) = *(const f32x4*)(src + 4 * i);
        if (ML && tid < NCH * 2) SM2[tid] = ((const float*)(F.ws + WS_MLS))[(size_t)sq * NCH * 2 + tid];
        SCAN_PARK(r0, 0); }
    __syncthreads();
    f32x4 acc[2][2];
#pragma unroll
    for (int mb = 0; mb < 2; ++mb)
#pragma unroll
        for (int nb = 0; nb < 2; ++nb) acc[mb][nb] = (f32x4){0.f, 0.f, 0.f, 0.f};
    float m_old = 0.f, nreg = 0.f;
    for (int C0 = 0; C0 < NCH; C0 += SCAN_RD) {
#pragma unroll
        for (int j = 0; j < SCAN_RD; ++j) {
            const int C = C0 + j;
            if (C >= NCH) break;
            SCAN_PARK(ring[(j + 1) % SCAN_RD], (C + 1) & 1); { const int cl_ = C + 1 + SCAN_RD; SCAN_LOAD(ring[(j + 1) % SCAN_RD], cl_ < NCH ? cl_ : NCH - 1); }
            const LAS bf16_t* kt = (const LAS bf16_t*)(F.lds + SC_SLOT + (C & 1) * SC_SLOTB); const LAS bf16_t* vt = kt + 128 * 72;
            const bf16x8 a00 = *(const LAS bf16x8*)(kt + (32 * ks + c) * 72 + 8 * g), a01 = *(const LAS bf16x8*)(kt + (32 * ks + c) * 72 + 32 + 8 * g);
            const bf16x8 a10 = *(const LAS bf16x8*)(kt + (32 * ks + 16 + c) * 72 + 8 * g), a11 = *(const LAS bf16x8*)(kt + (32 * ks + 16 + c) * 72 + 32 + 8 * g);
            float sc = 1.f; f32x4 d0, d1;
            if (ML) {
                const float bend = SM2[2 * C], mloc = SM2[2 * C + 1];
                const float mnew = fmaxf(bend + m_old, mloc), w_old = fast_exp(bend + m_old - mnew);
                sc = fast_exp(mloc - mnew);
                if (tid < 128) { const float nsv = SM[C * 128 + tid]; SM[C * 128 + tid] = nreg; nreg = w_old * nreg + sc * nsv; }
                if (tid == 0) SM2[2 * NCH + C] = m_old;
                m_old = mnew; d0 = (f32x4){w_old, w_old, w_old, w_old}; d1 = d0;
            } else { d0 = *(const LAS f32x4*)(SM + C * 128 + 32 * ks + 4 * g); d1 = *(const LAS f32x4*)(SM + C * 128 + 32 * ks + 16 + 4 * g); }
#pragma unroll
            for (int nb = 0; nb < 2; ++nb)
                *(u32x4*)(SP + (size_t)C * 16384 + (size_t)(((ks * 8 + 4 * vs + 2 * nbh + nb) * 64 + lane) * 8)) =
                    (u32x4){pk2(acc[0][nb][0], acc[0][nb][1]), pk2(acc[0][nb][2], acc[0][nb][3]), pk2(acc[1][nb][0], acc[1][nb][1]), pk2(acc[1][nb][2], acc[1][nb][3])};
#pragma unroll
            for (int nb = 0; nb < 2; ++nb) {
                const bf16x8 bk0 = *(const LAS bf16x8*)(vt + (32 * nbh + 16 * nb + c) * 72 + 8 * g), bk1 = *(const LAS bf16x8*)(vt + (32 * nbh + 16 * nb + c) * 72 + 32 + 8 * g);
                if (ML) {
                    f32x4 t0 = (f32x4){0.f, 0.f, 0.f, 0.f}, t1 = t0;
                    t0 = mfma16(a00, bk0, t0); t0 = mfma16(a01, bk1, t0); t1 = mfma16(a10, bk0, t1); t1 = mfma16(a11, bk1, t1);
                    acc[0][nb] = acc[0][nb] * d0 + t0 * sc; acc[1][nb] = acc[1][nb] * d1 + t1 * sc;
                } else {
                    acc[0][nb] = acc[0][nb] * d0; acc[1][nb] = acc[1][nb] * d1;
                    acc[0][nb] = mfma16(a00, bk0, acc[0][nb]); acc[0][nb] = mfma16(a01, bk1, acc[0][nb]); acc[1][nb] = mfma16(a10, bk0, acc[1][nb]); acc[1][nb] = mfma16(a11, bk1, acc[1][nb]); }
            }
            __syncthreads();
        }
    }
    if (ML && vs == 0) {
        __syncthreads();
        for (int i = tid; i < NCH * 128; i += 512) NST[(size_t)(i >> 7) * 132 + (i & 127)] = SM[i];
        if (tid < NCH) NST[(size_t)tid * 132 + 128] = SM2[2 * NCH + tid];
    }
#undef SCAN_LOAD
#undef SCAN_PARK
}

constexpr int R2_QS = 0, R2_GT = 17408, R2_KS = 51200, R2_ST = 51200  , R2_VT = 83968, R2_AM = 102400, R2_OT = 111616, R2_SEG = 145408, R2_SC = 147456, R2_NST = 149504  , R2_NW = 150528  ;
__device__ __forceinline__ bf16x8 hg_frag(const LAS bf16_t* X, const LAS float* G, int row, int ks, int g, const LAS float* ref, float sgn) {
    const u32x4 xv = *(const LAS u32x4*)(X + row * 136 + 32 * ks + 8 * g);
    f32x4 g0 = *(const LAS f32x4*)(G + row * 132 + 32 * ks + 8 * g), g1 = *(const LAS f32x4*)(G + row * 132 + 32 * ks + 8 * g + 4);
    if (ref) { g0 = g0 - *(const LAS f32x4*)(ref + 32 * ks + 8 * g); g1 = g1 - *(const LAS f32x4*)(ref + 32 * ks + 8 * g + 4); }
    u32x4 o;
    o.x = pk2(bflo(xv.x) * fast_exp(sgn * g0.x), bfhi(xv.x) * fast_exp(sgn * g0.y)); o.y = pk2(bflo(xv.y) * fast_exp(sgn * g0.z), bfhi(xv.y) * fast_exp(sgn * g0.w));
    o.z = pk2(bflo(xv.z) * fast_exp(sgn * g1.x), bfhi(xv.z) * fast_exp(sgn * g1.y)); o.w = pk2(bflo(xv.w) * fast_exp(sgn * g1.z), bfhi(xv.w) * fast_exp(sgn * g1.w));
    return __builtin_bit_cast(bf16x8, o);
}
__device__ __forceinline__ bf16x8 hg_frag_perm(const LAS bf16_t* X, const LAS float* G, int row, int ks, int g) {
    const u32x2 xa = *(const LAS u32x2*)(X + row * 136 + 32 * ks + 4 * g), xb = *(const LAS u32x2*)(X + row * 136 + 32 * ks + 16 + 4 * g);
    const f32x4 g0 = *(const LAS f32x4*)(G + row * 132 + 32 * ks + 4 * g), g1 = *(const LAS f32x4*)(G + row * 132 + 32 * ks + 16 + 4 * g);
    u32x4 o;
    o.x = pk2(bflo(xa.x) * fast_exp(g0.x), bfhi(xa.x) * fast_exp(g0.y)); o.y = pk2(bflo(xa.y) * fast_exp(g0.z), bfhi(xa.y) * fast_exp(g0.w));
    o.z = pk2(bflo(xb.x) * fast_exp(g1.x), bfhi(xb.x) * fast_exp(g1.y)); o.w = pk2(bflo(xb.y) * fast_exp(g1.z), bfhi(xb.y) * fast_exp(g1.w));
    return __builtin_bit_cast(bf16x8, o);
}
struct R2Regs { u32x4 rows[4]; u32x4 aux[2]; float gi, gf, nst; };
#define R2_DECL \
    const bf16_t* P = (const bf16_t*)(F.ws + WS_PROJ); bf16_t* BR = (bf16_t*)(F.ws + WS_BR); \
    LAS bf16_t* QS = (LAS bf16_t*)(F.lds + R2_QS); LAS bf16_t* KS = (LAS bf16_t*)(F.lds + R2_KS); LAS float* GT = (LAS float*)(F.lds + R2_GT); \
    LAS bf16_t* VT = (LAS bf16_t*)(F.lds + R2_VT); LAS bf16_t* AM = (LAS bf16_t*)(F.lds + R2_AM); LAS float* OT = (LAS float*)(F.lds + R2_OT); \
    LAS bf16_t* STL = (LAS bf16_t*)(F.lds + R2_ST); LAS float* SEG = (LAS float*)(F.lds + R2_SEG); LAS float* SC = (LAS float*)(F.lds + R2_SC); \
    LAS float* S_NST = (LAS float*)(F.lds + R2_NST); LAS float* NWL = (LAS float*)(F.lds + R2_NW); (void)S_NST; (void)NWL; \
    LAS float* S_AS = SC, *S_MU = SC + 64, *S_WI = SC + 128, *S_FL = SC + 192, *S_QN = SC + 256, *S_DEN = SC + 320; \
    const int lane = tid & 63, w = F.wave, g = lane >> 4, c = lane & 15, p_ = tid >> 3, c8 = tid & 7; \
    (void)P; (void)BR; (void)QS; (void)KS; (void)GT; (void)VT; (void)AM; (void)OT; (void)STL; (void)SEG; (void)S_AS; (void)S_MU; (void)S_WI; (void)S_FL; (void)S_QN; (void)S_DEN; (void)lane; (void)w; (void)g; (void)c; (void)p_; (void)c8;
__device__ __forceinline__ const bf16_t* r2_state_ptr(Frame& F, bool ml, int b, int h, int cn, int dir) {
    const int C = dir == 0 ? cn : (cn < 4 ? 3 - cn : 71 - cn);
    return (const bf16_t*)(F.ws + WS_SP) + ((size_t)((((ml ? 1 : 0) * 4 + b) * 4 + h) * 2 + dir) * NCH + C) * 16384;
}
__device__ __forceinline__ void r2_state_load(u32x4 (&stq)[4], const bf16_t* ST, int tid) {
#pragma unroll
    for (int it = 0; it < 4; ++it) stq[it] = *(const u32x4*)(ST + (size_t)(tid + 512 * it) * 8);
}
template <bool ML>
__device__ __forceinline__ void r2_load(Frame& F, int l, int b, int h, int cn, int dir, int tid, R2Regs& R) {

    const bf16_t* P = (const bf16_t*)(F.ws + WS_PROJ);
    const int p_ = tid >> 3, c8 = tid & 7;
    const int C = dir == 0 ? cn : (cn < 4 ? 3 - cn : 71 - cn);
    const int mrow = tokrow(b, dir, 64 * C + p_);
    if (!ML) {
        const bf16_t* qp = P + (size_t)mrow * NPROJ + C_HGQ + 128 * h + 16 * c8;
        const bf16_t* zp = P + (size_t)mrow * NPROJ + C_HGF + 512 * dir + 128 * h + 16 * c8;
        R.rows[0] = *(const u32x4*)qp; R.rows[1] = *(const u32x4*)(qp + 8); R.rows[2] = *(const u32x4*)zp; R.rows[3] = *(const u32x4*)(zp + 8);
    } else {
#pragma unroll
        for (int q = 0; q < 4; ++q) {
            const u32x2 vq = *(const u32x2*)(P + (size_t)mrow * NPROJ + C_MLQ + 128 * h + 64 * (q >> 1) + 32 * (q & 1) + 4 * c8);
            const u32x2 vk = *(const u32x2*)(P + (size_t)mrow * NPROJ + C_MLK + 128 * h + 64 * (q >> 1) + 32 * (q & 1) + 4 * c8);
            if (q & 1) { R.rows[q >> 1].z = vq.x; R.rows[q >> 1].w = vq.y; R.rows[2 + (q >> 1)].z = vk.x; R.rows[2 + (q >> 1)].w = vk.y; }
            else { R.rows[q >> 1].x = vq.x; R.rows[q >> 1].y = vq.y; R.rows[2 + (q >> 1)].x = vk.x; R.rows[2 + (q >> 1)].y = vk.y; } }
        if (tid < 64) { const float* G16 = (const float*)(F.ws + WS_G16); const int mr = tokrow(b, dir, 64 * C + tid);
            R.gi = G16[(size_t)mr * 16 + dir * 8 + h] + F.in[I_MLGB][((l * 2 + dir) * 2 + 0) * 4 + h]; R.gf = G16[(size_t)mr * 16 + dir * 8 + 4 + h] + F.in[I_MLGB][((l * 2 + dir) * 2 + 1) * 4 + h]; }
        if (tid < 132) R.nst = ((const float*)(F.ws + WS_NST))[((size_t)(((b * 4 + h) * 2 + dir) * NCH) + C) * 132 + tid];
    }
    if (dir == 0) {
        const bf16_t* VG = (const bf16_t*)(F.ws + WS_VTG) + ((size_t)(b * NCH + cn) * 1536 + (ML ? V_ML : V_HG) + 128 * h) * 64;
#pragma unroll
        for (int it = 0; it < 2; ++it) { const int q = tid + 512 * it; R.aux[it] = *(const u32x4*)(VG + (size_t)(q >> 3) * 64 + 8 * (q & 7)); }
    } else {
        const bf16_t* gp = P + (size_t)(b * TT + 64 * cn + p_) * NPROJ + (ML ? C_MLO : C_HGG) + 128 * h + 16 * c8;
        R.aux[0] = *(const u32x4*)gp; R.aux[1] = *(const u32x4*)(gp + 8);
    }
}
template <bool ML>
__device__ __forceinline__ void r2_dir(Frame& F, int l, int b, int h, int cn, int dir, int tid, const R2Regs& R, u32x4 (&stq)[4], const bf16_t* nextST) {

    R2_DECL
    const int C = dir == 0 ? cn : (cn < 4 ? 3 - cn : 71 - cn);
    const int mrow = tokrow(b, dir, 64 * C + p_);
    if (ML) { if (tid < 132) S_NST[tid] = R.nst; }
    __syncthreads();
    if (dir == 0) {
#pragma unroll
        for (int it = 0; it < 2; ++it) { const int q = tid + 512 * it; *(LAS u32x4*)(VT + (q >> 3) * 72 + 8 * (q & 7)) = R.aux[it]; } }
    if (!ML) {
        const u32x4 q0 = R.rows[0], q1 = R.rows[1], z0 = R.rows[2], z1 = R.rows[3];
        float qv[16], lf[16];
#pragma unroll
        for (int q = 0; q < 4; ++q) { qv[2 * q] = bflo(q0[q]); qv[2 * q + 1] = bfhi(q0[q]); qv[8 + 2 * q] = bflo(q1[q]); qv[8 + 2 * q + 1] = bfhi(q1[q]);
            lf[2 * q] = bflo(z0[q]); lf[2 * q + 1] = bfhi(z0[q]); lf[8 + 2 * q] = bflo(z1[q]); lf[8 + 2 * q + 1] = bfhi(z1[q]); }
        unsigned qk[8], kk[8];
#pragma unroll
        for (int e = 0; e < 16; e += 2) {
            const float f0 = fast_exp(lf[e]), f1 = fast_exp(lf[e + 1]);
            kk[e >> 1] = pk2(1.0f - f0, 1.0f - f1); qk[e >> 1] = pk2(siluf_(qv[e]), siluf_(qv[e + 1])); }
        *(LAS u32x4*)(QS + p_ * 136 + 16 * c8) = (u32x4){qk[0], qk[1], qk[2], qk[3]}; *(LAS u32x4*)(QS + p_ * 136 + 16 * c8 + 8) = (u32x4){qk[4], qk[5], qk[6], qk[7]};
        *(LAS u32x4*)(KS + p_ * 136 + 16 * c8) = (u32x4){kk[0], kk[1], kk[2], kk[3]}; *(LAS u32x4*)(KS + p_ * 136 + 16 * c8 + 8) = (u32x4){kk[4], kk[5], kk[6], kk[7]};
#pragma unroll
        for (int q = 0; q < 4; ++q) *(LAS f32x4*)(GT + p_ * 132 + 16 * c8 + 4 * q) = (f32x4){lf[4 * q], lf[4 * q + 1], lf[4 * q + 2], lf[4 * q + 3]};
        __syncthreads();
        {
            const int d = 16 * w + c;
            float pre[16]; float run = 0.f;
#pragma unroll
            for (int i = 0; i < 16; ++i) { run += GT[(16 * g + i) * 132 + d]; pre[i] = run; }
            float off = 0.f;
#pragma unroll
            for (int q = 0; q < 4; ++q) { const float t = __shfl(run, c + 16 * q); off += (q < g) ? t : 0.f; }
#pragma unroll
            for (int i = 0; i < 16; ++i) GT[(16 * g + i) * 132 + d] = off + pre[i]; }
    } else {
        float xq[2][2][4], xk[2][2][4];
#pragma unroll
        for (int hf = 0; hf < 2; ++hf) {
            const u32x4 vq = R.rows[hf], vk = R.rows[2 + hf];
            xq[hf][0][0] = bflo(vq.x); xq[hf][0][1] = bfhi(vq.x); xq[hf][0][2] = bflo(vq.y); xq[hf][0][3] = bfhi(vq.y); xq[hf][1][0] = bflo(vq.z); xq[hf][1][1] = bfhi(vq.z); xq[hf][1][2] = bflo(vq.w); xq[hf][1][3] = bfhi(vq.w);
            const float ksc = 0.08838834764831845f;
            xk[hf][0][0] = bflo(vk.x) * ksc; xk[hf][0][1] = bfhi(vk.x) * ksc; xk[hf][0][2] = bflo(vk.y) * ksc; xk[hf][0][3] = bfhi(vk.y) * ksc; xk[hf][1][0] = bflo(vk.z) * ksc; xk[hf][1][1] = bfhi(vk.z) * ksc; xk[hf][1][2] = bflo(vk.w) * ksc; xk[hf][1][3] = bfhi(vk.w) * ksc; }
        { const int rr = mrow % TT;
          if (rr >= NCTX) { const int t = rr - NCTX;
#pragma unroll
            for (int hf = 0; hf < 2; ++hf) { const float pos = (float)(hf ? (t & 63) : (t >> 6));
#pragma unroll
                for (int e = 0; e < 4; ++e) { const float rev = pos * (__builtin_amdgcn_exp2f(-(float)(4 * c8 + e) * 0.41524101186092030f) * 0.15915494309189535f);
                    const float cs = __builtin_amdgcn_cosf(rev), sn = __builtin_amdgcn_sinf(rev);
                    const float a1 = xq[hf][0][e], a2 = xq[hf][1][e]; xq[hf][0][e] = a1 * cs - a2 * sn; xq[hf][1][e] = a1 * sn + a2 * cs;
                    const float b1 = xk[hf][0][e], b2 = xk[hf][1][e]; xk[hf][0][e] = b1 * cs - b2 * sn; xk[hf][1][e] = b1 * sn + b2 * cs; } } } }
        float qn = 0.f;
#pragma unroll
        for (int hf = 0; hf < 2; ++hf)
#pragma unroll
            for (int q = 0; q < 2; ++q) { const int ch = 64 * hf + 32 * q + 4 * c8;
                const f32x4 nv = *(const LAS f32x4*)(S_NST + ch);
                qn += (xq[hf][q][0] * nv.x + xq[hf][q][1] * nv.y) + (xq[hf][q][2] * nv.z + xq[hf][q][3] * nv.w);
                *(LAS u32x2*)(QS + p_ * 136 + ch) = (u32x2){pk2(xq[hf][q][0], xq[hf][q][1]), pk2(xq[hf][q][2], xq[hf][q][3])};
                *(LAS u32x2*)(KS + p_ * 136 + ch) = (u32x2){pk2(xk[hf][q][0], xk[hf][q][1]), pk2(xk[hf][q][2], xk[hf][q][3])}; }
        qn += __shfl_xor(qn, 1); qn += __shfl_xor(qn, 2); qn += __shfl_xor(qn, 4);
        if (c8 == 0) S_QN[p_] = qn;
        if (w == 0) {
            const int mr = tokrow(b, dir, 64 * C + lane);
            const float ig = R.gi, lfg = logsigmoidf_(R.gf), m_in = S_NST[128];
            const float bb = wave_scan_add(lfg, lane), a = ig - bb, mu = fmaxf(m_in, wave_scan_max(a, lane));
            S_AS[lane] = a; S_MU[lane] = mu; S_WI[lane] = fast_exp(m_in - mu); S_FL[lane] = fast_exp(-bb - mu);
        }
    }
    __syncthreads();
    if (!ML) {
        const int J = w < 4 ? w : (w == 4 ? 0 : (w == 5 ? 1 : (w == 6 ? 0 : 2)));
        const int I0 = w < 4 ? w : (w == 4 ? 1 : (w == 5 ? 2 : 3));
        const int nblk = (w == 4 || w == 5) ? 2 : 1;
        const LAS float* ref = GT + ((w < 4) ? 16 * J + 8 : 16 * J + 15) * 132;
        f32x4 z0 = (f32x4){0.f, 0.f, 0.f, 0.f}, z1 = z0;
#pragma unroll
        for (int ks = 0; ks < 4; ++ks) {
            const bf16x8 kf = hg_frag(KS, GT, 16 * J + c, ks, g, ref, -1.0f);
            z0 = mfma16(kf, hg_frag(QS, GT, 16 * I0 + c, ks, g, ref, 1.0f), z0);
            if (nblk == 2) z1 = mfma16(kf, hg_frag(QS, GT, 16 * (I0 + 1) + c, ks, g, ref, 1.0f), z1);
        }
        for (int q = 0; q < nblk; ++q) {
            const int I = I0 + q;
            f32x4 z = q ? z1 : z0;
            if (I == J) {
#pragma unroll
                for (int r = 0; r < 4; ++r) z[r] = (4 * g + r <= c) ? z[r] : 0.f; }
            if (dir == 0) *(LAS u32x2*)(AM + (16 * I + c) * 72 + 16 * J + 4 * g) = (u32x2){pk2(z[0], z[1]), pk2(z[2], z[3])};
            else *(LAS u32x2*)(AM + (16 * I + c) * 72 + 16 * (3 - J) + 12 - 4 * g) = (u32x2){pk2(z[3], z[2]), pk2(z[1], z[0])};
        }
        if (w == 7) {
            for (int i = lane; i < 6 * 16 * 2; i += 64) { const int blk = i >> 5, rr = (i >> 1) & 15, hh = i & 1;
                const int Iz = blk < 3 ? 0 : (blk < 5 ? 1 : 2), Jz = blk < 3 ? 1 + blk : (blk < 5 ? blk - 1 : 3);
                *(LAS u32x4*)(AM + (16 * Iz + rr) * 72 + 16 * (dir == 0 ? Jz : 3 - Jz) + 8 * hh) = (u32x4){0u, 0u, 0u, 0u}; }
        }
    } else {
        const int I = w & 3, par = w >> 2;
        float dsum = 0.f;
        const float mu = S_MU[16 * I + c];
        for (int J = par; J < 4; J += 2) {
            if (J <= I) {
                f32x4 z = (f32x4){0.f, 0.f, 0.f, 0.f};
#pragma unroll
                for (int ks = 0; ks < 4; ++ks) z = mfma16(*(const LAS bf16x8*)(KS + (16 * J + c) * 136 + 32 * ks + 8 * g), *(const LAS bf16x8*)(QS + (16 * I + c) * 136 + 32 * ks + 8 * g), z);
                const f32x4 as = *(const LAS f32x4*)(S_AS + 16 * J + 4 * g);
#pragma unroll
                for (int r = 0; r < 4; ++r) { const bool ok = (J < I) || (4 * g + r <= c); z[r] = ok ? fast_exp(as[r] - mu) * z[r] : 0.f; dsum += z[r]; }
                if (dir == 0) *(LAS u32x2*)(AM + (16 * I + c) * 72 + 16 * J + 4 * g) = (u32x2){pk2(z[0], z[1]), pk2(z[2], z[3])};
                else *(LAS u32x2*)(AM + (16 * I + c) * 72 + 16 * (3 - J) + 12 - 4 * g) = (u32x2){pk2(z[3], z[2]), pk2(z[1], z[0])};
            } else {
                *(LAS u32x2*)(AM + (16 * I + c) * 72 + 16 * (dir == 0 ? J : 3 - J) + 4 * g) = (u32x2){0u, 0u};
            }
        }
        dsum += __shfl_xor(dsum, 16); dsum += __shfl_xor(dsum, 32);
        if (g == 0) S_DEN[par * 64 + 16 * I + c] = dsum;
    }
    __syncthreads();
#pragma unroll
    for (int it = 0; it < 4; ++it) *(LAS u32x4*)(STL + (tid + 512 * it) * 8) = stq[it];
    if (nextST) r2_state_load(stq, nextST, tid);
    __syncthreads();
    {
        const int I = w & 3, half = w >> 2;
        f32x4 o[4];
#pragma unroll
        for (int nb = 0; nb < 4; ++nb) o[nb] = (f32x4){0.f, 0.f, 0.f, 0.f};
#pragma unroll
        for (int ks = 0; ks < 4; ++ks) {
            const bf16x8 af = ML ? cat4(*(const LAS bf16x4*)(QS + (16 * I + c) * 136 + 32 * ks + 4 * g), *(const LAS bf16x4*)(QS + (16 * I + c) * 136 + 32 * ks + 16 + 4 * g)) : hg_frag_perm(QS, GT, 16 * I + c, ks, g);
#pragma unroll
            for (int nb = 0; nb < 4; ++nb) { const bf16x8 bf = *(const LAS bf16x8*)(STL + ((ks * 8 + 4 * half + nb) * 64 + lane) * 8); o[nb] = mfma16(af, bf, o[nb]); } }
        if (ML) { const f32x4 wi = *(const LAS f32x4*)(S_WI + 16 * I + 4 * g);
#pragma unroll
            for (int nb = 0; nb < 4; ++nb) o[nb] = o[nb] * wi; }
#pragma unroll
        for (int kp = 0; kp < 2; ++kp) {
            const bf16x8 af = *(const LAS bf16x8*)(AM + (16 * I + c) * 72 + 32 * kp + 8 * g);
#pragma unroll
            for (int nb = 0; nb < 4; ++nb) { const bf16x8 bf = *(const LAS bf16x8*)(VT + (64 * half + 16 * nb + c) * 72 + 32 * kp + 8 * g); o[nb] = mfma16(af, bf, o[nb]); } }
        f32x4 rs = (f32x4){1.f, 1.f, 1.f, 1.f};
        if (ML) {
#pragma unroll
            for (int r = 0; r < 4; ++r) { const int pp = 16 * I + 4 * g + r; const float den = S_DEN[pp] + S_DEN[64 + pp] + S_WI[pp] * S_QN[pp]; rs[r] = fast_rcp(fmaxf(fabsf(den), S_FL[pp])); } }
#pragma unroll
        for (int r = 0; r < 4; ++r) { const int pp = 16 * I + 4 * g + r; const int nl = dir == 0 ? pp : 63 - pp;
#pragma unroll
            for (int nb = 0; nb < 4; ++nb) { LAS float* op = OT + nl * 132 + 64 * half + 16 * nb + c; const float val = o[nb][r] * rs[r]; *op = (dir == 0) ? val : *op + val; } }
    }
}
template <bool ML>
__device__ __forceinline__ void r2_finish(Frame& F, int l, int b, int h, int cn, int tid, const R2Regs& R) {
    R2_DECL
    __syncthreads();
    {
        const int m = b * TT + 64 * cn + p_;
        float ov[16]; float ss = 0.f;
#pragma unroll
        for (int q = 0; q < 4; ++q) { const f32x4 t = *(const LAS f32x4*)(OT + p_ * 132 + 16 * c8 + 4 * q); ov[4 * q] = t.x; ov[4 * q + 1] = t.y; ov[4 * q + 2] = t.z; ov[4 * q + 3] = t.w; ss += (t.x * t.x + t.y * t.y) + (t.z * t.z + t.w * t.w); }
        ss += __shfl_xor(ss, 1); ss += __shfl_xor(ss, 2); ss += __shfl_xor(ss, 4);
        const float rstd = 1.0f / sqrtf(ss * (1.0f / 128.0f) + EPS);
        const u32x4 g0 = R.aux[0], g1 = R.aux[1];
        const LAS float* nw = NWL + (ML ? 512 : 0) + 128 * h + 16 * c8;
        unsigned ow[8];
#pragma unroll
        for (int q = 0; q < 8; ++q) { const unsigned gw_ = q < 4 ? g0[q] : g1[q - 4]; const float ga = bflo(gw_), gb = bfhi(gw_);
            const float fa = ML ? sigmoidf_(ga) : siluf_(ga), fb = ML ? sigmoidf_(gb) : siluf_(gb);
            ow[q] = pk2(ov[2 * q] * rstd * nw[2 * q] * fa, ov[2 * q + 1] * rstd * nw[2 * q + 1] * fb); }
        bf16_t* op = BR + (size_t)m * 1536 + (ML ? 1024 : 512) + 128 * h + 16 * c8;
        *(u32x4*)op = (u32x4){ow[0], ow[1], ow[2], ow[3]}; *(u32x4*)(op + 8) = (u32x4){ow[4], ow[5], ow[6], ow[7]};
    }
}
__device__ __forceinline__ void r2_decode(int u, int G, int c0, int ncn, int& mix, int& b, int& h, int& cn) { mix = (u + u / G) & 1; const int v = u >> 1; cn = c0 + v % ncn; const int bh = v / ncn; b = bh >> 2; h = bh & 3; }
template <bool T0>
__device__ __forceinline__ void r2_loop(Frame& F, int l, int c0, int ncn, int nu) {
    int tid = F.tid; asm volatile("" : "+v"(tid));
    __syncthreads();
    for (int i = tid; i < 1024; i += 512) ((LAS float*)(F.lds + R2_NW))[i] = F.in[i < 512 ? I_HGNW : I_MLNW][l * 512 + (i & 511)];
    R2Regs ra, rb; u32x4 stq[4]; int mix, b, h, cn, b2, h2, cn2;
    int u = F.bid; if (u >= nu) return;
    r2_decode(u, F.G, c0, ncn, mix, b, h, cn);
    r2_load<T0>(F, l, b, h, cn, 0, tid, ra); r2_state_load(stq, r2_state_ptr(F, T0, b, h, cn, 0), tid);
    for (;;) {
        r2_load<T0>(F, l, b, h, cn, 1, tid, rb);
        r2_dir<T0>(F, l, b, h, cn, 0, tid, ra, stq, r2_state_ptr(F, T0, b, h, cn, 1));
        const int u2 = u + F.G; const bool has2 = u2 < nu;
        if (has2) { r2_decode(u2, F.G, c0, ncn, mix, b2, h2, cn2); r2_load<!T0>(F, l, b2, h2, cn2, 0, tid, ra); }
        r2_dir<T0>(F, l, b, h, cn, 1, tid, rb, stq, has2 ? r2_state_ptr(F, !T0, b2, h2, cn2, 0) : (const bf16_t*)nullptr);
        r2_finish<T0>(F, l, b, h, cn, tid, rb);
        if (!has2) break;
        r2_load<!T0>(F, l, b2, h2, cn2, 1, tid, rb);
        r2_dir<!T0>(F, l, b2, h2, cn2, 0, tid, ra, stq, r2_state_ptr(F, !T0, b2, h2, cn2, 1));
        const int u3 = u2 + F.G; const bool has3 = u3 < nu;
        if (has3) { r2_decode(u3, F.G, c0, ncn, mix, b, h, cn); r2_load<T0>(F, l, b, h, cn, 0, tid, ra); }
        r2_dir<!T0>(F, l, b2, h2, cn2, 1, tid, rb, stq, has3 ? r2_state_ptr(F, T0, b, h, cn, 0) : (const bf16_t*)nullptr);
        r2_finish<!T0>(F, l, b2, h2, cn2, tid, rb);
        if (!has3) break;
        u = u3;
    }
}
constexpr int MOE_T1 = 17600, MOE_T2 = 27000;
constexpr int SPL = 11, N_PHASES = 2 + 2 * SPL, PH_FINAL = N_PHASES - 1, PH_EMPTY = 1 + 10;
__device__ __forceinline__ void init_frame(Frame& F, const Args& args, unsigned char* lds_raw) {
    F.lds = (LAS unsigned char*)lds_raw;
    F.MISC = (volatile LAS unsigned*)(F.lds + LDSCTL_OFF);
    F.tid = threadIdx.x; F.lane = F.tid & 63; F.wave = __builtin_amdgcn_readfirstlane(F.tid >> 6);
    F.G = gridDim.x; F.bid = blockIdx.x;
    F.ws = args.ws; F.ctl = (unsigned*)(args.ws + WS_CTL); F.in = args.in; F.out = args.out;
}
template <int PH>
__device__ __forceinline__ void run_phase(Frame& F) {
    LAS unsigned char* lds = F.lds;
    bf16_t* A1 = (bf16_t*)(F.ws + WS_A1); bf16_t* PROJ = (bf16_t*)(F.ws + WS_PROJ); bf16_t* BRb = (bf16_t*)(F.ws + WS_BR); bf16_t* Yb = (bf16_t*)(F.ws + WS_Y);
    bf16_t* HMID = (bf16_t*)(F.ws + WS_HMID); bf16_t* XG = (bf16_t*)(F.ws + WS_XG); bf16_t* YM = (bf16_t*)(F.ws + WS_YM);
    float* H = (float*)(F.ws + WS_H); const float* MOD = (const float*)(F.ws + WS_MOD);
    if constexpr (PH == 0) ph_prologue(F);
    else if constexpr (PH == PH_FINAL) ph_final(F);
    else {
        constexpr int l = (PH - 1) / SPL, sp0 = (PH - 1) % SPL, sp = sp0 <= 2 ? sp0 : (sp0 == 3 ? 100 : sp0 - 1);
        if constexpr (sp == 0) ph_norm1(F, l);
        else if constexpr (sp == 1) {
            pg8::InProjOrder S{(const char*)A1, (const char*)(F.ws + WS_WIN) + (size_t)l * NWIN * 1024 * 2, F.G, F.bid};
            pg8::EpiInProj E{PROJ, (bf16_t*)(F.ws + WS_VTG)};
#ifdef STAGGER_US
            if ((F.bid >> 3) & 1) { const unsigned long long t0 = __builtin_amdgcn_s_memrealtime(); while (__builtin_amdgcn_s_memrealtime() - t0 < (unsigned long long)(STAGGER_US * 100)) __builtin_amdgcn_s_sleep(32); }
#endif
            pg8::gemm_phase(lds, F.tid, 1024, 1024, 1024, S, E);
        } else if constexpr (sp == 2) {
            prep_loop<false>(F, l); prep_loop<true>(F, l);
        } else if constexpr (sp == 100) {
            for (int u = F.bid; u < 128; u += F.G) {
                const int vs = u & 1, sq = (u >> 1) & 31, dir = sq & 1, h = (sq >> 1) & 3, b = sq >> 3;
                if (u < 64) scan_unit<false>(F, b, h, dir, vs); else scan_unit<true>(F, b, h, dir, vs); }
            constexpr int nna = (l == 0) ? 1024 + 64 : 1024;
            for (;;) {
                __syncthreads();
                if (F.tid == 0) F.MISC[16] = xb_add(F.ctl + CW_NAQ + 64 * l, 1u);
                __syncthreads();
                const int u = (int)F.MISC[16];
                if (u >= nna) break;
                if (u < 1024) na_unit<true>(F, l, u >> 8, (u >> 5) & 7, u & 31);
                else { const int v = u - 1024; na_unit<false>(F, l, v >> 4, (v >> 1) & 7, v & 1); } }
        } else if constexpr (sp == 3) {
            constexpr int c0 = (l == 0) ? 0 : 4, ncn = NCH - c0, nu = 2 * 16 * ncn;
            { int mix0, b0_, h0_, cn0_; r2_decode(F.bid, F.G, c0, ncn, mix0, b0_, h0_, cn0_);
              if (mix0 == 0) r2_loop<false>(F, l, c0, ncn, nu); else r2_loop<true>(F, l, c0, ncn, nu); }
        } else if constexpr (sp == 4) {
            pg8::MergeOrder S{(const char*)BRb, (const char*)(F.ws + WS_WB) + (size_t)l * 1024 * 1536 * 2, (size_t)256 * 1536 * 2, (size_t)256 * 1536 * 2, l == 0 ? MT / 256 : 64, 4, F.G, F.bid, l == 0 ? 0 : 1};
            pg8::EpiMerge E{PROJ, Yb};
            pg8::gemm_phase(lds, F.tid, 512, 1536, 1536, S, E);
            if constexpr (l == 0) { if (F.bid >= 16) moe_convert(F, 0, MOE_T1, (F.bid - 16) * NWAVES + F.wave, (F.G - 16) * NWAVES); }
        } else if constexpr (sp == 5) {
            pg8::StaticOrder S{(const char*)Yb, (const char*)(F.ws + WS_WO) + (size_t)l * 1024 * 1024 * 2, (size_t)256 * 1024 * 2, (size_t)256 * 1024 * 2, l == 0 ? MT / 256 : 64, 4, F.G, F.bid, l == 0 ? 0 : 1};
            pg8::EpiResid E{H, MOD + (size_t)l * 5 * 6144 + 2 * 1024};
            pg8::gemm_phase(lds, F.tid, 1024, 1024, 1024, S, E);
            if constexpr (l == 0) { if (F.bid >= 16) moe_convert(F, MOE_T1, MOE_T2, (F.bid - 16) * NWAVES + F.wave, (F.G - 16) * NWAVES); }
        } else if constexpr (sp == 6) ph_norm2(F, l);
        else if constexpr (sp == 7) {
            if constexpr (l == 0) {
                pg8::StaticOrder S{(const char*)A1, (const char*)(F.ws + WS_WUP), (size_t)256 * 1024 * 2, (size_t)256 * 1024 * 2, MT / 256, 2 * FFN / 256, F.G, F.bid, 0};
                pg8::EpiSwiGLU E{HMID, FFN};
                pg8::gemm_phase(lds, F.tid, 1024, 1024, 1024, S, E);
            } else ph_moe_gather(F);
        } else if constexpr (sp == 8) {
            if constexpr (l == 0) {
                pg8::StaticOrder S{(const char*)HMID, (const char*)(F.ws + WS_WDN), (size_t)256 * FFN * 2, (size_t)256 * FFN * 2, MT / 256, 4, F.G, F.bid, 0};
                pg8::EpiResid E{H, MOD + 5 * 1024};
                pg8::gemm_phase(lds, F.tid, FFN, FFN, FFN, S, E);
                if (F.bid >= 16) moe_convert(F, MOE_T2, MOE_XITEMS, (F.bid - 16) * NWAVES + F.wave, (F.G - 16) * NWAVES);
            } else {
                const int* RT = (const int*)(F.ws + WS_ROUTE);
                pg8::MoeOrder S{(const char*)XG, (const char*)(F.ws + WS_MUP), (size_t)1024 * 2, (size_t)256 * 1024 * 2, (size_t)2 * EXD * 1024 * 2, RT + RT_TILE, RT[RT_NT], 2 * EXD / 256, F.G, F.bid, 1 << 30};
                pg8::EpiSwiGLU E{HMID, EXD};
                pg8::gemm_phase(lds, F.tid, 1024, 1024, 1024, S, E);
            }
        } else if constexpr (sp == 9) {
            if constexpr (l == 1) {
                const int* RT = (const int*)(F.ws + WS_ROUTE);
                const int nrt = RT[RT_NT], full = RT[RT_NT + 1], nextra = RT[RT_NT + 2];
                pg8::MoeOrder S{(const char*)HMID, (const char*)(F.ws + WS_MDN), (size_t)EXD * 2, (size_t)256 * EXD * 2, (size_t)1024 * EXD * 2, RT + RT_TILE, nrt, 4, F.G, F.bid, full};
                pg8::EpiStoreBf16 E{YM, 1024};
                pg8::gemm_phase(lds, F.tid, EXD, EXD, EXD, S, E);
                if (nextra > 0) {
                    pg8::MoeSplitOrder S2{(const char*)HMID, (const char*)(F.ws + WS_MDN), (size_t)256 * EXD * 2, (size_t)1024 * EXD * 2, RT + RT_TILE, nrt, 4, F.G, F.bid, full, nextra};
                    pg8::EpiStoreBf16 E2{(bf16_t*)(F.ws + WS_YMP), 256};
                    pg8::gemm_phase(lds, F.tid, 512, EXD, EXD, S2, E2);
                }
            }
        }
    }
}
#ifdef MK_ONE_LAUNCH
template <int PH> __device__ __forceinline__ void run_all(Frame& F, const Args& args, const XcdBarrier& bar) {
    if constexpr (PH < N_PHASES) {
        if constexpr (PH != PH_EMPTY) {
            { size_t zo = 0; asm volatile("" : "+s"(zo)); unsigned char* wsl = args.ws + zo; F.ws = wsl; F.ctl = (unsigned*)(wsl + WS_CTL);
              int ln = (int)__builtin_amdgcn_mbcnt_hi(~0u, __builtin_amdgcn_mbcnt_lo(~0u, 0u)); asm volatile("" : "+v"(ln)); F.lane = ln; F.tid = F.wave * 64 + ln; }
            run_phase<PH>(F);
#ifdef PROBE_DUP
            if constexpr (PH == PROBE_DUP) { xcd_barrier(bar); run_phase<PH>(F); }
#endif
            if constexpr (PH + 1 < N_PHASES) xcd_barrier(bar);
        }
        run_all<PH + 1>(F, args, bar);
    }
}
__global__ void __launch_bounds__(NWAVES * 64, 2) mega_fwd(Args args) {
    extern __shared__ __attribute__((aligned(16))) unsigned char lds_raw[];
    Frame F; init_frame(F, args, lds_raw);
    for (int u = F.tid; u < (LDS_BYTES - LDSCTL_OFF) / 4; u += NWAVES * 64) ((LAS unsigned*)(F.lds + LDSCTL_OFF))[u] = 0u;
    __syncthreads();
    const XcdBarrier bar = xcd_barrier_post(F.ctl + CW_BAR, F.MISC + 8);
    run_all<0>(F, args, bar);
}
#else
template <int PH>
__global__ void __launch_bounds__(NWAVES * 64, 2) k_phase(Args args) {
    extern __shared__ __attribute__((aligned(16))) unsigned char lds_raw[];
    Frame F; init_frame(F, args, lds_raw);
    run_phase<PH>(F);
}
template <int PH> static void launch_phases(int grid, hipStream_t stream, const Args& a) {
    if constexpr (PH < N_PHASES) {
        if constexpr (PH != PH_EMPTY) {
            static bool attr = false;
            if (!attr) { (void)hipFuncSetAttribute((const void*)k_phase<PH>, hipFuncAttributeMaxDynamicSharedMemorySize, LDS_BYTES); attr = true; }
            hipLaunchKernelGGL(k_phase<PH>, dim3(grid), dim3(NWAVES * 64), LDS_BYTES, stream, a);
        }
        launch_phases<PH + 1>(grid, stream, a);
    }
}
#endif

extern "C" void kernel_launch(void* const* d_in, const int* in_sizes, int n_in, void* d_out, int out_size, void* d_ws, size_t ws_size, hipStream_t stream) {
    static int grid = 0;
    if (grid == 0) {
        if (n_in != 22 || out_size != NB * SEQ * DM || ws_size < WS_END) { fprintf(stderr, "kernel_launch: unexpected shapes (n_in %d, out %d, ws %zu, need %zu)\n", n_in, out_size, ws_size, (size_t)WS_END); grid = -1; return; }
        int dev = 0, cus = 0;
        if (hipGetDevice(&dev) != hipSuccess || hipDeviceGetAttribute(&cus, hipDeviceAttributeMultiprocessorCount, dev) != hipSuccess) { grid = -1; return; }
#ifdef MK_ONE_LAUNCH
        int per_cu = 0;
        if (hipFuncSetAttribute((const void*)mega_fwd, hipFuncAttributeMaxDynamicSharedMemorySize, LDS_BYTES) != hipSuccess) { fprintf(stderr, "kernel_launch: hipFuncSetAttribute(%d B LDS) failed\n", LDS_BYTES); grid = -1; return; }
        if (hipOccupancyMaxActiveBlocksPerMultiprocessor(&per_cu, (const void*)mega_fwd, NWAVES * 64, LDS_BYTES) != hipSuccess || per_cu < 1) { fprintf(stderr, "kernel_launch: occupancy query reports %d workgroups per CU; nothing launched\n", per_cu); (void)hipGetLastError(); grid = -1; return; }
#endif
        grid = cus;
    }
    if (grid < 0) return;
    (void)hipMemsetAsync((char*)d_ws + WS_CTL, 0, 32768, stream);
    Args a{};
    for (int i = 0; i < 22; ++i) a.in[i] = (const float*)d_in[i];
    a.out = (float*)d_out; a.ws = (unsigned char*)d_ws; a.ph_lo = 0; a.ph_hi = N_PHASES;
#ifndef MK_ONE_LAUNCH
    launch_phases<0>(grid, stream, a);
#else
    hipLaunchKernelGGL(mega_fwd, dim3(grid), dim3(NWAVES * 64), LDS_BYTES, stream, a);
#endif
}
```
